# Optimizing an MI355X kernel written in HIP

```python
import math
import jax, jax.numpy as jnp
from jax import lax
import numpy as np

D_MODEL = 1024
BATCH = 8
SEQ = 2048
DEPTH = 2

CTX_LEN = 256
GRID_W = 64
HD = 64
BLOCK = 128
WINDOW = 128
ROPE_THETA = 10000.0
EPS = 1e-6
NEG_INF = -1e30
A_HEADS = 8
A_KV = 2
B_HEADS = 8
B_KV = 2
C_HEADS = 4
D_HEADS = 8
Q_LORA = 512
KV_LORA = 256
QK_NOPE = 64
QK_ROPE = 32
V_HEAD = 64
N_BRANCH = 4
BRANCH_W = 512
Q_SIZES = (A_HEADS * HD, B_HEADS * HD, 2 * C_HEADS * HD, Q_LORA)
KV_SIZES = (A_KV * HD, A_KV * HD, B_KV * HD, B_KV * HD, 2 * C_HEADS * HD, 2 * C_HEADS * HD, KV_LORA, QK_ROPE)
Q_COLS = A_HEADS * HD + B_HEADS * HD + 2 * C_HEADS * HD + Q_LORA
KV_COLS = 2 * A_KV * HD + 2 * B_KV * HD + 4 * C_HEADS * HD + KV_LORA + QK_ROPE
GATE_COLS = N_BRANCH * D_MODEL
IN_COLS = Q_COLS + KV_COLS + GATE_COLS
D_FF = 2816
N_EXPERTS = 8
TOP_K = 2
EXPERT_FF = 3584
MOE_BLOCK = 128
N_DENSE = (DEPTH + 1) // 2
N_MOE = DEPTH // 2

kernel_name = 'hybrid_gated_branch_diffusion_block'


def _offsets(sizes):
    return [int(v) for v in np.cumsum(sizes)[:-1]]


def rms(x, g):
    xf = x.astype(jnp.float32)
    y = xf * lax.rsqrt(jnp.mean(xf * xf, axis=-1, keepdims=True) + EPS)
    return (y * g.astype(jnp.float32)).astype(x.dtype)


def adaln(x, g, shift, scale):
    return rms(x, g) * (1 + scale) + shift


def modulation(cond, w, b):
    m = jax.nn.silu(cond) @ w + b
    return jnp.split(m, 6, axis=-1)


def axial_rope(rows, rot_dim):
    t = jnp.arange(rows * GRID_W)
    n = rot_dim // 4
    inv = jnp.power(ROPE_THETA, -jnp.arange(n, dtype=jnp.float32) / n)
    ang = jnp.concatenate([(t // GRID_W).astype(jnp.float32)[:, None] * inv,
                           (t % GRID_W).astype(jnp.float32)[:, None] * inv], axis=-1)
    return jnp.cos(ang), jnp.sin(ang)


def apply_rope(x, rope):
    if rope is None:
        return x
    cos, sin = rope
    half = x.shape[-1] // 2
    c = cos[:, None, :].astype(x.dtype)
    s = sin[:, None, :].astype(x.dtype)
    x1, x2 = x[..., :half], x[..., half:]
    return jnp.concatenate([x1 * c - x2 * s, x1 * s + x2 * c], axis=-1)


def build_q(pq, P, rope_h, rope_r):
    B, L, _ = pq.shape
    qa, qb, qc, cq = jnp.split(pq, _offsets(Q_SIZES), axis=-1)
    qa = apply_rope(rms(qa.reshape(B, L, A_HEADS, HD), P['a_qn']), rope_h).reshape(B, L, A_KV, A_HEADS // A_KV, HD)
    qb = apply_rope(rms(qb.reshape(B, L, B_HEADS, HD), P['b_qn']), rope_h).reshape(B, L, B_KV, B_HEADS // B_KV, HD)
    qc = apply_rope(rms(qc.reshape(B, L, 2 * C_HEADS, HD), P['c_qn']), rope_h).reshape(B, L, C_HEADS, 2, HD)
    qd = (rms(cq, P['d_q_norm']) @ P['d_w_uq']).reshape(B, L, D_HEADS, QK_NOPE + QK_ROPE)
    qd = jnp.concatenate([rms(qd[..., :QK_NOPE], P['d_qn_nope']),
                          apply_rope(rms(qd[..., QK_NOPE:], P['d_qn_rope']), rope_r)], axis=-1)
    return {'a': qa, 'b': qb, 'c1': qc[:, :, :, 0], 'c2': qc[:, :, :, 1], 'd': qd[:, :, :, None, :]}


def build_kv(pkv, P, rope_h, rope_r):
    B, S, _ = pkv.shape
    ka, va, kb, vb, kc, vc, ckv, kr = jnp.split(pkv, _offsets(KV_SIZES), axis=-1)
    ka = apply_rope(rms(ka.reshape(B, S, A_KV, HD), P['a_kn']), rope_h)
    kb = apply_rope(rms(kb.reshape(B, S, B_KV, HD), P['b_kn']), rope_h)
    kc = apply_rope(rms(kc.reshape(B, S, 2 * C_HEADS, HD), P['c_kn']), rope_h).reshape(B, S, C_HEADS, 2, HD)
    kvd = (rms(ckv, P['d_kv_norm']) @ P['d_w_ukv']).reshape(B, S, D_HEADS, QK_NOPE + V_HEAD)
    kd_rope = apply_rope(rms(kr.reshape(B, S, 1, QK_ROPE), P['d_kn_rope']), rope_r)
    kd = jnp.concatenate([rms(kvd[..., :QK_NOPE], P['d_kn_nope']),
                          jnp.broadcast_to(kd_rope, (B, S, D_HEADS, QK_ROPE))], axis=-1)
    return {'ka': ka, 'va': va.reshape(B, S, A_KV, HD),
            'kb': kb, 'vb': vb.reshape(B, S, B_KV, HD),
            'kc1': kc[:, :, :, 0], 'kc2': kc[:, :, :, 1], 'vc': vc.reshape(B, S, C_HEADS, 2 * HD),
            'kd': kd, 'vd': kvd[..., QK_NOPE:]}


def dense_attn(q, k, v, scale, sink=None):
    B, L, Hk, G, d = q.shape
    nb = L // BLOCK
    qb = jnp.moveaxis(q.reshape(B, nb, BLOCK, Hk, G, d), 1, 0)

    def one(qblk):
        s = jnp.einsum('bqhgd,bkhd->bhgqk', qblk, k, preferred_element_type=jnp.float32) * scale
        if sink is not None:
            s_sink = jnp.broadcast_to(sink.astype(jnp.float32).reshape(1, Hk, G, 1, 1), s.shape[:-1] + (1,))
            p = jax.nn.softmax(jnp.concatenate([s, s_sink], axis=-1), axis=-1)[..., :-1]
        else:
            p = jax.nn.softmax(s, axis=-1)
        return jnp.einsum('bhgqk,bkhd->bqhgd', p.astype(v.dtype), v)

    out = lax.map(one, qb)
    return jnp.moveaxis(out, 0, 1).reshape(B, L, Hk, G, v.shape[-1])


def window_attn(q, k, v, k_ctx, v_ctx, sink, scale):
    B, L, Hk, G, d = q.shape
    nb = L // BLOCK
    pad = ((0, 0), (BLOCK, BLOCK), (0, 0), (0, 0))
    kp = jnp.pad(k, pad).reshape(B, nb + 2, BLOCK, Hk, d)
    vp = jnp.pad(v, pad).reshape(B, nb + 2, BLOCK, Hk, v.shape[-1])
    kw = jnp.concatenate([kp[:, :-2], kp[:, 1:-1], kp[:, 2:]], axis=2)
    vw = jnp.concatenate([vp[:, :-2], vp[:, 1:-1], vp[:, 2:]], axis=2)
    qb = q.reshape(B, nb, BLOCK, Hk, G, d)
    s_loc = jnp.einsum('bnqhgd,bnkhd->bnhgqk', qb, kw, preferred_element_type=jnp.float32) * scale
    qi = jnp.arange(BLOCK)[:, None]
    kj = jnp.arange(3 * BLOCK)[None, :]
    kpos = (jnp.arange(nb)[:, None, None] - 1) * BLOCK + kj
    valid = (kj >= qi + BLOCK - WINDOW) & (kj <= qi + BLOCK + WINDOW) & (kpos >= 0) & (kpos < L)
    s_loc = jnp.where(valid[None, :, None, None], s_loc, NEG_INF)
    s_ctx = jnp.einsum('bnqhgd,bkhd->bnhgqk', qb, k_ctx, preferred_element_type=jnp.float32) * scale
    s_sink = jnp.broadcast_to(sink.astype(jnp.float32).reshape(1, 1, Hk, G, 1, 1), s_loc.shape[:-1] + (1,))
    p = jax.nn.softmax(jnp.concatenate([s_loc, s_ctx, s_sink], axis=-1), axis=-1)
    nl = 3 * BLOCK
    nc = k_ctx.shape[1]
    out = (jnp.einsum('bnhgqk,bnkhd->bnqhgd', p[..., :nl].astype(v.dtype), vw)
           + jnp.einsum('bnhgqk,bkhd->bnqhgd', p[..., nl:nl + nc].astype(v.dtype), v_ctx))
    return out.reshape(B, L, Hk, G, v.shape[-1])


def diff_attn(q1, q2, k1, k2, v, lam, scale):
    B, L, H, d = q1.shape
    nb = L // BLOCK
    qs = jnp.moveaxis(jnp.stack([q1, q2], axis=2).reshape(B, nb, BLOCK, 2, H, d), 1, 0)

    def one(qblk):
        s1 = jnp.einsum('bqhd,bkhd->bhqk', qblk[:, :, 0], k1, preferred_element_type=jnp.float32) * scale
        s2 = jnp.einsum('bqhd,bkhd->bhqk', qblk[:, :, 1], k2, preferred_element_type=jnp.float32) * scale
        p = jax.nn.softmax(s1, axis=-1) - lam * jax.nn.softmax(s2, axis=-1)
        return jnp.einsum('bhqk,bkhe->bqhe', p.astype(v.dtype), v)

    out = lax.map(one, qs)
    return jnp.moveaxis(out, 0, 1).reshape(B, L, H, v.shape[-1])


def run_mixers(q, kv, kv_ctx, P, lam, lam_init):
    sc = 1.0 / math.sqrt(HD)
    if kv is None:
        keys = kv_ctx
        oa = dense_attn(q['a'], keys['ka'], keys['va'], sc, sink=P['a_sink'])
    else:
        oa = window_attn(q['a'], kv['ka'], kv['va'], kv_ctx['ka'], kv_ctx['va'], P['a_sink'], sc)
        keys = {n: jnp.concatenate([kv[n], kv_ctx[n]], axis=1)
                for n in ('kb', 'vb', 'kc1', 'kc2', 'vc', 'kd', 'vd')}
    ob = dense_attn(q['b'], keys['kb'], keys['vb'], sc)
    oc = diff_attn(q['c1'], q['c2'], keys['kc1'], keys['kc2'], keys['vc'], lam, sc)
    oc = rms(oc, P['c_subln']) * (1.0 - lam_init)
    od = dense_attn(q['d'], keys['kd'], keys['vd'], 1.0 / math.sqrt(QK_NOPE + QK_ROPE))
    B, L = oa.shape[0], oa.shape[1]
    return jnp.stack([oa.reshape(B, L, BRANCH_W), ob.reshape(B, L, BRANCH_W),
                      oc.reshape(B, L, BRANCH_W), od.reshape(B, L, BRANCH_W)], axis=2)


def merge(br, pg, P):
    y = jnp.einsum('blnw,nwd->blnd', br, P['w_br'])
    g = jax.nn.sigmoid(pg.reshape(y.shape))
    return jnp.sum(g * y, axis=2) @ P['w_out']


def swiglu(h, wg, wu, wd):
    return (jax.nn.silu(h @ wg) * (h @ wu)) @ wd


def moe_swiglu(h, w_router, w1, w3, w2):
    N, Dm = h.shape
    logits = (h @ w_router).astype(jnp.float32)
    top_v, top_i = lax.top_k(logits, TOP_K)
    wts = jax.nn.softmax(top_v, axis=-1)
    n_assign = N * TOP_K
    e_flat = top_i.reshape(-1)
    tok_flat = jnp.repeat(jnp.arange(N), TOP_K)
    order = jnp.argsort(e_flat)
    e_s, tok_s, w_s = e_flat[order], tok_flat[order], wts.reshape(-1)[order]
    counts = jnp.bincount(e_flat, length=N_EXPERTS)
    starts = jnp.cumsum(counts) - counts
    padded = (counts + MOE_BLOCK - 1) // MOE_BLOCK * MOE_BLOCK
    pstarts = jnp.cumsum(padded) - padded
    pends = pstarts + padded
    dest = pstarts[e_s] + (jnp.arange(n_assign) - starts[e_s])
    n_blocks = -(-n_assign // MOE_BLOCK) + N_EXPERTS
    xbuf = jnp.zeros((n_blocks * MOE_BLOCK, Dm), h.dtype).at[dest].set(h[tok_s])
    blk_e = jnp.minimum(jnp.searchsorted(pends, jnp.arange(n_blocks) * MOE_BLOCK, side='right'), N_EXPERTS - 1)

    def expert_block(args):
        xb, e = args
        return swiglu(xb, w1[e], w3[e], w2[e])

    ybuf = lax.map(expert_block, (xbuf.reshape(n_blocks, MOE_BLOCK, Dm), blk_e))
    y = ybuf.reshape(n_blocks * MOE_BLOCK, Dm)[dest] * w_s[:, None].astype(h.dtype)
    return jnp.zeros_like(h).at[tok_s].add(y)


def setup_inputs(seed: int = 0) -> dict:
    key = jax.random.key(seed)
    ks = jax.random.split(key, 40)
    cnt = [0]

    def nrm(shape, s):
        k = ks[cnt[0]]
        cnt[0] += 1
        return jax.random.normal(k, shape, jnp.float32) * s

    def gain(shape):
        return 1.0 + nrm(shape, 0.02)

    D = D_MODEL
    return {
        'x': nrm((BATCH, SEQ, D), 1.0),
        'c': nrm((BATCH, D), 1.0),
        'ctx': nrm((BATCH, CTX_LEN, D), 1.0),
        'c_ctx': nrm((D,), 1.0),
        'w_mod': nrm((DEPTH, D, 6 * D), 0.5 * D ** -0.5),
        'b_mod': nrm((DEPTH, 6 * D), 0.02),
        'mix_norm': gain((DEPTH, D)),
        'ffn_norm': gain((DEPTH, D)),
        'w_in': nrm((DEPTH, D, IN_COLS), D ** -0.5),
        'a_qn': gain((DEPTH, HD)),
        'a_kn': gain((DEPTH, HD)),
        'a_sink': nrm((DEPTH, A_HEADS), 0.5),
        'b_qn': gain((DEPTH, HD)),
        'b_kn': gain((DEPTH, HD)),
        'c_qn': gain((DEPTH, HD)),
        'c_kn': gain((DEPTH, HD)),
        'c_lq1': nrm((DEPTH, HD), 0.1),
        'c_lk1': nrm((DEPTH, HD), 0.1),
        'c_lq2': nrm((DEPTH, HD), 0.1),
        'c_lk2': nrm((DEPTH, HD), 0.1),
        'c_subln': gain((DEPTH, 2 * HD)),
        'd_q_norm': gain((DEPTH, Q_LORA)),
        'd_kv_norm': gain((DEPTH, KV_LORA)),
        'd_w_uq': nrm((DEPTH, Q_LORA, D_HEADS * (QK_NOPE + QK_ROPE)), Q_LORA ** -0.5),
        'd_w_ukv': nrm((DEPTH, KV_LORA, D_HEADS * (QK_NOPE + V_HEAD)), KV_LORA ** -0.5),
        'd_qn_nope': gain((DEPTH, QK_NOPE)),
        'd_kn_nope': gain((DEPTH, QK_NOPE)),
        'd_qn_rope': gain((DEPTH, QK_ROPE)),
        'd_kn_rope': gain((DEPTH, QK_ROPE)),
        'w_br': nrm((DEPTH, N_BRANCH, BRANCH_W, D), BRANCH_W ** -0.5),
        'w_out': nrm((DEPTH, D, D), D ** -0.5),
        'ff_w_gate': nrm((N_DENSE, D, D_FF), D ** -0.5),
        'ff_w_up': nrm((N_DENSE, D, D_FF), D ** -0.5),
        'ff_w_down': nrm((N_DENSE, D_FF, D), D_FF ** -0.5),
        'moe_router': nrm((N_MOE, D, N_EXPERTS), D ** -0.5),
        'moe_w1': nrm((N_MOE, N_EXPERTS, D, EXPERT_FF), D ** -0.5),
        'moe_w3': nrm((N_MOE, N_EXPERTS, D, EXPERT_FF), D ** -0.5),
        'moe_w2': nrm((N_MOE, N_EXPERTS, EXPERT_FF, D), EXPERT_FF ** -0.5),
    }


def reference(x, c, ctx, c_ctx, w_mod, b_mod, mix_norm, ffn_norm, w_in,
              a_qn, a_kn, a_sink, b_qn, b_kn, c_qn, c_kn, c_lq1, c_lk1, c_lq2, c_lk2, c_subln,
              d_q_norm, d_kv_norm, d_w_uq, d_w_ukv, d_qn_nope, d_kn_nope, d_qn_rope, d_kn_rope,
              w_br, w_out, ff_w_gate, ff_w_up, ff_w_down, moe_router, moe_w1, moe_w3, moe_w2):
    B, L, _ = x.shape
    rows = L // GRID_W
    rope_h = axial_rope(rows, HD)
    rope_r = axial_rope(rows, QK_ROPE)
    lat, cx = x, ctx
    kv_lo, kv_hi = Q_COLS, Q_COLS + KV_COLS
    for l in range(DEPTH):
        last = l == DEPTH - 1
        P = {'a_qn': a_qn[l], 'a_kn': a_kn[l], 'a_sink': a_sink[l], 'b_qn': b_qn[l], 'b_kn': b_kn[l],
             'c_qn': c_qn[l], 'c_kn': c_kn[l], 'c_subln': c_subln[l],
             'd_q_norm': d_q_norm[l], 'd_kv_norm': d_kv_norm[l], 'd_w_uq': d_w_uq[l], 'd_w_ukv': d_w_ukv[l],
             'd_qn_nope': d_qn_nope[l], 'd_kn_nope': d_kn_nope[l], 'd_qn_rope': d_qn_rope[l],
             'd_kn_rope': d_kn_rope[l], 'w_br': w_br[l], 'w_out': w_out[l]}
        lam_init = 0.8 - 0.6 * math.exp(-0.3 * l)
        lam = (jnp.exp(jnp.sum(c_lq1[l].astype(jnp.float32) * c_lk1[l].astype(jnp.float32)))
               - jnp.exp(jnp.sum(c_lq2[l].astype(jnp.float32) * c_lk2[l].astype(jnp.float32))) + lam_init)
        m_lat = [t[:, None, :] for t in modulation(c, w_mod[l], b_mod[l])]
        m_ctx = modulation(c_ctx, w_mod[l], b_mod[l])
        p_lat = adaln(lat, mix_norm[l], m_lat[0], m_lat[1]) @ w_in[l]
        h_ctx = adaln(cx, mix_norm[l], m_ctx[0], m_ctx[1])
        if last:
            p_ctx_kv = h_ctx @ w_in[l][:, kv_lo:kv_hi]
        else:
            p_ctx = h_ctx @ w_in[l]
            p_ctx_kv = p_ctx[..., kv_lo:kv_hi]
        kv_ctx = build_kv(p_ctx_kv, P, None, None)
        kv_lat = build_kv(p_lat[..., kv_lo:kv_hi], P, rope_h, rope_r)
        q_lat = build_q(p_lat[..., :kv_lo], P, rope_h, rope_r)
        br_lat = run_mixers(q_lat, kv_lat, kv_ctx, P, lam, lam_init)
        lat = lat + m_lat[2] * merge(br_lat, p_lat[..., kv_hi:], P)
        if not last:
            q_ctx = build_q(p_ctx[..., :kv_lo], P, None, None)
            br_ctx = run_mixers(q_ctx, None, kv_ctx, P, lam, lam_init)
            cx = cx + m_ctx[2] * merge(br_ctx, p_ctx[..., kv_hi:], P)
        i = l // 2
        if l % 2 == 0:
            ffn = lambda h: swiglu(h, ff_w_gate[i], ff_w_up[i], ff_w_down[i])
        else:
            ffn = lambda h: moe_swiglu(h.reshape(-1, h.shape[-1]), moe_router[i], moe_w1[i],
                                       moe_w3[i], moe_w2[i]).reshape(h.shape)
        lat = lat + m_lat[5] * ffn(adaln(lat, ffn_norm[l], m_lat[3], m_lat[4]))
        if not last:
            cx = cx + m_ctx[5] * ffn(adaln(cx, ffn_norm[l], m_ctx[3], m_ctx[4]))
    return lat
```

```cpp
#include <hip/hip_runtime.h>
#include <hip/hip_cooperative_groups.h>
#include <cstdio>
#include <cstdint>
namespace cg = cooperative_groups;

typedef unsigned short bf16_t;
typedef float f32x4 __attribute__((ext_vector_type(4)));
typedef unsigned u32x4 __attribute__((ext_vector_type(4)));
typedef unsigned u32x2 __attribute__((ext_vector_type(2)));

constexpr int DM = 1024, NBATCH = 8, SEQ = 2048, CTXL = 256;
constexpr int NL = NBATCH * SEQ, NC = NBATCH * CTXL, NT = NL + NC;
constexpr int IN_COLS = 7968;
constexpr int C_QA = 0, C_QB = 512, C_QC = 1024, C_CQ = 1536, C_KA = 2048, C_VA = 2176, C_KB = 2304, C_VB = 2432, C_KC = 2560, C_VC = 3072, C_CKV = 3584, C_KR = 3840;
constexpr int PQW = 4096, PGW = 4096, BRW = 2048;
constexpr int DFF = 2816, EFF = 3584, NEXP = 8;
constexpr int MOE_ROWS = 34816;
constexpr float EPS = 1e-6f;
constexpr float LOG2E = 1.4426950408889634f;
constexpr float QSCALE64 = 0.125f * LOG2E, QSCALE96 = 0.10206207261596577f * LOG2E;
constexpr int NTHREADS = 512;
constexpr int LDS_BYTES = 147456;

constexpr size_t MiB = 1u << 20;
constexpr size_t WS_MOD = 0;
constexpr size_t WS_CNT = 512 * 1024;
constexpr size_t WS_ROUTE_E = 1 * MiB;
constexpr size_t WS_ROUTE_W = WS_ROUTE_E + 64 * 1024;
constexpr size_t WS_POS = WS_ROUTE_W + 128 * 1024;
constexpr size_t WS_ROWMAP = WS_POS + 128 * 1024;
constexpr size_t WS_RQ = 1536 * 1024;
constexpr size_t WS_XN = 4 * MiB;
constexpr size_t WS_BR = 4 * MiB;
constexpr size_t WS_WSMALL = 76 * MiB;
constexpr size_t WS_CX = 140 * MiB;
constexpr size_t WS_PQKV = 148 * MiB;
constexpr size_t WS_MERGED = 148 * MiB;
constexpr size_t WS_PG = 292 * MiB;
constexpr size_t WS_H = 292 * MiB;
constexpr size_t WS_QD = 436 * MiB;
constexpr size_t WS_KVD = 463 * MiB;
constexpr size_t WS_OC1 = 499 * MiB;
constexpr size_t WS_HM = 208 * MiB;
constexpr size_t WS_YM = 446 * MiB;
constexpr size_t WS_NEED = 535 * MiB;

__device__ __forceinline__ float bf2f(unsigned h) { return __uint_as_float(h << 16); }
__device__ __forceinline__ unsigned f2bf(float f) { unsigned u = __float_as_uint(f); return (u + 0x7fffu + ((u >> 16) & 1u)) >> 16; }
typedef float f32x2_t __attribute__((ext_vector_type(2))); typedef __bf16 bf16x2_t __attribute__((ext_vector_type(2)));
__device__ __forceinline__ unsigned pk2(float lo, float hi) { f32x2_t v = {lo, hi}; bf16x2_t b = __builtin_convertvector(v, bf16x2_t); return __builtin_bit_cast(unsigned, b); }
__device__ __forceinline__ float wave_sum(float v) {
#pragma unroll
    for (int o = 1; o < 64; o <<= 1) v += __shfl_xor(v, o);
    return v;
}
__device__ __forceinline__ float sigmoidf_(float x) { return 1.f / (1.f + __expf(-x)); }
__device__ __forceinline__ float siluf_(float x) { return x / (1.f + __expf(-x)); }
__device__ __forceinline__ void unpack8(u32x4 raw, float* dst) {
    dst[0] = bf2f(raw.x & 0xffffu); dst[1] = bf2f(raw.x >> 16); dst[2] = bf2f(raw.y & 0xffffu); dst[3] = bf2f(raw.y >> 16);
    dst[4] = bf2f(raw.z & 0xffffu); dst[5] = bf2f(raw.z >> 16); dst[6] = bf2f(raw.w & 0xffffu); dst[7] = bf2f(raw.w >> 16);
}

struct Params { const float* in[38]; float* out; unsigned char* ws; int ph_lo, ph_hi; };

struct Ctx { const Params& P; float* lds_f; int tid, lane, wave, nblk, blk; };

__device__ __forceinline__ void ph_prologue(const Ctx& C) {
    if (C.blk == 0 && C.tid < 32) ((int*)(C.P.ws + WS_CNT))[C.tid] = 0;
    if (C.blk == 0) for (int i = C.tid; i < 3456; i += NTHREADS) ((unsigned*)(C.P.ws + (2u << 20)))[i] = 0u;
    if (C.blk == 0 && C.wave == 1) {
        for (int l = 0; l < 2; ++l) {
            const float a = wave_sum((C.P.in[16])[l * 64 + C.lane] * (C.P.in[17])[l * 64 + C.lane]);
            const float b = wave_sum((C.P.in[18])[l * 64 + C.lane] * (C.P.in[19])[l * 64 + C.lane]);
            const float lam_init = 0.8f - 0.6f * expf(-0.3f * (float)l);
            if (C.lane == 0) ((float*)(C.P.ws + WS_CNT + 128))[l] = expf(a) - expf(b) + lam_init;
        }
    }
    float* sc = C.lds_f;
    float* red = C.lds_f + 9 * 1024;
    for (int i = C.tid; i < 9 * 1024; i += NTHREADS) { const int row = i >> 10, k = i & 1023; const float v = row < 8 ? (C.P.in[1])[row * 1024 + k] : (C.P.in[3])[k]; sc[i] = v / (1.f + expf(-v)); }
    __syncthreads();
    for (int item = C.blk; item < 384; item += C.nblk) {
        const int l = item / 192, cgp = item % 192, cl32 = C.lane & 31, kpar = C.lane >> 5;
        const float* w = (C.P.in[4]) + (size_t)l * 1024 * 6144 + cgp * 32 + cl32;
        float acc[9];
#pragma unroll
        for (int r = 0; r < 9; ++r) acc[r] = 0.f;
#pragma unroll 16
        for (int i = 0; i < 64; ++i) {
            const int k = C.wave * 128 + 2 * i + kpar; const float wv = w[(size_t)k * 6144];
#pragma unroll
            for (int r = 0; r < 9; ++r) acc[r] += sc[r * 1024 + k] * wv;
        }
#pragma unroll
        for (int r = 0; r < 9; ++r) { acc[r] += __shfl_xor(acc[r], 32); if (kpar == 0) red[(C.wave * 9 + r) * 32 + cl32] = acc[r]; }
        __syncthreads();
        for (int i = C.tid; i < 9 * 32; i += NTHREADS) {
            const int r = i >> 5, cl = i & 31; float sm = 0.f;
#pragma unroll
            for (int w8 = 0; w8 < 8; ++w8) sm += red[(w8 * 9 + r) * 32 + cl];
            ((float*)(C.P.ws + WS_MOD))[(size_t)(l * 9 + r) * 6144 + cgp * 32 + cl] = sm + (C.P.in[5])[l * 6144 + cgp * 32 + cl];
        }
        __syncthreads();
    }
}

__device__ __forceinline__ void ph_adaln(const Ctx& C, int l, int which) {
    const float* g = (which == 0 ? (C.P.in[6]) : (C.P.in[7])) + l * 1024;
    const bool router = (l == 1 && which == 1);
    const int nrows = router ? NL : NT;
    const int gw = C.blk * 8 + C.wave, NGW = C.nblk * 8;
    auto load_row = [&](int r, f32x4 (&v)[4]) {
        const float* src;
        if (l == 0 && which == 0) src = r < NL ? (C.P.in[0]) + (size_t)r * 1024 : (C.P.in[2]) + (size_t)(r - NL) * 1024;
        else src = r < NL ? (C.P.out) + (size_t)r * 1024 : ((float*)(C.P.ws + WS_CX)) + (size_t)(r - NL) * 1024;
#pragma unroll
        for (int j = 0; j < 4; ++j) v[j] = ((const f32x4*)src)[C.lane + 64 * j];
    };
    auto finish_row = [&](int r, const f32x4 (&v)[4]) {
        const int mrow = r < NL ? (r >> 11) : 8;
        const float* mod = ((float*)(C.P.ws + WS_MOD)) + (size_t)(l * 9 + mrow) * 6144;
        const float* shift = mod + (which ? 3 : 0) * 1024; const float* scale = mod + (which ? 4 : 1) * 1024;
        float ss = 0.f;
#pragma unroll
        for (int j = 0; j < 4; ++j) ss += (v[j].x * v[j].x + v[j].y * v[j].y) + (v[j].z * v[j].z + v[j].w * v[j].w);
        ss = wave_sum(ss);
        const float rinv = __builtin_amdgcn_rsqf(ss * (1.f / 1024.f) + EPS);
        float y[16];
#pragma unroll
        for (int j = 0; j < 4; ++j) {
            const f32x4 gg = ((const f32x4*)g)[C.lane + 64 * j], sh = ((const f32x4*)shift)[C.lane + 64 * j], sl = ((const f32x4*)scale)[C.lane + 64 * j];
            y[4 * j + 0] = v[j].x * rinv * gg.x * (1.f + sl.x) + sh.x; y[4 * j + 1] = v[j].y * rinv * gg.y * (1.f + sl.y) + sh.y;
            y[4 * j + 2] = v[j].z * rinv * gg.z * (1.f + sl.z) + sh.z; y[4 * j + 3] = v[j].w * rinv * gg.w * (1.f + sl.w) + sh.w;
            u32x2 o; o.x = pk2(y[4 * j + 0], y[4 * j + 1]); o.y = pk2(y[4 * j + 2], y[4 * j + 3]);
            ((u32x2*)(((bf16_t*)(C.P.ws + WS_XN)) + (size_t)r * 1024))[C.lane + 64 * j] = o;
        }
        if (router) {
            float lg[8];
#pragma unroll
            for (int e = 0; e < 8; ++e) lg[e] = 0.f;
#pragma unroll
            for (int j = 0; j < 4; ++j)
#pragma unroll
                for (int q = 0; q < 4; ++q) {
                    const int k = 4 * C.lane + 256 * j + q;
                    const f32x4 w0 = ((const f32x4*)((C.P.in[34]) + (size_t)k * 8))[0], w1 = ((const f32x4*)((C.P.in[34]) + (size_t)k * 8))[1];
                    const float yy = y[4 * j + q];
                    lg[0] += yy * w0.x; lg[1] += yy * w0.y; lg[2] += yy * w0.z; lg[3] += yy * w0.w; lg[4] += yy * w1.x; lg[5] += yy * w1.y; lg[6] += yy * w1.z; lg[7] += yy * w1.w;
                }
#pragma unroll
            for (int e = 0; e < 8; ++e) lg[e] = wave_sum(lg[e]);
            float b0 = lg[0]; int i0 = 0;
#pragma unroll
            for (int e = 1; e < 8; ++e) if (lg[e] > b0) { b0 = lg[e]; i0 = e; }
            float b1 = -3.0e38f; int i1 = 0;
#pragma unroll
            for (int e = 0; e < 8; ++e) if (e != i0 && lg[e] > b1) { b1 = lg[e]; i1 = e; }
            if (C.lane == 0) {
                const float w0 = 1.f / (1.f + expf(b1 - b0));
                ((int*)(C.P.ws + WS_ROUTE_E))[r] = i0 | (i1 << 8); ((float*)(C.P.ws + WS_ROUTE_W))[2 * r] = w0; ((float*)(C.P.ws + WS_ROUTE_W))[2 * r + 1] = 1.f - w0;
                atomicAdd(&((int*)(C.P.ws + WS_CNT))[i0], 1); atomicAdd(&((int*)(C.P.ws + WS_CNT))[i1], 1);
            }
        }
    };
    if (router) {
        for (int r = gw; r < nrows; r += 2 * NGW) {
            const int r2 = r + NGW; const bool h2 = r2 < nrows;
            f32x4 va[4], vb[4];
            load_row(r, va);
            if (h2) load_row(r2, vb);
            finish_row(r, va);
            if (h2) finish_row(r2, vb);
        }
    } else
    for (int r = gw; r < nrows; r += 4 * NGW) {
        const int r2 = r + NGW, r3 = r + 2 * NGW, r4 = r + 3 * NGW; const bool h2 = r2 < nrows, h3 = r3 < nrows, h4 = r4 < nrows;
        f32x4 va[4], vb[4], vc[4], vd[4];
        load_row(r, va);
        if (h2) load_row(r2, vb);
        if (h3) load_row(r3, vc);
        if (h4) load_row(r4, vd);
        finish_row(r, va);
        if (h2) finish_row(r2, vb);
        if (h3) finish_row(r3, vc);
        if (h4) finish_row(r4, vd);
    }
}

template <class AF, class BF>
__device__ __forceinline__ void ngemm_tile(float* lds_f, int tid, int K, AF af, BF bf, float (&acc)[4][4]) {
    float* As = lds_f;
    float* Bs = lds_f + 128 * 33;
    const int ty = tid >> 4, tx = tid & 15;
#pragma unroll
    for (int i = 0; i < 4; ++i)
#pragma unroll
        for (int j = 0; j < 4; ++j) acc[i][j] = 0.f;
    for (int k0 = 0; k0 < K; k0 += 32) {
        {
            const int i = tid >> 2, kq = (tid & 3) * 8; const bf16_t* ap = af(i, k0 + kq); float t[8];
            if (ap) unpack8(*(const u32x4*)ap, t); else {
#pragma unroll
                for (int q = 0; q < 8; ++q) t[q] = 0.f; }
#pragma unroll
            for (int q = 0; q < 8; ++q) As[i * 33 + kq + q] = t[q];
        }
        {
            const int k = tid >> 4, j = (tid & 15) * 4;
#pragma unroll
            for (int q = 0; q < 4; ++q) Bs[k * 64 + j + q] = bf(k0 + k, j + q);
        }
        __syncthreads();
#pragma unroll 8
        for (int kk = 0; kk < 32; ++kk) {
            float a[4];
#pragma unroll
            for (int i = 0; i < 4; ++i) a[i] = As[(ty * 4 + i) * 33 + kk];
            const f32x4 b = *(const f32x4*)&Bs[kk * 64 + tx * 4];
#pragma unroll
            for (int i = 0; i < 4; ++i) { acc[i][0] += a[i] * b.x; acc[i][1] += a[i] * b.y; acc[i][2] += a[i] * b.z; acc[i][3] += a[i] * b.w; }
        }
        __syncthreads();
    }
}
#define NG_EPI(acc, ...) do { const int ty_ = C.tid >> 4, tx_ = C.tid & 15; auto ef_ = __VA_ARGS__; _Pragma("unroll") for (int i_ = 0; i_ < 4; ++i_) ef_(ty_ * 4 + i_, tx_ * 4, acc[i_]); } while (0)

__device__ __forceinline__ void ph_g1(const Ctx& C, int l) {
    const float* W = (C.P.in[8]) + (size_t)l * 1024 * IN_COLS;
    const int n_lat = (NL / 128) * 128, n_ctx = (NC / 128) * (l == 0 ? 128 : 32);
    for (int it = C.blk; it < n_lat + n_ctx; it += C.nblk) {
        int rt, ct;
        if (it < n_lat) { rt = it >> 7; ct = it & 127; }
        else { const int j = it - n_lat; if (l == 0) { rt = NL / 128 + (j >> 7); ct = j & 127; } else { rt = NL / 128 + (j >> 5); ct = 32 + (j & 31); } }
        const int row0 = rt * 128, col0 = ct * 64;
        float acc[4][4];
        ngemm_tile(C.lds_f, C.tid, 1024,
            [&](int i, int k) { return ((bf16_t*)(C.P.ws + WS_XN)) + (size_t)(row0 + i) * 1024 + k; },
            [&](int k, int j) { const int n = col0 + j; return n < 3872 ? W[(size_t)k * IN_COLS + n] : (n < 4096 ? 0.f : W[(size_t)k * IN_COLS + n - 224]); }, acc);
        NG_EPI(acc, [&](int i, int j0, const float* a) {
                const int n = col0 + j0; u32x2 o;
                if (n < 4096) { o.x = pk2(a[0], a[1]); o.y = pk2(a[2], a[3]); *(u32x2*)(((bf16_t*)(C.P.ws + WS_PQKV)) + (size_t)(row0 + i) * PQW + n) = o; }
                else { o.x = pk2(sigmoidf_(a[0]), sigmoidf_(a[1])); o.y = pk2(sigmoidf_(a[2]), sigmoidf_(a[3])); *(u32x2*)(((bf16_t*)(C.P.ws + WS_PG)) + (size_t)(row0 + i) * PGW + n - 4096) = o; }
            });
    }
}
__device__ __forceinline__ void ph_g2(const Ctx& C, int l) {
    const float* Wq = (C.P.in[23]) + (size_t)l * 512 * 768; const float* gq = (C.P.in[21]) + l * 512;
    const float* Wk = (C.P.in[24]) + (size_t)l * 256 * 1024; const float* gk = (C.P.in[22]) + l * 256;
    const int nq = (NT / 128) * 12, nk = (NT / 128) * 16;
    for (int it = C.blk; it < nq + nk; it += C.nblk) {
        float acc[4][4];
        if (it < nq) {
            const int row0 = (it / 12) * 128, col0 = (it % 12) * 64;
            ngemm_tile(C.lds_f, C.tid, 512,
                [&](int i, int k) { return ((bf16_t*)(C.P.ws + WS_PQKV)) + (size_t)(row0 + i) * PQW + C_CQ + k; },
                [&](int k, int j) { return gq[k] * Wq[(size_t)k * 768 + col0 + j]; }, acc);
            NG_EPI(acc, [&](int i, int j0, const float* a) { u32x2 o; o.x = pk2(a[0], a[1]); o.y = pk2(a[2], a[3]); *(u32x2*)(((bf16_t*)(C.P.ws + WS_QD)) + (size_t)(row0 + i) * 768 + col0 + j0) = o; });
        } else {
            const int j2 = it - nq; const int row0 = (j2 / 16) * 128, col0 = (j2 % 16) * 64;
            ngemm_tile(C.lds_f, C.tid, 256,
                [&](int i, int k) { return ((bf16_t*)(C.P.ws + WS_PQKV)) + (size_t)(row0 + i) * PQW + C_CKV + k; },
                [&](int k, int j) { return gk[k] * Wk[(size_t)k * 1024 + col0 + j]; }, acc);
            NG_EPI(acc, [&](int i, int j0, const float* a) { u32x2 o; o.x = pk2(a[0], a[1]); o.y = pk2(a[2], a[3]); *(u32x2*)(((bf16_t*)(C.P.ws + WS_KVD)) + (size_t)(row0 + i) * 1024 + col0 + j0) = o; });
        }
    }
}

__device__ __forceinline__ float inv_freq(int i, int n) { return exp2f(-(float)i / (float)n * 13.287712379549449f); }
__device__ __forceinline__ float grp16_sum(float v) { v += __shfl_xor(v, 1); v += __shfl_xor(v, 2); v += __shfl_xor(v, 4); v += __shfl_xor(v, 8); return v; }
__device__ __forceinline__ float grp8_sum(float v) { v += __shfl_xor(v, 1); v += __shfl_xor(v, 2); v += __shfl_xor(v, 4); return v; }
__device__ __forceinline__ float rms_inv(float ss, float inv_n) { return __builtin_amdgcn_rsqf(ss * inv_n + EPS); }
__device__ __forceinline__ void ph_post(const Ctx& C, int l, int rep = 0) {
    (void)rep;
    const int gw = C.blk * 8 + C.wave, NGW = C.nblk * 8, lane = C.lane, g = lane >> 4, j = lane & 15, jj = lane & 7, g8 = lane >> 3;
    float fh[2], fr[2];
#pragma unroll
    for (int e = 0; e < 2; ++e) { fh[e] = inv_freq((2 * j + e) & 15, 16); fr[e] = inv_freq((2 * jj + e) & 7, 8); }
    float ga[6][4];
    {
        const float* gp[6] = {C.P.in[9], C.P.in[12], C.P.in[14], C.P.in[10], C.P.in[13], C.P.in[15]};
#pragma unroll
        for (int f = 0; f < 6; ++f) { ga[f][0] = gp[f][l * 64 + 2 * j]; ga[f][1] = gp[f][l * 64 + 2 * j + 1]; ga[f][2] = gp[f][l * 64 + 32 + 2 * j]; ga[f][3] = gp[f][l * 64 + 33 + 2 * j]; }
    }
    const f32x4 g_qn = *(const f32x4*)(C.P.in[25] + l * 64 + 4 * j), g_kn = *(const f32x4*)(C.P.in[26] + l * 64 + 4 * j);
    float g_qr[4], g_kr[4];
    g_qr[0] = (C.P.in[27])[l * 32 + 2 * jj]; g_qr[1] = (C.P.in[27])[l * 32 + 2 * jj + 1]; g_qr[2] = (C.P.in[27])[l * 32 + 16 + 2 * jj]; g_qr[3] = (C.P.in[27])[l * 32 + 17 + 2 * jj];
    g_kr[0] = (C.P.in[28])[l * 32 + 2 * jj]; g_kr[1] = (C.P.in[28])[l * 32 + 2 * jj + 1]; g_kr[2] = (C.P.in[28])[l * 32 + 16 + 2 * jj]; g_kr[3] = (C.P.in[28])[l * 32 + 17 + 2 * jj];
    for (int r = gw; r < NT; r += NGW) {
        const bool lat = r < NL; const int t = r & 2047; const float prow = (float)(t >> 6), pcol = (float)(t & 63);
        float ch[2] = {1.f, 1.f}, sh[2] = {0.f, 0.f}, cr[2] = {1.f, 1.f}, sr[2] = {0.f, 0.f};
        if (lat) {
#pragma unroll
            for (int e = 0; e < 2; ++e) { __sincosf((j < 8 ? prow : pcol) * fh[e], &sh[e], &ch[e]); __sincosf((jj < 4 ? prow : pcol) * fr[e], &sr[e], &cr[e]); }
        }
        bf16_t* pq = ((bf16_t*)(C.P.ws + WS_PQKV)) + (size_t)r * PQW;
        bf16_t* kv = ((bf16_t*)(C.P.ws + WS_KVD)) + (size_t)r * 1024;
        bf16_t* qd = ((bf16_t*)(C.P.ws + WS_QD)) + (size_t)r * 768;
        const bool do_q = lat || l == 0;
        const u32x2 ckv_raw = *(const u32x2*)(pq + C_CKV + lane * 4);
        const u32x4 cq_raw = *(const u32x4*)(pq + C_CQ + lane * 8);
#pragma unroll
        for (int it = 6; it < 9; ++it) {
            const int hh = 4 * it + g;
            const int col = it < 6 ? hh * 64 : (it == 6 ? (g < 2 ? C_KA + g * 64 : C_KB + (g - 2) * 64) : C_KC + (hh - 28) * 64);
            const unsigned w0 = *(const unsigned*)(pq + col + 2 * j), w1 = *(const unsigned*)(pq + col + 32 + 2 * j);
            const float x0 = bf2f(w0 & 0xffffu), x1 = bf2f(w0 >> 16), x2 = bf2f(w1 & 0xffffu), x3 = bf2f(w1 >> 16);
            const float rinv = rms_inv(grp16_sum((x0 * x0 + x1 * x1) + (x2 * x2 + x3 * x3)), 1.f / 64.f);
            float ga0, ga1, ga2, ga3;
            if (it < 6) { ga0 = ga[it >> 1][0]; ga1 = ga[it >> 1][1]; ga2 = ga[it >> 1][2]; ga3 = ga[it >> 1][3]; }
            else if (it == 6) { ga0 = g < 2 ? ga[3][0] : ga[4][0]; ga1 = g < 2 ? ga[3][1] : ga[4][1]; ga2 = g < 2 ? ga[3][2] : ga[4][2]; ga3 = g < 2 ? ga[3][3] : ga[4][3]; }
            else { ga0 = ga[5][0]; ga1 = ga[5][1]; ga2 = ga[5][2]; ga3 = ga[5][3]; }
            const float sc = it < 6 ? QSCALE64 : 1.f;
            const float y0 = x0 * rinv * ga0 * sc, y1 = x1 * rinv * ga1 * sc, y2 = x2 * rinv * ga2 * sc, y3 = x3 * rinv * ga3 * sc;
            *(unsigned*)(pq + col + 2 * j) = pk2(y0 * ch[0] - y2 * sh[0], y1 * ch[1] - y3 * sh[1]);
            *(unsigned*)(pq + col + 32 + 2 * j) = pk2(y0 * sh[0] + y2 * ch[0], y1 * sh[1] + y3 * ch[1]);
        }
        {
            const unsigned w0 = lane < 8 ? *(const unsigned*)(pq + C_KR + 2 * jj) : 0u, w1 = lane < 8 ? *(const unsigned*)(pq + C_KR + 16 + 2 * jj) : 0u;
            const float x0 = bf2f(w0 & 0xffffu), x1 = bf2f(w0 >> 16), x2 = bf2f(w1 & 0xffffu), x3 = bf2f(w1 >> 16);
            const float rinv = rms_inv(grp8_sum((x0 * x0 + x1 * x1) + (x2 * x2 + x3 * x3)), 1.f / 32.f);
            const float y0 = x0 * rinv * g_kr[0], y1 = x1 * rinv * g_kr[1], y2 = x2 * rinv * g_kr[2], y3 = x3 * rinv * g_kr[3];
            if (lane < 8) { *(unsigned*)(pq + C_KR + 2 * jj) = pk2(y0 * cr[0] - y2 * sr[0], y1 * cr[1] - y3 * sr[1]); *(unsigned*)(pq + C_KR + 16 + 2 * jj) = pk2(y0 * sr[0] + y2 * cr[0], y1 * sr[1] + y3 * cr[1]); }
        }
        {
            float t4[4] = {bf2f(ckv_raw.x & 0xffffu), bf2f(ckv_raw.x >> 16), bf2f(ckv_raw.y & 0xffffu), bf2f(ckv_raw.y >> 16)};
            const float rkv = rms_inv(wave_sum((t4[0] * t4[0] + t4[1] * t4[1]) + (t4[2] * t4[2] + t4[3] * t4[3])), 1.f / 256.f);
#pragma unroll
            for (int it = 0; it < 2; ++it) {
                bf16_t* p = kv + (4 * it + g) * 128 + 4 * j;
                const u32x2 w = *(const u32x2*)p;
                const float x0 = rkv * bf2f(w.x & 0xffffu), x1 = rkv * bf2f(w.x >> 16), x2 = rkv * bf2f(w.y & 0xffffu), x3 = rkv * bf2f(w.y >> 16);
                const float rinv = rms_inv(grp16_sum((x0 * x0 + x1 * x1) + (x2 * x2 + x3 * x3)), 1.f / 64.f);
                u32x2 o; o.x = pk2(x0 * rinv * g_kn[0], x1 * rinv * g_kn[1]); o.y = pk2(x2 * rinv * g_kn[2], x3 * rinv * g_kn[3]); *(u32x2*)p = o;
            }
            {
                bf16_t* p = kv + g8 * 128 + 64 + jj * 8;
                float v8[8]; unpack8(*(const u32x4*)p, v8);
                u32x4 o; o.x = pk2(rkv * v8[0], rkv * v8[1]); o.y = pk2(rkv * v8[2], rkv * v8[3]); o.z = pk2(rkv * v8[4], rkv * v8[5]); o.w = pk2(rkv * v8[6], rkv * v8[7]); *(u32x4*)p = o;
            }
        }
        if (do_q) {
            float t8[8]; unpack8(cq_raw, t8);
            float ss = 0.f;
#pragma unroll
            for (int q = 0; q < 8; ++q) ss += t8[q] * t8[q];
            const float rq = rms_inv(wave_sum(ss), 1.f / 512.f);
            if (lane == 0) ((float*)(C.P.ws + WS_RQ))[r] = rq;
        }
    }
}

struct AttnArgs {
    const bf16_t* q; int qpitch; const bf16_t* k1; int k1pitch; const bf16_t* k2; int k2pitch; const bf16_t* v; int vpitch;
    float scale, sink; bool has_sink, windowed, qctx, lat_keys; int b, q0, nq;
};
template <int DQK, int DV>
__device__ __forceinline__ void nattn_core(float* lds_f, int tid, const AttnArgs& a, float (&o)[DV]) {
    float* Ks = lds_f; float* Vs = lds_f + 32 * DQK;
    const int qpos = a.q0 + tid; const bool valid = tid < a.nq;
    const size_t qrow = valid ? (a.qctx ? (size_t)(NL + a.b * CTXL + qpos) : (size_t)(a.b * SEQ + qpos)) : (size_t)0;
    float q[DQK];
    {
        const bf16_t* qp = a.q + qrow * a.qpitch;
#pragma unroll
        for (int d8 = 0; d8 < DQK / 8; ++d8) { float t[8]; unpack8(*(const u32x4*)(qp + d8 * 8), t);
#pragma unroll
            for (int i = 0; i < 8; ++i) q[d8 * 8 + i] = t[i] * a.scale; }
    }
    float m = a.has_sink ? a.sink : -1e30f, ls = a.has_sink ? 1.f : 0.f;
#pragma unroll
    for (int d = 0; d < DV; ++d) o[d] = 0.f;
    auto tile = [&](size_t krow0, int kpos0, bool masked) {
        __syncthreads();
        for (int c = tid; c < 32 * DQK / 8; c += NTHREADS) {
            const int key = c / (DQK / 8), d8 = (c % (DQK / 8)) * 8;
            const bf16_t* src = d8 < 64 ? a.k1 + (krow0 + key) * a.k1pitch + d8 : a.k2 + (krow0 + key) * a.k2pitch + (d8 - 64);
            float t[8]; unpack8(*(const u32x4*)src, t);
#pragma unroll
            for (int i = 0; i < 8; ++i) Ks[key * DQK + d8 + i] = t[i];
        }
        for (int c = tid; c < 32 * DV / 8; c += NTHREADS) {
            const int key = c / (DV / 8), d8 = (c % (DV / 8)) * 8;
            float t[8]; unpack8(*(const u32x4*)(a.v + (krow0 + key) * a.vpitch + d8), t);
#pragma unroll
            for (int i = 0; i < 8; ++i) Vs[key * DV + d8 + i] = t[i];
        }
        __syncthreads();
        for (int j = 0; j < 32; ++j) {
            int dist = qpos - (kpos0 + j); dist = dist < 0 ? -dist : dist;
            const bool ok = valid && (!masked || dist <= 128);
            if (ok) {
                float s = 0.f; const f32x4* kp = (const f32x4*)(Ks + j * DQK);
#pragma unroll
                for (int d4 = 0; d4 < DQK / 4; ++d4) { const f32x4 kv = kp[d4]; s += q[4 * d4] * kv.x + q[4 * d4 + 1] * kv.y + q[4 * d4 + 2] * kv.z + q[4 * d4 + 3] * kv.w; }
                if (s > m) { const float corr = exp2f(m - s); ls *= corr;
#pragma unroll
                    for (int d = 0; d < DV; ++d) o[d] *= corr;
                    m = s; }
                const float p = exp2f(s - m); ls += p; const f32x4* vp = (const f32x4*)(Vs + j * DV);
#pragma unroll
                for (int d4 = 0; d4 < DV / 4; ++d4) { const f32x4 vv = vp[d4]; o[4 * d4] += p * vv.x; o[4 * d4 + 1] += p * vv.y; o[4 * d4 + 2] += p * vv.z; o[4 * d4 + 3] += p * vv.w; }
            }
        }
    };
    if (a.lat_keys) {
        int lo = 0, hi = SEQ;
        if (a.windowed) { lo = a.q0 - 128; lo = lo < 0 ? 0 : lo; lo &= ~31; hi = a.q0 + a.nq + 128; hi = hi > SEQ ? SEQ : hi; }
        for (int kp = lo; kp < hi; kp += 32) tile((size_t)(a.b * SEQ + kp), kp, a.windowed);
    }
    for (int kp = 0; kp < CTXL; kp += 32) tile((size_t)(NL + a.b * CTXL + kp), 0, false);
    const float inv = ls > 0.f ? 1.f / ls : 0.f;
#pragma unroll
    for (int d = 0; d < DV; ++d) o[d] *= inv;
    __syncthreads();
}
__device__ __forceinline__ void store_o64(bf16_t* dst, const float (&o)[64]) {
#pragma unroll
    for (int d8 = 0; d8 < 8; ++d8) { u32x4 w; w.x = pk2(o[d8 * 8], o[d8 * 8 + 1]); w.y = pk2(o[d8 * 8 + 2], o[d8 * 8 + 3]); w.z = pk2(o[d8 * 8 + 4], o[d8 * 8 + 5]); w.w = pk2(o[d8 * 8 + 6], o[d8 * 8 + 7]); *(u32x4*)(dst + d8 * 8) = w; }
}
__device__ __forceinline__ void ph_attn(const Ctx& C, int l) {
    const int n_lat = NBATCH * 4 * 28, n_ctx = (l == 0) ? NBATCH * 28 : 0;
    const float lam = __hip_atomic_load(&((float*)(C.P.ws + WS_CNT + 128))[l], __ATOMIC_RELAXED, __HIP_MEMORY_SCOPE_AGENT);
    const float lam_init = 0.8f - 0.6f * expf(-0.3f * (float)l);
    bf16_t* PQKV = (bf16_t*)(C.P.ws + WS_PQKV); bf16_t* BR = (bf16_t*)(C.P.ws + WS_BR);
    for (int it = C.blk; it < n_lat + n_ctx; it += C.nblk) {
        AttnArgs a; int hitem;
        if (it < n_lat) { hitem = it % 28; const int rest = it / 28; a.b = rest >> 2; a.q0 = (rest & 3) * 512; a.nq = 512; a.qctx = false; a.lat_keys = true; }
        else { const int j = it - n_lat; hitem = j % 28; a.b = j / 28; a.q0 = 0; a.nq = CTXL; a.qctx = true; a.lat_keys = false; }
        a.k2 = nullptr; a.k2pitch = 0; a.has_sink = false; a.sink = 0.f; a.windowed = false; a.scale = 1.0f;
        const bool valid = C.tid < a.nq;
        const size_t orow = valid ? (a.qctx ? (size_t)(NL + a.b * CTXL + a.q0 + C.tid) : (size_t)(a.b * SEQ + a.q0 + C.tid)) : (size_t)0;
        float o[64];
        if (hitem < 16) {
            const bool isA = hitem < 8; const int h = hitem & 7, kvh = h >> 2;
            a.q = PQKV + (isA ? C_QA : C_QB) + h * 64; a.qpitch = PQW;
            a.k1 = PQKV + (isA ? C_KA : C_KB) + kvh * 64; a.k1pitch = PQW;
            a.v = PQKV + (isA ? C_VA : C_VB) + kvh * 64; a.vpitch = PQW;
            if (isA) { a.has_sink = true; a.sink = (C.P.in[11])[l * 8 + h] * LOG2E; a.windowed = !a.qctx; }
            nattn_core<64, 64>(C.lds_f, C.tid, a, o);
            if (valid) store_o64(BR + orow * BRW + (isA ? 0 : 512) + h * 64, o);
        } else if (hitem < 20) {
            const int hc = hitem - 16;
            float* sc1 = (float*)(C.P.ws + WS_OC1) + (orow * 4 + hc) * 128;
            float ss = 0.f;
            for (int part = 0; part < 2; ++part)
                for (int ch = 0; ch < 2; ++ch) {
                    a.q = PQKV + C_QC + (2 * hc + part) * 64; a.qpitch = PQW; a.k1 = PQKV + C_KC + (2 * hc + part) * 64; a.k1pitch = PQW;
                    a.v = PQKV + C_VC + hc * 128 + ch * 64; a.vpitch = PQW;
                    nattn_core<64, 64>(C.lds_f, C.tid, a, o);
                    if (valid) {
                        f32x4* s4 = (f32x4*)(sc1 + ch * 64);
                        if (part == 0) {
#pragma unroll
                            for (int d4 = 0; d4 < 16; ++d4) s4[d4] = (f32x4){o[4 * d4], o[4 * d4 + 1], o[4 * d4 + 2], o[4 * d4 + 3]};
                        } else {
#pragma unroll
                            for (int d4 = 0; d4 < 16; ++d4) { const f32x4 o1 = s4[d4];
                                const f32x4 dl = (f32x4){o1.x - lam * o[4 * d4], o1.y - lam * o[4 * d4 + 1], o1.z - lam * o[4 * d4 + 2], o1.w - lam * o[4 * d4 + 3]};
                                ss += (dl.x * dl.x + dl.y * dl.y) + (dl.z * dl.z + dl.w * dl.w); s4[d4] = dl; }
                        }
                    }
                }
            if (valid) {
                const float rs = (1.0f / sqrtf(ss * (1.f / 128.f) + EPS)) * (1.f - lam_init);
                const float* gn = (C.P.in[20]) + l * 128;
                for (int ch = 0; ch < 2; ++ch) {
#pragma unroll
                    for (int d4 = 0; d4 < 16; ++d4) { const f32x4 dl = ((const f32x4*)(sc1 + ch * 64))[d4]; const f32x4 g4 = ((const f32x4*)(gn + ch * 64))[d4];
                        o[4 * d4] = dl.x * rs * g4.x; o[4 * d4 + 1] = dl.y * rs * g4.y; o[4 * d4 + 2] = dl.z * rs * g4.z; o[4 * d4 + 3] = dl.w * rs * g4.w; }
                    store_o64(BR + orow * BRW + 1024 + hc * 128 + ch * 64, o);
                }
            }
        } else {
            const int h = hitem - 20;
            bf16_t* QD = (bf16_t*)(C.P.ws + WS_QD); bf16_t* KVD = (bf16_t*)(C.P.ws + WS_KVD);
            a.q = QD + h * 96; a.qpitch = 768; a.k1 = KVD + h * 128; a.k1pitch = 1024; a.k2 = PQKV + C_KR; a.k2pitch = PQW; a.v = KVD + h * 128 + 64; a.vpitch = 1024;
            nattn_core<96, 64>(C.lds_f, C.tid, a, o);
            if (valid) store_o64(BR + orow * BRW + 1536 + h * 64, o);
        }
    }
}

__device__ __forceinline__ void ph_g3(const Ctx& C, int l) {
    const int nrt = (l == 0 ? NT : NL) / 128;
    for (int it = C.blk; it < nrt * 16; it += C.nblk) {
        const int row0 = (it >> 4) * 128, col0 = (it & 15) * 64;
        const int ty = C.tid >> 4, tx = C.tid & 15;
        float tot[4][4];
#pragma unroll
        for (int i = 0; i < 4; ++i)
#pragma unroll
            for (int j = 0; j < 4; ++j) tot[i][j] = 0.f;
        for (int n = 0; n < 4; ++n) {
            const float* W = (C.P.in[29]) + (size_t)(l * 4 + n) * 512 * 1024;
            float part[4][4];
            ngemm_tile(C.lds_f, C.tid, 512,
                [&](int i, int k) { return ((bf16_t*)(C.P.ws + WS_BR)) + (size_t)(row0 + i) * BRW + n * 512 + k; },
                [&](int k, int j) { return W[(size_t)k * 1024 + col0 + j]; }, part);
#pragma unroll
            for (int i = 0; i < 4; ++i) {
                const u32x2 g = *(const u32x2*)(((bf16_t*)(C.P.ws + WS_PG)) + (size_t)(row0 + ty * 4 + i) * PGW + n * 1024 + col0 + tx * 4);
                tot[i][0] += bf2f(g.x & 0xffffu) * part[i][0]; tot[i][1] += bf2f(g.x >> 16) * part[i][1]; tot[i][2] += bf2f(g.y & 0xffffu) * part[i][2]; tot[i][3] += bf2f(g.y >> 16) * part[i][3];
            }
        }
#pragma unroll
        for (int i = 0; i < 4; ++i) { u32x2 o; o.x = pk2(tot[i][0], tot[i][1]); o.y = pk2(tot[i][2], tot[i][3]); *(u32x2*)(((bf16_t*)(C.P.ws + WS_MERGED)) + (size_t)(row0 + ty * 4 + i) * 1024 + col0 + tx * 4) = o; }
    }
}
__device__ __forceinline__ void resid_store(const Ctx& C, int l, int mi, bool first, int row, int n, const float* a) {
    const int mrow = row < NL ? (row >> 11) : 8;
    const f32x4 mv = *(const f32x4*)(((float*)(C.P.ws + WS_MOD)) + (size_t)(l * 9 + mrow) * 6144 + mi * 1024 + n);
    float* dst = row < NL ? (C.P.out) + (size_t)row * 1024 + n : ((float*)(C.P.ws + WS_CX)) + (size_t)(row - NL) * 1024 + n;
    const float* base = first ? (row < NL ? (C.P.in[0]) + (size_t)row * 1024 + n : (C.P.in[2]) + (size_t)(row - NL) * 1024 + n) : dst;
    const f32x4 b = *(const f32x4*)base;
    *(f32x4*)dst = (f32x4){b.x + mv.x * a[0], b.y + mv.y * a[1], b.z + mv.z * a[2], b.w + mv.w * a[3]};
}
__device__ __forceinline__ void ph_g4(const Ctx& C, int l) {
    const float* W = (C.P.in[30]) + (size_t)l * 1024 * 1024;
    const int nrt = (l == 0 ? NT : NL) / 128;
    for (int it = C.blk; it < nrt * 16; it += C.nblk) {
        const int row0 = (it >> 4) * 128, col0 = (it & 15) * 64;
        float acc[4][4];
        ngemm_tile(C.lds_f, C.tid, 1024,
            [&](int i, int k) { return ((bf16_t*)(C.P.ws + WS_MERGED)) + (size_t)(row0 + i) * 1024 + k; },
            [&](int k, int j) { return W[(size_t)k * 1024 + col0 + j]; }, acc);
        NG_EPI(acc, [&](int i, int j0, const float* a) { resid_store(C, l, 2, l == 0, row0 + i, col0 + j0, a); });
    }
}
__device__ __forceinline__ void ph_g5(const Ctx& C) {
    for (int it = C.blk; it < (NT / 128) * 88; it += C.nblk) {
        const int row0 = (it / 88) * 128, col0 = (it % 88) * 64;
        float acc[4][4];
        ngemm_tile(C.lds_f, C.tid, 1024,
            [&](int i, int k) { return ((bf16_t*)(C.P.ws + WS_XN)) + (size_t)(row0 + i) * 1024 + k; },
            [&](int k, int j) { const int v = col0 + j; return (v & 1) ? (C.P.in[32])[(size_t)k * DFF + (v >> 1)] : (C.P.in[31])[(size_t)k * DFF + (v >> 1)]; }, acc);
        NG_EPI(acc, [&](int i, int j0, const float* a) { const int jj = (col0 + j0) >> 1; *(unsigned*)(((bf16_t*)(C.P.ws + WS_H)) + (size_t)(row0 + i) * DFF + jj) = pk2(siluf_(a[0]) * a[1], siluf_(a[2]) * a[3]); });
    }
}
__device__ __forceinline__ void ph_g6(const Ctx& C) {
    for (int it = C.blk; it < (NT / 128) * 16; it += C.nblk) {
        const int row0 = (it >> 4) * 128, col0 = (it & 15) * 64;
        float acc[4][4];
        ngemm_tile(C.lds_f, C.tid, DFF,
            [&](int i, int k) { return ((bf16_t*)(C.P.ws + WS_H)) + (size_t)(row0 + i) * DFF + k; },
            [&](int k, int j) { return (C.P.in[33])[(size_t)k * 1024 + col0 + j]; }, acc);
        NG_EPI(acc, [&](int i, int j0, const float* a) { resid_store(C, 0, 5, false, row0 + i, col0 + j0, a); });
    }
}

__device__ __forceinline__ void moe_starts(const Ctx& C, int (&cnt)[8], int (&ps)[9]) {
    ps[0] = 0;
#pragma unroll
    for (int e = 0; e < 8; ++e) { cnt[e] = __hip_atomic_load(&((int*)(C.P.ws + WS_CNT))[e], __ATOMIC_RELAXED, __HIP_MEMORY_SCOPE_AGENT); ps[e + 1] = ps[e] + ((cnt[e] + 255) & ~255); }
}
__device__ __forceinline__ void ph_assign(const Ctx& C) {
    int cnt[8], ps[9]; moe_starts(C, cnt, ps);
    const int gw = C.blk * 8 + C.wave, NGW = C.nblk * 8;
    for (int t0 = gw * 64; t0 < NL; t0 += NGW * 64) {
        const int tok = t0 + C.lane; const int ee = ((int*)(C.P.ws + WS_ROUTE_E))[tok];
#pragma unroll
        for (int k = 0; k < 2; ++k) {
            const int my = (ee >> (8 * k)) & 0xff; int pos = 0;
#pragma unroll
            for (int e = 0; e < 8; ++e) {
                const unsigned long long mask = __ballot(my == e);
                if (mask) {
                    int base = 0; const int leader = __ffsll((long long)mask) - 1;
                    if (C.lane == leader) base = atomicAdd(&((int*)(C.P.ws + WS_CNT))[16 + e], (int)__popcll(mask));
                    base = __shfl(base, leader);
                    if (my == e) pos = ps[e] + base + (int)__popcll(mask & ((1ull << C.lane) - 1ull));
                }
            }
            ((int*)(C.P.ws + WS_ROWMAP))[pos] = tok; ((int*)(C.P.ws + WS_POS))[2 * tok + k] = pos;
        }
    }
    if (C.blk == 0) {
#pragma unroll
        for (int e = 0; e < 8; ++e) for (int i = cnt[e] + C.tid; i < ps[e + 1] - ps[e]; i += NTHREADS) ((int*)(C.P.ws + WS_ROWMAP))[ps[e] + i] = -1;
    }
}
__device__ __forceinline__ int moe_expert_of(const int (&ps)[9], int p0) {
    int e = 0;
#pragma unroll
    for (int q = 1; q < 8; ++q) if (p0 >= ps[q]) e = q;
    return e;
}
__device__ __forceinline__ void ph_g7(const Ctx& C) {
    int cnt[8], ps[9]; moe_starts(C, cnt, ps);
    const int nrt = ps[8] / 128;
    for (int it = C.blk; it < nrt * 112; it += C.nblk) {
        const int p0 = (it / 112) * 128, col0 = (it % 112) * 64;
        const int e = moe_expert_of(ps, p0);
        int cnt_e = 0;
#pragma unroll
        for (int q = 0; q < 8; ++q) if (q == e) cnt_e = cnt[q];
        int ps_e = 0;
#pragma unroll
        for (int q = 0; q < 8; ++q) if (q == e) ps_e = ps[q];
        if (p0 >= ps_e + cnt_e) continue;
        const float* W1 = (C.P.in[35]) + (size_t)e * 1024 * EFF; const float* W3 = (C.P.in[36]) + (size_t)e * 1024 * EFF;
        float acc[4][4];
        ngemm_tile(C.lds_f, C.tid, 1024,
            [&](int i, int k) { const int tok = ((int*)(C.P.ws + WS_ROWMAP))[p0 + i]; return tok < 0 ? (const bf16_t*)nullptr : ((bf16_t*)(C.P.ws + WS_XN)) + (size_t)tok * 1024 + k; },
            [&](int k, int j) { const int v = col0 + j; return (v & 1) ? W3[(size_t)k * EFF + (v >> 1)] : W1[(size_t)k * EFF + (v >> 1)]; }, acc);
        NG_EPI(acc, [&](int i, int j0, const float* a) { const int jj = (col0 + j0) >> 1; *(unsigned*)(((bf16_t*)(C.P.ws + WS_HM)) + (size_t)(p0 + i) * EFF + jj) = pk2(siluf_(a[0]) * a[1], siluf_(a[2]) * a[3]); });
    }
}
__device__ __forceinline__ void ph_g8(const Ctx& C) {
    int cnt[8], ps[9]; moe_starts(C, cnt, ps);
    const int nrt = ps[8] / 128;
    for (int it = C.blk; it < nrt * 16; it += C.nblk) {
        const int p0 = (it >> 4) * 128, col0 = (it & 15) * 64;
        const int e = moe_expert_of(ps, p0);
        int cnt_e = 0, ps_e = 0;
#pragma unroll
        for (int q = 0; q < 8; ++q) if (q == e) { cnt_e = cnt[q]; ps_e = ps[q]; }
        if (p0 >= ps_e + cnt_e) continue;
        const float* W2 = (C.P.in[37]) + (size_t)e * EFF * 1024;
        float acc[4][4];
        ngemm_tile(C.lds_f, C.tid, EFF,
            [&](int i, int k) { return ((bf16_t*)(C.P.ws + WS_HM)) + (size_t)(p0 + i) * EFF + k; },
            [&](int k, int j) { return W2[(size_t)k * 1024 + col0 + j]; }, acc);
        NG_EPI(acc, [&](int i, int j0, const float* a) { u32x2 o; o.x = pk2(a[0], a[1]); o.y = pk2(a[2], a[3]); *(u32x2*)(((bf16_t*)(C.P.ws + WS_YM)) + (size_t)(p0 + i) * 1024 + col0 + j0) = o; });
    }
}
__device__ __forceinline__ void ph_combine(const Ctx& C) {
    const int gw = C.blk * 8 + C.wave, NGW = C.nblk * 8;
    for (int r = gw; r < NL; r += NGW) {
        const int p0 = ((int*)(C.P.ws + WS_POS))[2 * r], p1 = ((int*)(C.P.ws + WS_POS))[2 * r + 1]; const float w0 = ((float*)(C.P.ws + WS_ROUTE_W))[2 * r], w1 = ((float*)(C.P.ws + WS_ROUTE_W))[2 * r + 1];
        const float* m5 = ((float*)(C.P.ws + WS_MOD)) + (size_t)(9 + (r >> 11)) * 6144 + 5 * 1024;
#pragma unroll
        for (int j = 0; j < 4; ++j) {
            const int c4 = C.lane + 64 * j;
            const u32x2 a = ((const u32x2*)(((bf16_t*)(C.P.ws + WS_YM)) + (size_t)p0 * 1024))[c4], b = ((const u32x2*)(((bf16_t*)(C.P.ws + WS_YM)) + (size_t)p1 * 1024))[c4];
            const f32x4 mv = ((const f32x4*)m5)[c4]; f32x4 o = ((const f32x4*)((C.P.out) + (size_t)r * 1024))[c4];
            o.x += mv.x * (w0 * bf2f(a.x & 0xffffu) + w1 * bf2f(b.x & 0xffffu)); o.y += mv.y * (w0 * bf2f(a.x >> 16) + w1 * bf2f(b.x >> 16));
            o.z += mv.z * (w0 * bf2f(a.y & 0xffffu) + w1 * bf2f(b.y & 0xffffu)); o.w += mv.w * (w0 * bf2f(a.y >> 16) + w1 * bf2f(b.y >> 16));
            ((f32x4*)((C.P.out) + (size_t)r * 1024))[c4] = o;
        }
    }
}

#define LAS __attribute__((address_space(3)))
typedef short bf16x8 __attribute__((ext_vector_type(8)));
constexpr int BM = 256, BK = 64, HALF = 128, HTB = HALF * BK * 2, NXCD = 8, WGM = 8;
__device__ __forceinline__ int lds_byte(int r, int c) { const int st = (r >> 4) * 2 + (c >> 5), rr = r & 15, cc = c & 31, ob = rr * 64 + cc * 2; return st * 1024 + (ob ^ (((ob >> 9) & 1) << 5)); }
__device__ __forceinline__ void stage_rc(int b, int& R, int& C) { const int st = b / 1024, sb = b % 1024, swz = sb ^ (((sb >> 9) & 1) << 5); R = (st >> 1) * 16 + swz / 64; C = (st & 1) * 32 + (swz % 64) / 2; }
__device__ __forceinline__ int perm32(int rho) { const int n = rho >> 4, i = rho & 15; return 8 * (i >> 2) + 4 * n + (i & 3); }
__device__ __forceinline__ unsigned cvt_pk_bf16(float lo, float hi) { f32x2_t v = {lo, hi}; bf16x2_t b = __builtin_convertvector(v, bf16x2_t); return __builtin_bit_cast(unsigned, b); }

struct GUnit { const char* A; const char* B; int pm, pn, aux; };
__device__ __forceinline__ bool static_order(int nM, int nN, int G, int c, int i, int& pm, int& pn) {
    const int nwg = nM * nN; const long L = (long)i * G + c; if (L >= nwg) return false;
    int wgid = (int)L; { const int q = nwg / NXCD, r = nwg % NXCD, xcd = wgid % NXCD, off = wgid / NXCD; wgid = (xcd < r ? xcd * (q + 1) : r * (q + 1) + (xcd - r) * q) + off; }
    const int nig = WGM * nN, gid = wgid / nig, fm = gid * WGM, gsz = (nM - fm) < WGM ? (nM - fm) : WGM;
    pm = fm + ((wgid % nig) % gsz); pn = (wgid % nig) / gsz; return true;
}

typedef f32x4 Acc[2][2][4][2];
template <bool PERM, bool GATHER, bool HALFN, class Sched, class Epi>
__device__ __forceinline__ void gemm_phase_t(LAS unsigned char* lds, const int K, const int lda, const Sched& S, Epi& E) {
    const int tid = threadIdx.x, wid = __builtin_amdgcn_readfirstlane(tid >> 6), lane = tid & 63, wr = wid >> 2, wc = wid & 3, fr = lane & 15, fq = lane >> 4;
    const int nt = K / BK;
    unsigned voffB[2]; int RA[2], CA[2];
#pragma unroll
    for (int i = 0; i < 2; ++i) { int R, C; stage_rc(tid * 16 + i * 8192, R, C); const int Rb = PERM ? ((R & ~31) + perm32(R & 31)) : R; voffB[i] = (unsigned)(Rb * K + C) * 2u; RA[i] = R; CA[i] = C; }
    const size_t kstep = (size_t)(BK * 2);
    const size_t hstepB = (size_t)HALF * K * 2;
    const unsigned ldsw = (unsigned)wid * 1024u;
    const int aoff = lds_byte(wr * 64 + fr, fq * 8), boff = lds_byte(wc * 32 + fr, fq * 8);
#define PG8_SA(b, h) (((b) * 2 + (h)) * HTB)
#define PG8_SB(b, h) ((4 + (b) * 2 + (h)) * HTB)
#define PG8_STAGE(bufoff, gbase, voff) do { _Pragma("unroll") for (int _i = 0; _i < 2; ++_i) \
        __builtin_amdgcn_global_load_lds((const unsigned*)((const char*)(gbase) + (voff)[_i]), (LAS unsigned*)(lds + (bufoff) + ldsw + _i * 8192), 16, 0, 0); } while (0)
#define PG8_LDA(dst, b, h) do { _Pragma("unroll") for (int m = 0; m < 4; ++m) _Pragma("unroll") for (int k = 0; k < 2; ++k) dst[m][k] = *(const LAS bf16x8*)(lds + PG8_SA(b, h) + aoff + m * 2048 + k * 1024); } while (0)
#define PG8_LDB(dst, b, h) do { _Pragma("unroll") for (int n = 0; n < 2; ++n) _Pragma("unroll") for (int k = 0; k < 2; ++k) dst[n][k] = *(const LAS bf16x8*)(lds + PG8_SB(b, h) + boff + n * 2048 + k * 1024); } while (0)
#define PG8_MMA(ai, bj, At, Bt) do { __builtin_amdgcn_s_setprio(1); _Pragma("unroll") for (int m = 0; m < 4; ++m) _Pragma("unroll") for (int n = 0; n < 2; ++n) _Pragma("unroll") for (int k = 0; k < 2; ++k) \
        acc[ai][bj][m][n] = __builtin_amdgcn_mfma_f32_16x16x32_bf16(Bt[n][k], At[m][k], acc[ai][bj][m][n], 0, 0, 0); __builtin_amdgcn_s_setprio(0); } while (0)
#define PG8_WAIT_V(n) asm volatile("s_waitcnt vmcnt(" #n ")" ::: "memory")
#define PG8_WAIT_L(n) asm volatile("s_waitcnt lgkmcnt(" #n ")" ::: "memory")
#define PG8_BAR __builtin_amdgcn_s_barrier()
#define PG8_SCHED __builtin_amdgcn_sched_barrier(0)
#define PG8_OFFA(u, o) do { _Pragma("unroll") for (int h_ = 0; h_ < 2; ++h_) _Pragma("unroll") for (int i_ = 0; i_ < 2; ++i_) { const int row_ = h_ * HALF + RA[i_]; \
        if constexpr (GATHER) o[h_][i_] = S.row_off(u, row_) + (unsigned)CA[i_] * 2u; else o[h_][i_] = (unsigned)(row_ * lda + CA[i_]) * 2u; } } while (0)
    GUnit cur, nxt; int ui = 0;
    if (!S.next(0, cur)) return;
    Acc acc;
#pragma unroll
    for (int a = 0; a < 2; ++a)
#pragma unroll
        for (int b = 0; b < 2; ++b)
#pragma unroll
            for (int m = 0; m < 4; ++m)
#pragma unroll
                for (int n = 0; n < 2; ++n) acc[a][b][m][n] = (f32x4){0.f, 0.f, 0.f, 0.f};
    bf16x8 At[4][2], B0[2][2], B1[2][2];
    unsigned oc[2][2], on[2][2];
    PG8_OFFA(cur, oc);
#pragma unroll
    for (int h = 0; h < 2; ++h)
#pragma unroll
        for (int i = 0; i < 2; ++i) on[h][i] = oc[h][i];
    const char* cA = cur.A; const char* cB = cur.B;
    if constexpr (HALFN) {
        PG8_STAGE(PG8_SB(0, 0), cB, voffB); PG8_STAGE(PG8_SA(0, 0), cA, oc[0]); PG8_STAGE(PG8_SA(0, 1), cA, oc[1]);
        if (wr == 1) PG8_BAR;
        PG8_WAIT_V(2); PG8_BAR;
        PG8_STAGE(PG8_SB(1, 0), cB + kstep, voffB); PG8_STAGE(PG8_SA(1, 0), cA + kstep, oc[0]);
        PG8_WAIT_V(4); PG8_BAR;
    } else {
    PG8_STAGE(PG8_SB(0, 0), cB, voffB); PG8_STAGE(PG8_SB(0, 1), cB + hstepB, voffB); PG8_STAGE(PG8_SA(0, 0), cA, oc[0]); PG8_STAGE(PG8_SA(0, 1), cA, oc[1]);
    if (wr == 1) PG8_BAR;
    PG8_WAIT_V(2); PG8_BAR;
    PG8_STAGE(PG8_SB(1, 0), cB + kstep, voffB); PG8_STAGE(PG8_SA(1, 0), cA + kstep, oc[0]); PG8_STAGE(PG8_SB(1, 1), cB + hstepB + kstep, voffB);
    PG8_WAIT_V(6); PG8_BAR;
    }
    for (;;) {
        const bool has_next = S.next(ui + 1, nxt);
        const char* nA = has_next ? nxt.A : cA; const char* nB = has_next ? nxt.B : cB;
        if constexpr (GATHER) { if (has_next) PG8_OFFA(nxt, on); }
        for (int t = 0; t < nt; t += 2) {
            const bool last = (t == nt - 2);
            const char* a1 = cA + (size_t)(t + 1) * kstep;
            const char* a2 = last ? nA : cA + (size_t)(t + 2) * kstep; const char* b2 = last ? nB : cB + (size_t)(t + 2) * kstep;
            const char* a3 = a2 + kstep; const char* b3 = b2 + kstep;
            unsigned o2[2][2];
#pragma unroll
            for (int h = 0; h < 2; ++h)
#pragma unroll
                for (int i = 0; i < 2; ++i) { if constexpr (GATHER) o2[h][i] = last ? on[h][i] : oc[h][i]; else o2[h][i] = oc[h][i]; }
            if constexpr (HALFN) {
            PG8_LDB(B0, 0, 0); PG8_SCHED; PG8_LDA(At, 0, 0); PG8_STAGE(PG8_SA(1, 1), a1, oc[1]);
            PG8_WAIT_V(6); PG8_WAIT_L(0); PG8_BAR; PG8_MMA(0, 0, At, B0); PG8_BAR; PG8_SCHED;
            PG8_LDA(At, 0, 1); PG8_STAGE(PG8_SB(0, 0), b2, voffB); PG8_STAGE(PG8_SA(0, 0), a2, o2[0]);
            PG8_WAIT_V(6); PG8_WAIT_L(0); PG8_BAR; PG8_MMA(1, 0, At, B0); PG8_BAR; PG8_SCHED;
            PG8_LDB(B0, 1, 0); PG8_SCHED; PG8_LDA(At, 1, 0); PG8_STAGE(PG8_SA(0, 1), a2, o2[1]);
            PG8_WAIT_V(6); PG8_WAIT_L(0); PG8_BAR; PG8_MMA(0, 0, At, B0); PG8_BAR; PG8_SCHED;
            PG8_LDA(At, 1, 1); PG8_STAGE(PG8_SB(1, 0), b3, voffB); PG8_STAGE(PG8_SA(1, 0), a3, o2[0]);
            PG8_WAIT_V(6); PG8_WAIT_L(0); PG8_BAR; PG8_MMA(1, 0, At, B0); PG8_BAR; PG8_SCHED;
            } else {
            PG8_LDB(B0, 0, 0); PG8_LDB(B1, 0, 1); PG8_SCHED; PG8_LDA(At, 0, 0); PG8_STAGE(PG8_SA(1, 1), a1, oc[1]);
            PG8_WAIT_V(8); PG8_WAIT_L(0); PG8_BAR; PG8_MMA(0, 0, At, B0); PG8_MMA(0, 1, At, B1); PG8_BAR; PG8_SCHED;
            PG8_LDA(At, 0, 1); PG8_STAGE(PG8_SB(0, 0), b2, voffB); PG8_STAGE(PG8_SB(0, 1), b2 + hstepB, voffB); PG8_STAGE(PG8_SA(0, 0), a2, o2[0]);
            PG8_WAIT_V(8); PG8_WAIT_L(0); PG8_BAR; PG8_MMA(1, 0, At, B0); PG8_MMA(1, 1, At, B1); PG8_BAR; PG8_SCHED;
            PG8_LDB(B0, 1, 0); PG8_LDB(B1, 1, 1); PG8_SCHED; PG8_LDA(At, 1, 0); PG8_STAGE(PG8_SA(0, 1), a2, o2[1]);
            PG8_WAIT_V(8); PG8_WAIT_L(0); PG8_BAR; PG8_MMA(0, 0, At, B0); PG8_MMA(0, 1, At, B1); PG8_BAR; PG8_SCHED;
            PG8_LDA(At, 1, 1); PG8_STAGE(PG8_SB(1, 0), b3, voffB); PG8_STAGE(PG8_SB(1, 1), b3 + hstepB, voffB); PG8_STAGE(PG8_SA(1, 0), a3, o2[0]);
            PG8_WAIT_V(8); PG8_WAIT_L(0); PG8_BAR; PG8_MMA(1, 0, At, B0); PG8_MMA(1, 1, At, B1); PG8_BAR; PG8_SCHED;
            }
        }
        if (wr == 0) PG8_BAR;
        E(acc, cur, wr, wc, fr, fq);
        if (!has_next) break;
#pragma unroll
        for (int a = 0; a < 2; ++a)
#pragma unroll
            for (int b = 0; b < 2; ++b)
#pragma unroll
                for (int m = 0; m < 4; ++m)
#pragma unroll
                    for (int n = 0; n < 2; ++n) acc[a][b][m][n] = (f32x4){0.f, 0.f, 0.f, 0.f};
        cur = nxt; cA = nA; cB = nB; ++ui;
        if constexpr (GATHER) {
#pragma unroll
            for (int h = 0; h < 2; ++h)
#pragma unroll
                for (int i = 0; i < 2; ++i) oc[h][i] = on[h][i];
        }
        if (wr == 1) PG8_BAR;
    }
    PG8_WAIT_V(0);
    PG8_BAR;
#undef PG8_SA
#undef PG8_SB
#undef PG8_STAGE
#undef PG8_LDA
#undef PG8_LDB
#undef PG8_MMA
#undef PG8_WAIT_V
#undef PG8_WAIT_L
#undef PG8_BAR
#undef PG8_SCHED
#undef PG8_OFFA
}

template <bool PERM, bool GATHER, class Sched, class Epi>
__device__ __forceinline__ void gemm_phase(LAS unsigned char* lds, const int K, const int lda, const Sched& S, const Epi& E) { Epi E2 = E; gemm_phase_t<PERM, GATHER, false>(lds, K, lda, S, E2); }

__device__ __forceinline__ u32x4 pack8(const f32x4 v0, const f32x4 v1) { u32x4 w; w.x = cvt_pk_bf16(v0[0], v0[1]); w.y = cvt_pk_bf16(v0[2], v0[3]); w.z = cvt_pk_bf16(v1[0], v1[1]); w.w = cvt_pk_bf16(v1[2], v1[3]); return w; }
__device__ __forceinline__ float fsig(float x) { return __builtin_amdgcn_rcpf(1.f + __builtin_amdgcn_exp2f(-LOG2E * x)); }
__device__ __forceinline__ f32x4 sig4(f32x4 v) { return (f32x4){fsig(v[0]), fsig(v[1]), fsig(v[2]), fsig(v[3])}; }
__device__ __forceinline__ void epi_store_bf16(const Acc& acc, bf16_t* O, int ldc, int row0, int col0, bool sig, int wr, int wc, int fr, int fq) {
#pragma unroll
    for (int ai = 0; ai < 2; ++ai)
#pragma unroll
        for (int m = 0; m < 4; ++m) { bf16_t* rowp = O + (size_t)(row0 + ai * HALF + wr * 64 + m * 16 + fr) * ldc + col0 + wc * 32 + 8 * fq;
#pragma unroll
            for (int bj = 0; bj < 2; ++bj) { f32x4 v0 = acc[ai][bj][m][0], v1 = acc[ai][bj][m][1]; if (sig) { v0 = sig4(v0); v1 = sig4(v1); } *(u32x4*)(rowp + bj * HALF) = pack8(v0, v1); } }
}

template <class RM>
__device__ __forceinline__ void transpose_item(const float* W, int K, int N, bf16_t* WT, RM rowmap, const float* ksc, float* scr, int item, int lane) {
    const int nblk = N / 32, kb = item / nblk, nb = item % nblk, k0 = 64 * kb, n0 = 32 * nb;
    float tv[32];
#pragma unroll
    for (int i = 0; i < 32; ++i) tv[i] = W[(size_t)(k0 + 2 * i + (lane >> 5)) * N + n0 + (lane & 31)];
    if (ksc) {
#pragma unroll
        for (int i = 0; i < 32; ++i) tv[i] *= ksc[k0 + 2 * i + (lane >> 5)];
    }
#pragma unroll
    for (int i = 0; i < 32; ++i) scr[(2 * i + (lane >> 5)) * 33 + (lane & 31)] = tv[i];
    asm volatile("s_waitcnt lgkmcnt(0)" ::: "memory");
    const int c = lane & 7;
#pragma unroll
    for (int j = 0; j < 4; ++j) { const int n = (lane >> 3) + 8 * j; const float* s = scr + (8 * c) * 33 + n;
        u32x4 o; o.x = pk2(s[0 * 33], s[1 * 33]); o.y = pk2(s[2 * 33], s[3 * 33]); o.z = pk2(s[4 * 33], s[5 * 33]); o.w = pk2(s[6 * 33], s[7 * 33]);
        *(u32x4*)(WT + (size_t)rowmap(n0 + n) * K + k0 + 8 * c) = o; }
    asm volatile("s_waitcnt lgkmcnt(0)" ::: "memory");
}

constexpr size_t WS_WIN_T = 76 * MiB;
constexpr size_t WS_WBR_T = 108 * MiB;
constexpr size_t WS_WOUT_T = 116 * MiB;
constexpr size_t WS_WUQ_T = 120 * MiB;
constexpr size_t WS_WUKV_T = 122 * MiB;
constexpr size_t WS_FFGU_T = 123 * MiB;
constexpr size_t WS_FFD_T = 134 * MiB;
constexpr size_t WS_MACC = 184 * MiB;
constexpr size_t WS_W13_T = 40 * MiB;
constexpr size_t WS_W2_T = 152 * MiB;
constexpr int CONV_LDS_OFF = 65536;

template <class RM>
__device__ __forceinline__ void transpose_item64(const float* W, int K, int N, bf16_t* WT, RM rowmap, float* scr, int item, int lane) {
    const int nblk = N / 64, kb = item / nblk, nb = item % nblk, k0 = 64 * kb, n0 = 64 * nb;
#pragma unroll
    for (int h = 0; h < 2; ++h) {
        float tv[32];
#pragma unroll
        for (int i = 0; i < 32; ++i) tv[i] = W[(size_t)(k0 + 32 * h + i) * N + n0 + lane];
#pragma unroll
        for (int i = 0; i < 32; ++i) scr[(32 * h + i) * 65 + lane] = tv[i];
    }
    asm volatile("s_waitcnt lgkmcnt(0)" ::: "memory");
    const int c = lane & 7;
#pragma unroll
    for (int j = 0; j < 8; ++j) { const int n = (lane >> 3) + 8 * j; const float* sp = scr + (8 * c) * 65 + n;
        u32x4 o; o.x = pk2(sp[0 * 65], sp[1 * 65]); o.y = pk2(sp[2 * 65], sp[3 * 65]); o.z = pk2(sp[4 * 65], sp[5 * 65]); o.w = pk2(sp[6 * 65], sp[7 * 65]);
        *(u32x4*)(WT + (size_t)rowmap(n0 + n) * K + k0 + 8 * c) = o; }
    asm volatile("s_waitcnt lgkmcnt(0)" ::: "memory");
}

struct ConvJob { const float* W; bf16_t* WT; const float* ksc; int K, N, kind, nitems; };
__device__ __forceinline__ int conv_rowmap(int kind, int n) {
    return kind == 0 ? n : (kind == 1 ? (n < 3872 ? n : n + 224) : ((n >> 7) * 256 + (n & 127) + (kind == 3 ? 128 : 0)));
}
__device__ __forceinline__ ConvJob conv_job_small(const Ctx& C, int j) {
    ConvJob J; J.ksc = nullptr; J.kind = 0;
    if (j < 2) { J.W = C.P.in[8] + (size_t)j * 1024 * IN_COLS; J.WT = (bf16_t*)(C.P.ws + WS_WIN_T) + (size_t)j * 8192 * 1024; J.K = 1024; J.N = IN_COLS; J.kind = 1; }
    else if (j < 4) { const int l = j - 2; J.W = C.P.in[23] + (size_t)l * 512 * 768; J.WT = (bf16_t*)(C.P.ws + WS_WUQ_T) + (size_t)l * 768 * 512; J.K = 512; J.N = 768; J.ksc = C.P.in[21] + l * 512; }
    else if (j < 6) { const int l = j - 4; J.W = C.P.in[24] + (size_t)l * 256 * 1024; J.WT = (bf16_t*)(C.P.ws + WS_WUKV_T) + (size_t)l * 1024 * 256; J.K = 256; J.N = 1024; J.ksc = C.P.in[22] + l * 256; }
    else if (j < 14) { const int q = j - 6; J.W = C.P.in[29] + (size_t)q * 512 * 1024; J.WT = (bf16_t*)(C.P.ws + WS_WBR_T) + (size_t)q * 1024 * 512; J.K = 512; J.N = 1024; }
    else if (j < 16) { const int l = j - 14; J.W = C.P.in[30] + (size_t)l * 1024 * 1024; J.WT = (bf16_t*)(C.P.ws + WS_WOUT_T) + (size_t)l * 1024 * 1024; J.K = 1024; J.N = 1024; }
    else if (j == 16) { J.W = C.P.in[31]; J.WT = (bf16_t*)(C.P.ws + WS_FFGU_T); J.K = 1024; J.N = DFF; J.kind = 2; }
    else if (j == 17) { J.W = C.P.in[32]; J.WT = (bf16_t*)(C.P.ws + WS_FFGU_T); J.K = 1024; J.N = DFF; J.kind = 3; }
    else { J.W = C.P.in[33]; J.WT = (bf16_t*)(C.P.ws + WS_FFD_T); J.K = DFF; J.N = 1024; }
    J.nitems = (J.K / 64) * (J.N / 32);
    return J;
}
__device__ __forceinline__ ConvJob conv_job_moe(const Ctx& C, int j) {
    ConvJob J; J.ksc = nullptr; const int e = j / 3, t = j % 3;
    if (t == 0) { J.W = C.P.in[35] + (size_t)e * 1024 * EFF; J.WT = (bf16_t*)(C.P.ws + WS_W13_T) + (size_t)e * 7168 * 1024; J.K = 1024; J.N = EFF; J.kind = 2; }
    else if (t == 1) { J.W = C.P.in[36] + (size_t)e * 1024 * EFF; J.WT = (bf16_t*)(C.P.ws + WS_W13_T) + (size_t)e * 7168 * 1024; J.K = 1024; J.N = EFF; J.kind = 3; }
    else { J.W = C.P.in[37] + (size_t)e * EFF * 1024; J.WT = (bf16_t*)(C.P.ws + WS_W2_T) + (size_t)e * 1024 * EFF; J.K = EFF; J.N = 1024; J.kind = 0; }
    J.nitems = (J.K / 64) * (J.N / 64);
    return J;
}
template <bool MOE>
__device__ __forceinline__ void conv_weights(const Ctx& C) {
    float* scr = MOE ? C.lds_f + C.wave * (64 * 65) : (float*)((unsigned char*)C.lds_f + CONV_LDS_OFF) + C.wave * (64 * 33);
    const int gw = C.blk * 8 + C.wave, NGW = C.nblk * 8;
    constexpr int NJ = MOE ? 24 : 19;
    int total = 0;
    for (int j = 0; j < NJ; ++j) total += (MOE ? conv_job_moe(C, j) : conv_job_small(C, j)).nitems;
    for (int it = gw; it < total; it += NGW) {
        int r = it;
        for (int j = 0; j < NJ; ++j) {
            const ConvJob J = MOE ? conv_job_moe(C, j) : conv_job_small(C, j);
            if (r < J.nitems) { const int kind = J.kind;
                if constexpr (MOE) transpose_item64(J.W, J.K, J.N, J.WT, [&](int n) { return conv_rowmap(kind, n); }, scr, r, C.lane);
                else transpose_item(J.W, J.K, J.N, J.WT, [&](int n) { return conv_rowmap(kind, n); }, J.ksc, scr, r, C.lane);
                break; }
            r -= J.nitems;
        }
    }
    if (!MOE) {
        const int gt = C.blk * NTHREADS + C.tid, NGT = C.nblk * NTHREADS;
        for (int i = gt; i < 2 * 224 * 128; i += NGT) { const int l = i / (224 * 128), q = i % (224 * 128);
            ((u32x4*)((bf16_t*)(C.P.ws + WS_WIN_T) + ((size_t)l * 8192 + 3872) * 1024))[q] = (u32x4){0u, 0u, 0u, 0u}; }
    }
}

__device__ __forceinline__ float silu_mul(float g, float u) { return g * u * __builtin_amdgcn_rcpf(1.f + __builtin_amdgcn_exp2f(-LOG2E * g)); }
__device__ __forceinline__ void epi_swiglu(const Acc& acc, bf16_t* O, int ldc, int row0, int col0, int wr, int wc, int fr, int fq) {
#pragma unroll
    for (int ai = 0; ai < 2; ++ai)
#pragma unroll
        for (int m = 0; m < 4; ++m) {
            f32x4 h0, h1;
#pragma unroll
            for (int q = 0; q < 4; ++q) { h0[q] = silu_mul(acc[ai][0][m][0][q], acc[ai][1][m][0][q]); h1[q] = silu_mul(acc[ai][0][m][1][q], acc[ai][1][m][1][q]); }
            *(u32x4*)(O + (size_t)(row0 + ai * HALF + wr * 64 + m * 16 + fr) * ldc + col0 + wc * 32 + 8 * fq) = pack8(h0, h1);
        }
}
__device__ __forceinline__ void epi_resid(const Ctx& C, const Acc& acc, int l, int mi, bool first, int row0, int col0, int wr, int wc, int fr, int fq) {
#pragma unroll
    for (int ai = 0; ai < 2; ++ai)
#pragma unroll
        for (int m = 0; m < 4; ++m) {
            const int row = row0 + ai * HALF + wr * 64 + m * 16 + fr;
            const int mrow = row < NL ? (row >> 11) : 8;
            const float* modp = (const float*)(C.P.ws + WS_MOD) + (size_t)(l * 9 + mrow) * 6144 + mi * 1024;
            float* dst = row < NL ? C.P.out + (size_t)row * 1024 : (float*)(C.P.ws + WS_CX) + (size_t)(row - NL) * 1024;
            const float* base = first ? (row < NL ? C.P.in[0] + (size_t)row * 1024 : C.P.in[2] + (size_t)(row - NL) * 1024) : dst;
#pragma unroll
            for (int bj = 0; bj < 2; ++bj)
#pragma unroll
                for (int n = 0; n < 2; ++n) { const int col = col0 + bj * HALF + wc * 32 + n * 16 + 4 * fq;
                    const f32x4 b = *(const f32x4*)(base + col), mv = *(const f32x4*)(modp + col); *(f32x4*)(dst + col) = b + mv * acc[ai][bj][m][n]; }
        }
}

struct SchedG1 { const char* A; const char* B; int l, G, c;
    __device__ __forceinline__ bool next(int i, GUnit& u) const {
        const long L = (long)i * G + c; int pm, pn;
        if (l == 0) { if (!static_order(NT / 256, 32, G, c, i, pm, pn)) return false; }
        else {
            const int nlat = (NL / 256) * 32;
            if (L < nlat) { static_order(NL / 256, 32, G, c, i, pm, pn); }
            else { const long L2 = L - nlat; if (L2 >= (NC / 256) * 8) return false; pm = NL / 256 + (int)(L2 >> 3); pn = 8 + (int)(L2 & 7); }
        }
        u.pm = pm; u.pn = pn; u.aux = 0; u.A = A + (size_t)pm * 256 * 1024 * 2; u.B = B + (size_t)pn * 256 * 1024 * 2; return true;
    } };
struct EpiG1 { bf16_t* PQKV; bf16_t* PG;
    __device__ __forceinline__ void operator()(const Acc& acc, const GUnit& u, int wr, int wc, int fr, int fq) const {
        if (u.pn < 16) epi_store_bf16(acc, PQKV, PQW, u.pm * 256, u.pn * 256, false, wr, wc, fr, fq);
        else epi_store_bf16(acc, PG, PGW, u.pm * 256, (u.pn - 16) * 256, true, wr, wc, fr, fq);
    } };
__device__ __forceinline__ void fg1(const Ctx& C, int l) {
    const SchedG1 S{(const char*)(C.P.ws + WS_XN), (const char*)(C.P.ws + WS_WIN_T) + (size_t)l * 8192 * 1024 * 2, l, C.nblk, C.blk};
    const EpiG1 E{(bf16_t*)(C.P.ws + WS_PQKV), (bf16_t*)(C.P.ws + WS_PG)};
    gemm_phase<true, false>((LAS unsigned char*)C.lds_f, 1024, 1024, S, E);
}
struct SchedRect { const char* A; const char* B; size_t astep, bstep; int nM, nN, G, c;
    __device__ __forceinline__ bool next(int i, GUnit& u) const {
        int pm, pn; if (!static_order(nM, nN, G, c, i, pm, pn)) return false;
        u.pm = pm; u.pn = pn; u.aux = 0; u.A = A + (size_t)pm * astep; u.B = B + (size_t)pn * bstep; return true;
    } };
struct EpiPlain { bf16_t* O; int ldc;
    __device__ __forceinline__ void operator()(const Acc& acc, const GUnit& u, int wr, int wc, int fr, int fq) const { epi_store_bf16(acc, O, ldc, u.pm * 256, u.pn * 256, false, wr, wc, fr, fq); } };
__device__ __forceinline__ void fg2(const Ctx& C, int l) {
    {
        const SchedRect S{(const char*)((bf16_t*)(C.P.ws + WS_PQKV) + C_CQ), (const char*)(C.P.ws + WS_WUQ_T) + (size_t)l * 768 * 512 * 2, (size_t)256 * PQW * 2, (size_t)256 * 512 * 2, NT / 256, 3, C.nblk, C.blk};
        const EpiPlain E{(bf16_t*)(C.P.ws + WS_QD), 768};
        gemm_phase<true, false>((LAS unsigned char*)C.lds_f, 512, PQW, S, E);
    }
    {
        const SchedRect S{(const char*)((bf16_t*)(C.P.ws + WS_PQKV) + C_CKV), (const char*)(C.P.ws + WS_WUKV_T) + (size_t)l * 1024 * 256 * 2, (size_t)256 * PQW * 2, (size_t)256 * 256 * 2, NT / 256, 4, C.nblk, C.blk};
        const EpiPlain E{(bf16_t*)(C.P.ws + WS_KVD), 1024};
        gemm_phase<true, false>((LAS unsigned char*)C.lds_f, 256, PQW, S, E);
    }
}
struct SchedG3 { const char* BR; const char* W; int nM, G, c;
    __device__ __forceinline__ bool next(int i, GUnit& u) const {
        int pm, pn; if (!static_order(nM, 8, G, c, i >> 2, pm, pn)) return false;
        const int n = i & 3; u.pm = pm; u.pn = pn; u.aux = n;
        u.A = BR + (size_t)pm * 256 * BRW * 2 + (size_t)n * 512 * 2; u.B = W + (size_t)n * 1024 * 512 * 2 + (size_t)pn * 128 * 512 * 2; return true;
    } };
struct EpiG3 { const bf16_t* PG; bf16_t* MERGED; f32x4 tot[2][4][2];
    __device__ __forceinline__ void operator()(const Acc& acc, const GUnit& u, int wr, int wc, int fr, int fq) {
        const int n = u.aux;
#pragma unroll
        for (int ai = 0; ai < 2; ++ai)
#pragma unroll
            for (int m = 0; m < 4; ++m) {
                const size_t row = (size_t)(u.pm * 256 + ai * HALF + wr * 64 + m * 16 + fr);
                const int col = u.pn * 128 + wc * 32 + 8 * fq;
                const u32x4 g = *(const u32x4*)(PG + row * PGW + n * 1024 + col);
                float gg[8]; unpack8(g, gg);
                f32x4 v0 = acc[ai][0][m][0], v1 = acc[ai][0][m][1];
                v0 = (f32x4){v0[0] * gg[0], v0[1] * gg[1], v0[2] * gg[2], v0[3] * gg[3]}; v1 = (f32x4){v1[0] * gg[4], v1[1] * gg[5], v1[2] * gg[6], v1[3] * gg[7]};
                if (n > 0) { v0 += tot[ai][m][0]; v1 += tot[ai][m][1]; }
                tot[ai][m][0] = v0; tot[ai][m][1] = v1;
                if (n == 3) *(u32x4*)(MERGED + row * 1024 + col) = pack8(v0, v1);
            }
    } };
__device__ __forceinline__ void fg3(const Ctx& C, int l) {
    const SchedG3 S{(const char*)(C.P.ws + WS_BR), (const char*)(C.P.ws + WS_WBR_T) + (size_t)l * 4 * 1024 * 512 * 2, (l == 0 ? NT : NL) / 256, C.nblk, C.blk};
    EpiG3 E; E.PG = (const bf16_t*)(C.P.ws + WS_PG); E.MERGED = (bf16_t*)(C.P.ws + WS_MERGED);
#pragma unroll
    for (int a = 0; a < 2; ++a)
#pragma unroll
        for (int m = 0; m < 4; ++m) { E.tot[a][m][0] = (f32x4){0.f, 0.f, 0.f, 0.f}; E.tot[a][m][1] = (f32x4){0.f, 0.f, 0.f, 0.f}; }
    gemm_phase_t<true, false, true>((LAS unsigned char*)C.lds_f, 512, BRW, S, E);
}
struct EpiResid { const Ctx& C; int l, mi; bool first;
    __device__ __forceinline__ void operator()(const Acc& acc, const GUnit& u, int wr, int wc, int fr, int fq) const { epi_resid(C, acc, l, mi, first, u.pm * 256, u.pn * 256, wr, wc, fr, fq); } };
__device__ __forceinline__ void fg4(const Ctx& C, int l) {
    const SchedRect S{(const char*)(C.P.ws + WS_MERGED), (const char*)(C.P.ws + WS_WOUT_T) + (size_t)l * 1024 * 1024 * 2, (size_t)256 * 1024 * 2, (size_t)256 * 1024 * 2, (l == 0 ? NT : NL) / 256, 4, C.nblk, C.blk};
    const EpiResid E{C, l, 2, l == 0};
    gemm_phase<false, false>((LAS unsigned char*)C.lds_f, 1024, 1024, S, E);
}
struct EpiSwiglu { bf16_t* O; int ldc;
    __device__ __forceinline__ void operator()(const Acc& acc, const GUnit& u, int wr, int wc, int fr, int fq) const { epi_swiglu(acc, O, ldc, u.pm * 256, u.pn * 128, wr, wc, fr, fq); } };
__device__ __forceinline__ void fg5(const Ctx& C) {
    const SchedRect S{(const char*)(C.P.ws + WS_XN), (const char*)(C.P.ws + WS_FFGU_T), (size_t)256 * 1024 * 2, (size_t)256 * 1024 * 2, NT / 256, 22, C.nblk, C.blk};
    const EpiSwiglu E{(bf16_t*)(C.P.ws + WS_H), DFF};
    gemm_phase<true, false>((LAS unsigned char*)C.lds_f, 1024, 1024, S, E);
}
__device__ __forceinline__ void fg6(const Ctx& C) {
    const SchedRect S{(const char*)(C.P.ws + WS_H), (const char*)(C.P.ws + WS_FFD_T), (size_t)256 * DFF * 2, (size_t)256 * DFF * 2, NT / 256, 4, C.nblk, C.blk};
    const EpiResid E{C, 0, 5, false};
    gemm_phase<false, false>((LAS unsigned char*)C.lds_f, DFF, DFF, S, E);
}
struct SchedG7 { const char* XN; const char* W; const int* ROWMAP; int ps[9]; int nM, G, c;
    __device__ __forceinline__ bool next(int i, GUnit& u) const {
        int pm, pn; if (!static_order(nM, 28, G, c, i, pm, pn)) return false;
        const int e = moe_expert_of(ps, pm * 256);
        u.pm = pm; u.pn = pn; u.aux = e; u.A = XN; u.B = W + (size_t)e * 7168 * 1024 * 2 + (size_t)pn * 256 * 1024 * 2; return true;
    }
    __device__ __forceinline__ unsigned row_off(const GUnit& u, int row) const { int tok = ROWMAP[u.pm * 256 + row]; tok = tok < 0 ? 0 : tok; return (unsigned)tok * 2048u; } };
__device__ __forceinline__ void fg7(const Ctx& C) {
    SchedG7 S; int cnt[8]; moe_starts(C, cnt, S.ps);
    S.XN = (const char*)(C.P.ws + WS_XN); S.W = (const char*)(C.P.ws + WS_W13_T); S.ROWMAP = (const int*)(C.P.ws + WS_ROWMAP); S.nM = S.ps[8] / 256; S.G = C.nblk; S.c = C.blk;
    const EpiSwiglu E{(bf16_t*)(C.P.ws + WS_HM), EFF};
    gemm_phase<true, true>((LAS unsigned char*)C.lds_f, 1024, 1024, S, E);
}
struct SchedG8 { const char* HM; const char* W; int ps[9]; int nM, G, c;
    __device__ __forceinline__ bool next(int i, GUnit& u) const {
        int pm, pn; if (!static_order(nM, 4, G, c, i, pm, pn)) return false;
        const int e = moe_expert_of(ps, pm * 256);
        u.pm = pm; u.pn = pn; u.aux = e; u.A = HM + (size_t)pm * 256 * EFF * 2; u.B = W + (size_t)e * 1024 * EFF * 2 + (size_t)pn * 256 * EFF * 2; return true;
    } };
__device__ __forceinline__ void fg8(const Ctx& C) {
    SchedG8 S; int cnt[8]; moe_starts(C, cnt, S.ps);
    S.HM = (const char*)(C.P.ws + WS_HM); S.W = (const char*)(C.P.ws + WS_W2_T); S.nM = S.ps[8] / 256; S.G = C.nblk; S.c = C.blk;
    const EpiPlain E{(bf16_t*)(C.P.ws + WS_YM), 1024};
    gemm_phase<true, false>((LAS unsigned char*)C.lds_f, EFF, EFF, S, E);
}

#ifndef FAST_G1
#define FAST_G1 1
#endif
#ifndef FAST_G2
#define FAST_G2 1
#endif
#ifndef FAST_G3
#define FAST_G3 1
#endif
#ifndef FAST_G4
#define FAST_G4 1
#endif
#ifndef FAST_G5
#define FAST_G5 1
#endif
#ifndef FAST_G6
#define FAST_G6 1
#endif
#ifndef FAST_G7
#define FAST_G7 1
#endif
#ifndef FAST_G8
#define FAST_G8 1
#endif
#define FAST_ANY_SMALL (FAST_G1 || FAST_G2 || FAST_G3 || FAST_G4 || FAST_G5 || FAST_G6)
#define FAST_ANY_MOE (FAST_G7 || FAST_G8)

typedef float f32x16 __attribute__((ext_vector_type(16)));
typedef short s16x4 __attribute__((ext_vector_type(4)));
constexpr int FA_STG = 28672, FA_VOFF = 12288, FA_WSF = 4 * FA_STG, FA_IDX = FA_WSF + 2048;
__device__ __forceinline__ int crow(int r, int hi) { return (r & 3) + 8 * (r >> 2) + 4 * hi; }
struct FAttn {
    const bf16_t* q; int qpitch; const bf16_t* k1; int k1pitch; const bf16_t* k2; int k2pitch; const bf16_t* v; int vpitch;
    int qrow0, qpos0, krow_lat, t0, nlat, krow_ctx; bool masked, has_sink; float sink2;
    const float* qgain; const float* qgain2; const float* rq; bool lat;
};
__device__ __forceinline__ s16x4 ds_tr(const LAS unsigned char* p) { return __builtin_bit_cast(s16x4, __builtin_amdgcn_ds_read_tr16_b64_v4i16((LAS s16x4*)p)); }
__device__ __forceinline__ float xhalf(float v) { return __shfl_xor(v, 32); }
__device__ __forceinline__ unsigned cvtpk(float lo, float hi) { f32x2_t v = {lo, hi}; bf16x2_t b = __builtin_convertvector(v, bf16x2_t); return __builtin_bit_cast(unsigned, b); }
#define FA_WAITV(n) asm volatile("s_waitcnt vmcnt(" #n ")" ::: "memory")
__device__ __forceinline__ void glds16(const void* gsrc, unsigned lds_dst) { unsigned keep;
    asm volatile("s_mov_b32 %0, m0\n\ts_mov_b32 m0, %2\n\ts_nop 0\n\tglobal_load_lds_dwordx4 %1, off\n\ts_mov_b32 m0, %0" : "=&s"(keep) : "v"(gsrc), "s"(lds_dst) : "memory"); }
__device__ __forceinline__ float max3f(float a, float b, float c) { float r; asm("v_max3_f32 %0, %1, %2, %3" : "=v"(r) : "v"(a), "v"(b), "v"(c)); return r; }
__device__ __forceinline__ float xhalf_max(float v) { auto rr = __builtin_amdgcn_permlane32_swap(__float_as_uint(v), __float_as_uint(v), false, false); return fmaxf(__uint_as_float(rr[0]), __uint_as_float(rr[1])); }
__device__ __forceinline__ float xhalf_sum(float v) { auto rr = __builtin_amdgcn_permlane32_swap(__float_as_uint(v), __float_as_uint(v), false, false); return __uint_as_float(rr[0]) + __uint_as_float(rr[1]); }
template <int DQK, int DV>
__device__ __forceinline__ void fattn_core(LAS unsigned char* lds, const FAttn& a, f32x16 (&o)[DV / 32]) {
    constexpr bool NEGM = (DV == 64 && DQK == 64);
    constexpr bool PIPE = (DV == 64);
    const int tid = threadIdx.x, lane = tid & 63, r32 = lane & 31, hi = lane >> 5; const int wid = __builtin_amdgcn_readfirstlane(tid >> 6);
    LAS float* wsf = (LAS float*)(lds + FA_WSF) + wid * 64;
    const int ntiles = a.nlat + 4;
    auto tile_row = [&](int tt) { return tt < a.nlat ? a.krow_lat + 64 * (a.t0 + tt) : a.krow_ctx + 64 * (tt - a.nlat); };
    const unsigned lds0 = (unsigned)(size_t)lds;
    auto issue = [&](int tt) {
        const size_t krow = (size_t)tile_row(tt); const unsigned sb = lds0 + (unsigned)((tt & 3) * FA_STG);
        glds16(a.k1 + (krow + lane) * a.k1pitch + wid * 8, (unsigned)__builtin_amdgcn_readfirstlane(sb + wid * 1024));
        if constexpr (DQK == 96) { if (wid < 4) glds16(a.k2 + (krow + lane) * a.k2pitch + wid * 8, (unsigned)__builtin_amdgcn_readfirstlane(sb + (8 + wid) * 1024)); }
#pragma unroll
        for (int j = 0; j < DV / 64; ++j) { const int cw = j * 8 + wid;
            glds16(a.v + (krow + 16 * (cw & 3) + (lane >> 2)) * a.vpitch + (cw >> 2) * 32 + (lane & 3) * 8, (unsigned)__builtin_amdgcn_readfirstlane(sb + FA_VOFF + cw * 1024)); }
    };
    auto wait_tiles = [&](int tiles_left) {
        if (tiles_left <= 0) FA_WAITV(0);
        else if constexpr (DQK == 96) { if (tiles_left == 1) { if (wid < 4) FA_WAITV(3); else FA_WAITV(2); } else { if (wid < 4) FA_WAITV(6); else FA_WAITV(4); } }
        else if constexpr (DV == 128) { if (tiles_left == 1) FA_WAITV(3); else FA_WAITV(6); }
        else { if (tiles_left == 1) FA_WAITV(2); else FA_WAITV(4); }
    };
    bf16x8 qr[DQK / 16];
    {
        const int row = a.qrow0 + wid * 32 + r32;
        const bf16_t* qp = a.q + (size_t)row * a.qpitch + hi * 8;
        float v[DQK / 16][8];
#pragma unroll
        for (int d0 = 0; d0 < DQK / 16; ++d0) unpack8(*(const u32x4*)(qp + d0 * 16), v[d0]);
        const int tq = a.qpos0 + wid * 32 + r32; const float prow = (float)(tq >> 6), pcol = (float)(tq & 63);
        if constexpr (DQK == 64) {
            float ss = 0.f;
#pragma unroll
            for (int d0 = 0; d0 < 4; ++d0)
#pragma unroll
                for (int j = 0; j < 8; ++j) ss += v[d0][j] * v[d0][j];
            const float rinv = __builtin_amdgcn_rsqf(xhalf_sum(ss) * (1.f / 64.f) + EPS) * QSCALE64;
#pragma unroll
            for (int d0 = 0; d0 < 4; ++d0) { const f32x4 g0 = *(const f32x4*)(a.qgain + 16 * d0 + 8 * hi), g1 = *(const f32x4*)(a.qgain + 16 * d0 + 8 * hi + 4);
#pragma unroll
                for (int j = 0; j < 4; ++j) { v[d0][j] *= rinv * g0[j]; v[d0][4 + j] *= rinv * g1[j]; } }
            if (a.lat) {
#pragma unroll
                for (int j = 0; j < 8; ++j) { const float f = inv_freq(8 * hi + j, 16); float s0, c0, s1, c1; __sincosf(prow * f, &s0, &c0); __sincosf(pcol * f, &s1, &c1);
                    const float x1 = v[0][j], x2 = v[2][j], y1 = v[1][j], y2 = v[3][j];
                    v[0][j] = x1 * c0 - x2 * s0; v[2][j] = x1 * s0 + x2 * c0; v[1][j] = y1 * c1 - y2 * s1; v[3][j] = y1 * s1 + y2 * c1; }
            }
        } else {
            const float rq = a.rq[row];
            float ssn = 0.f, ssr = 0.f;
#pragma unroll
            for (int d0 = 0; d0 < 6; ++d0)
#pragma unroll
                for (int j = 0; j < 8; ++j) { v[d0][j] *= rq; if (d0 < 4) ssn += v[d0][j] * v[d0][j]; else ssr += v[d0][j] * v[d0][j]; }
            const float rn = __builtin_amdgcn_rsqf(xhalf_sum(ssn) * (1.f / 64.f) + EPS) * QSCALE96, rr = __builtin_amdgcn_rsqf(xhalf_sum(ssr) * (1.f / 32.f) + EPS) * QSCALE96;
#pragma unroll
            for (int d0 = 0; d0 < 6; ++d0) { const float* gp = d0 < 4 ? a.qgain + 16 * d0 + 8 * hi : a.qgain2 + 16 * (d0 - 4) + 8 * hi; const float rs = d0 < 4 ? rn : rr;
                const f32x4 g0 = *(const f32x4*)gp, g1 = *(const f32x4*)(gp + 4);
#pragma unroll
                for (int j = 0; j < 4; ++j) { v[d0][j] *= rs * g0[j]; v[d0][4 + j] *= rs * g1[j]; } }
            if (a.lat) {
#pragma unroll
                for (int j = 0; j < 8; ++j) { const float f = inv_freq(j, 8); float s0, c0; __sincosf((hi == 0 ? prow : pcol) * f, &s0, &c0);
                    const float x1 = v[4][j], x2 = v[5][j]; v[4][j] = x1 * c0 - x2 * s0; v[5][j] = x1 * s0 + x2 * c0; }
            }
        }
#pragma unroll
        for (int d0 = 0; d0 < DQK / 16; ++d0) { u32x4 w; w.x = cvtpk(v[d0][0], v[d0][1]); w.y = cvtpk(v[d0][2], v[d0][3]); w.z = cvtpk(v[d0][4], v[d0][5]); w.w = cvtpk(v[d0][6], v[d0][7]); qr[d0] = __builtin_bit_cast(bf16x8, w); }
    }
    asm volatile("s_waitcnt vmcnt(0)" ::: "memory");
    issue(0); issue(1); issue(2);
    float m = a.has_sink ? a.sink2 : 0.f, l = a.has_sink ? (hi == 0 ? 1.f : 0.f) : 0.f;
    f32x16 negm;
#pragma unroll
    for (int r = 0; r < 16; ++r) negm[r] = NEGM ? -m : 0.f;
#pragma unroll
    for (int d0 = 0; d0 < DV / 32; ++d0)
#pragma unroll
        for (int r = 0; r < 16; ++r) o[d0][r] = 0.f;
    const int qpos = a.qpos0 + wid * 32 + r32;
    auto qk = [&](int tt, f32x16& p0, f32x16& p1) {
        const LAS unsigned char* kb = lds + (tt & 3) * FA_STG + hi * 1024 + r32 * 16;
#pragma unroll
        for (int dd = 0; dd < DQK / 32; ++dd) {
            bf16x8 kf[4];
#pragma unroll
            for (int e = 0; e < 2; ++e) { kf[2 * e] = *(const LAS bf16x8*)(kb + (2 * dd + e) * 2048); kf[2 * e + 1] = *(const LAS bf16x8*)(kb + (2 * dd + e) * 2048 + 512); }
#pragma unroll
            for (int e = 0; e < 2; ++e) { const int d0 = 2 * dd + e;
                p0 = __builtin_amdgcn_mfma_f32_32x32x16_bf16(kf[2 * e], qr[d0], d0 == 0 ? negm : p0, 0, 0, 0); p1 = __builtin_amdgcn_mfma_f32_32x32x16_bf16(kf[2 * e + 1], qr[d0], d0 == 0 ? negm : p1, 0, 0, 0); }
        }
    };
    auto step = [&](int t, f32x16& pc0, f32x16& pc1, f32x16& pn0, f32x16& pn1) {
        wait_tiles(t + 2 < ntiles ? 1 : 0);
        __builtin_amdgcn_s_barrier();
        asm volatile("" ::: "memory");
        if (t + 3 < ntiles) issue(t + 3);
        if constexpr (!PIPE) qk(t, pc0, pc1);
        const LAS unsigned char* vp = lds + (t & 3) * FA_STG + FA_VOFF + ((lane >> 4) & 1) * 32 + (lane & 3) * 8 + (4 * hi + ((lane & 15) >> 2)) * 64;
        s16x4 vlo[4], vhh[4];
#pragma unroll
        for (int ks = 0; ks < 4; ++ks) { vlo[ks] = ds_tr(vp + ks * 1024); vhh[ks] = ds_tr(vp + ks * 1024 + 512); }
        if constexpr (!NEGM) {
#pragma unroll
            for (int r = 0; r < 16; ++r) { pc0[r] -= m; pc1[r] -= m; }
        }
        if (a.masked && t < a.nlat) {
            const int kbase = 64 * (a.t0 + t) + 4 * hi - qpos;
#pragma unroll
            for (int r = 0; r < 16; ++r) { const int d = kbase + (r & 3) + 8 * (r >> 2); if (d > 128 || d < -128) pc0[r] = -1e30f; if (d + 32 > 128 || d + 32 < -128) pc1[r] = -1e30f; }
        }
        float mt = max3f(pc0[0], pc0[1], pc1[0]), mu = max3f(pc0[2], pc0[3], pc1[1]); mt = max3f(mt, pc1[2], pc1[3]);
#pragma unroll
        for (int r = 4; r < 16; r += 4) { mt = max3f(mt, pc0[r], pc0[r + 1]); mu = max3f(mu, pc0[r + 2], pc0[r + 3]); mt = max3f(mt, pc1[r], pc1[r + 1]); mu = max3f(mu, pc1[r + 2], pc1[r + 3]); }
        mt = xhalf_max(fmaxf(mt, mu));
        if (__any(mt > 6.0f)) {
            const float dl = fmaxf(mt, 0.f), alpha = __builtin_amdgcn_exp2f(-dl);
            m += dl; l *= alpha;
#pragma unroll
            for (int r = 0; r < 16; ++r) { pc0[r] -= dl; pc1[r] -= dl; }
            if constexpr (NEGM) {
#pragma unroll
                for (int r = 0; r < 16; ++r) negm[r] = -m;
            }
            if (hi == 0) wsf[r32] = alpha;
#pragma unroll
            for (int r4 = 0; r4 < 4; ++r4) { const f32x4 al = *(const LAS f32x4*)(wsf + 8 * r4 + 4 * hi);
#pragma unroll
                for (int d0 = 0; d0 < DV / 32; ++d0) { o[d0][4 * r4] *= al[0]; o[d0][4 * r4 + 1] *= al[1]; o[d0][4 * r4 + 2] *= al[2]; o[d0][4 * r4 + 3] *= al[3]; } }
        }
        if constexpr (PIPE) qk(t + 1, pn0, pn1);
        float ls = 0.f;
#pragma unroll
        for (int r = 0; r < 16; ++r) { pc0[r] = __builtin_amdgcn_exp2f(pc0[r]); pc1[r] = __builtin_amdgcn_exp2f(pc1[r]); ls += pc0[r] + pc1[r]; }
        l += ls;
        bf16x8 pa[4];
#pragma unroll
        for (int s = 0; s < 2; ++s) {
            u32x4 w0, w1;
            w0.x = cvtpk(pc0[8 * s], pc0[8 * s + 1]); w0.y = cvtpk(pc0[8 * s + 2], pc0[8 * s + 3]); w0.z = cvtpk(pc0[8 * s + 4], pc0[8 * s + 5]); w0.w = cvtpk(pc0[8 * s + 6], pc0[8 * s + 7]);
            w1.x = cvtpk(pc1[8 * s], pc1[8 * s + 1]); w1.y = cvtpk(pc1[8 * s + 2], pc1[8 * s + 3]); w1.z = cvtpk(pc1[8 * s + 4], pc1[8 * s + 5]); w1.w = cvtpk(pc1[8 * s + 6], pc1[8 * s + 7]);
            pa[s] = __builtin_bit_cast(bf16x8, w0); pa[2 + s] = __builtin_bit_cast(bf16x8, w1);
        }
#pragma unroll
        for (int d0 = 0; d0 < DV / 32; ++d0) {
#pragma unroll
            for (int ks = 0; ks < 4; ++ks) { const bf16x8 vf = (bf16x8){vlo[ks][0], vlo[ks][1], vlo[ks][2], vlo[ks][3], vhh[ks][0], vhh[ks][1], vhh[ks][2], vhh[ks][3]};
                o[d0] = __builtin_amdgcn_mfma_f32_32x32x16_bf16(pa[ks], vf, o[d0], 0, 0, 0); }
            if (d0 + 1 < DV / 32) {
#pragma unroll
                for (int ks = 0; ks < 4; ++ks) { vlo[ks] = ds_tr(vp + (d0 + 1) * 4096 + ks * 1024); vhh[ks] = ds_tr(vp + (d0 + 1) * 4096 + ks * 1024 + 512); }
            }
        }
        if constexpr (PIPE) {
#pragma unroll
            for (int i = 0; i < DQK / 8; ++i) { __builtin_amdgcn_sched_group_barrier(0x008, 1, 0); __builtin_amdgcn_sched_group_barrier(0x002, 80 / (DQK / 8), 0); }
        }
    };
    f32x16 pA0, pA1, pB0, pB1;
    wait_tiles(2); __builtin_amdgcn_s_barrier(); asm volatile("" ::: "memory");
    if constexpr (PIPE) { qk(0, pA0, pA1); for (int t = 0; t < ntiles; t += 2) { step(t, pA0, pA1, pB0, pB1); step(t + 1, pB0, pB1, pA0, pA1); } }
    else { for (int t = 0; t < ntiles; ++t) step(t, pA0, pA1, pA0, pA1); }
    l = xhalf_sum(l);
    if (hi == 0) wsf[r32] = l > 0.f ? 1.f / l : 0.f;
#pragma unroll
    for (int r4 = 0; r4 < 4; ++r4) { const f32x4 il = *(const LAS f32x4*)(wsf + 8 * r4 + 4 * hi);
#pragma unroll
        for (int d0 = 0; d0 < DV / 32; ++d0) { o[d0][4 * r4] *= il[0]; o[d0][4 * r4 + 1] *= il[1]; o[d0][4 * r4 + 2] *= il[2]; o[d0][4 * r4 + 3] *= il[3]; } }
    __syncthreads();
}
template <int NB>
__device__ __forceinline__ void fattn_store(bf16_t* dst  , int row0, const f32x16 (&o)[NB], int lane) {
    const int r32 = lane & 31, hi = lane >> 5;
#pragma unroll
    for (int d0 = 0; d0 < NB; ++d0)
#pragma unroll
        for (int r = 0; r < 16; ++r) dst[(size_t)(row0 + crow(r, hi)) * BRW + 32 * d0 + r32] = (bf16_t)f2bf(o[d0][r]);
}
__device__ __forceinline__ void fattn_phase(const Ctx& C, int l, int rep = 0) {
    LAS unsigned char* lds = (LAS unsigned char*)C.lds_f;
    const int n_lat = 1792, total = n_lat + (l == 0 ? NBATCH * 28 : 0);
    int* counter = (int*)(C.P.ws + WS_CNT) + 24 + l + 2 * rep;
    const float lam = __hip_atomic_load(&((float*)(C.P.ws + WS_CNT + 128))[l], __ATOMIC_RELAXED, __HIP_MEMORY_SCOPE_AGENT);
    const float lam_init = 0.8f - 0.6f * expf(-0.3f * (float)l);
    const int wid = __builtin_amdgcn_readfirstlane(C.tid >> 6);
    for (;;) {
        unsigned char* wsb = C.P.ws; asm volatile("" : "+s"(wsb));
        bf16_t* PQKV = (bf16_t*)(wsb + WS_PQKV); bf16_t* BR = (bf16_t*)(wsb + WS_BR); bf16_t* QD = (bf16_t*)(wsb + WS_QD); bf16_t* KVD = (bf16_t*)(wsb + WS_KVD);
        if (C.tid == 0) *(LAS int*)(lds + FA_IDX) = atomicAdd(counter, 1);
        __syncthreads();
        const int idx = __builtin_amdgcn_readfirstlane(*(LAS int*)(lds + FA_IDX));
        __syncthreads();
        if (idx >= total) break;
        int mixer, b, h, qb; bool isctx = false;
        if (idx < 256) { mixer = 2; b = idx >> 5; h = (idx >> 3) & 3; qb = idx & 7; }
        else if (idx < n_lat) { const int j = (idx - 256) & 511; mixer = idx < 768 ? 3 : (idx < 1280 ? 1 : 0); b = j >> 6; h = (j >> 3) & 7; qb = j & 7; }
        else { const int j = idx - n_lat, hitem = j % 28; b = j / 28; qb = 0; isctx = true; mixer = hitem < 8 ? 0 : (hitem < 16 ? 1 : (hitem < 20 ? 2 : 3)); h = hitem < 16 ? (hitem & 7) : (hitem < 20 ? hitem - 16 : hitem - 20); }
        FAttn a;
        a.qrow0 = isctx ? NL + b * CTXL : b * SEQ + qb * 256; a.qpos0 = qb * 256;
        a.krow_lat = b * SEQ; a.t0 = 0; a.nlat = isctx ? 0 : 32; a.krow_ctx = NL + b * CTXL; a.masked = false; a.has_sink = false; a.sink2 = 0.f;
        a.k2 = nullptr; a.k2pitch = 0; a.qgain2 = nullptr; a.rq = nullptr; a.lat = !isctx;
        a.qgain = (mixer == 0 ? C.P.in[9] : (mixer == 1 ? C.P.in[12] : (mixer == 2 ? C.P.in[14] : C.P.in[25]))) + l * 64;
        const int row0 = a.qrow0 + wid * 32;
        if (mixer <= 1) {
            const bool isA = mixer == 0; const int kvh = h >> 2;
            a.q = PQKV + (isA ? C_QA : C_QB) + h * 64; a.qpitch = PQW; a.k1 = PQKV + (isA ? C_KA : C_KB) + kvh * 64; a.k1pitch = PQW; a.v = PQKV + (isA ? C_VA : C_VB) + kvh * 64; a.vpitch = PQW;
            if (isA) { a.has_sink = true; a.sink2 = (C.P.in[11])[l * 8 + h] * LOG2E;
                if (!isctx) { a.masked = true; const int ta = 4 * qb - 2, tb = 4 * qb + 6; a.t0 = ta < 0 ? 0 : ta; a.nlat = (tb > 32 ? 32 : tb) - a.t0; } }
            f32x16 o[2]; fattn_core<64, 64>(lds, a, o);
            fattn_store<2>(BR + (isA ? 0 : 512) + h * 64, row0, o, C.lane);
        } else if (mixer == 2) {
            const int hc = h; float* OC1 = (float*)(wsb + WS_OC1);
            a.v = PQKV + C_VC + hc * 128; a.vpitch = PQW; a.qpitch = PQW; a.k1pitch = PQW;
            const int r32 = C.lane & 31, hi = C.lane >> 5;
            f32x16 o[4];
            a.q = PQKV + C_QC + (2 * hc) * 64; a.k1 = PQKV + C_KC + (2 * hc) * 64;
            fattn_core<64, 128>(lds, a, o);
#pragma unroll
            for (int d0 = 0; d0 < 4; ++d0)
#pragma unroll
                for (int r = 0; r < 16; ++r) OC1[((size_t)(row0 + crow(r, hi)) * 4 + hc) * 128 + 32 * d0 + r32] = o[d0][r];
            a.q = PQKV + C_QC + (2 * hc + 1) * 64; a.k1 = PQKV + C_KC + (2 * hc + 1) * 64;
            fattn_core<64, 128>(lds, a, o);
            float ss[16];
#pragma unroll
            for (int r = 0; r < 16; ++r) ss[r] = 0.f;
#pragma unroll
            for (int d0 = 0; d0 < 4; ++d0)
#pragma unroll
                for (int r = 0; r < 16; ++r) { const float o1 = OC1[((size_t)(row0 + crow(r, hi)) * 4 + hc) * 128 + 32 * d0 + r32]; const float dl = o1 - lam * o[d0][r]; o[d0][r] = dl; ss[r] += dl * dl; }
#pragma unroll
            for (int r = 0; r < 16; ++r) {
#pragma unroll
                for (int sft = 1; sft < 32; sft <<= 1) ss[r] += __shfl_xor(ss[r], sft);
                ss[r] = (1.0f / sqrtf(ss[r] * (1.f / 128.f) + EPS)) * (1.f - lam_init);
            }
            const float* gn = (C.P.in[20]) + l * 128;
#pragma unroll
            for (int d0 = 0; d0 < 4; ++d0) { const float g = gn[32 * d0 + r32];
#pragma unroll
                for (int r = 0; r < 16; ++r) o[d0][r] *= ss[r] * g; }
            fattn_store<4>(BR + 1024 + hc * 128, row0, o, C.lane);
        } else {
            a.qgain2 = C.P.in[27] + l * 32; a.rq = (const float*)(wsb + WS_RQ);
            a.q = QD + h * 96; a.qpitch = 768; a.k1 = KVD + h * 128; a.k1pitch = 1024; a.k2 = PQKV + C_KR; a.k2pitch = PQW; a.v = KVD + h * 128 + 64; a.vpitch = 1024;
            f32x16 o[2]; fattn_core<96, 64>(lds, a, o);
            fattn_store<2>(BR + 1536 + h * 64, row0, o, C.lane);
        }
    }
}
#ifndef FAST_ATTN
#define FAST_ATTN 1
#endif

#define XB_TMO      128
#define XB_XCNT(j)  (256  + 64 * (j))
#define XB_XSUB(j)  (1280 + 64 * (j))
#define XB_XGEN(j)  (2304 + 64 * (j))
#define XB_TOP      3328
#define XB_TOPGEN   3392
#define XCD_BAR_WORDS 3456
#define XB_SPIN_CAP (1u << 18)
constexpr size_t WS_BAR = 2 * MiB;
constexpr int LDS_ST_OFF = LDS_BYTES - 64;
__device__ __forceinline__ unsigned xb_ld(unsigned* p)              { return __hip_atomic_load(p, __ATOMIC_RELAXED, __HIP_MEMORY_SCOPE_AGENT); }
__device__ __forceinline__ unsigned xb_add(unsigned* p, unsigned v) { return __hip_atomic_fetch_add(p, v, __ATOMIC_RELAXED, __HIP_MEMORY_SCOPE_AGENT); }
__device__ __forceinline__ unsigned xb_xcc_id() { return (unsigned)__builtin_amdgcn_s_getreg((3 << 11) | 20) & 0xFu; }
#define XB_SPIN(cond, bar) do { unsigned _sp = 0; while (cond) { __builtin_amdgcn_s_sleep(1); \
    if ((++_sp & 255u) == 0u) { if (xb_ld(&(bar)[XB_TMO])) break; if (_sp > XB_SPIN_CAP) { atomicAdd(&(bar)[XB_TMO], 1u); break; } } } } while (0)
struct XcdBarrier { unsigned* bar; unsigned x; volatile LAS unsigned* st; };
__device__ __forceinline__ XcdBarrier xcd_barrier_post(unsigned* bar, volatile LAS unsigned* st) {
    XcdBarrier b; b.bar = bar; b.x = xb_xcc_id(); b.st = st;
    if (threadIdx.x == 0) (void)xb_add(&bar[XB_XCNT(b.x)], 1u);
    return b;
}
__device__ __forceinline__ void xcd_barrier_complete(unsigned* bar, unsigned x, unsigned& nloc, unsigned& nx) {
    const unsigned G = gridDim.x * gridDim.y * gridDim.z;
    unsigned sum, cnt, mine, sp = 0u;
    for (;;) {
        sum = 0u; cnt = 0u; mine = 0u;
#pragma unroll
        for (unsigned j = 0; j < 16; ++j) { const unsigned c = xb_ld(&bar[XB_XCNT(j)]); sum += c; cnt += (c > 0u) ? 1u : 0u; mine = (j == x) ? c : mine; }
        if (sum == G) break;
        __builtin_amdgcn_s_sleep(1);
        if ((++sp & 255u) == 0u) { if (xb_ld(&bar[XB_TMO])) break; if (sp > XB_SPIN_CAP) { atomicAdd(&bar[XB_TMO], 1u); break; } }
    }
    nloc = mine > 0u ? mine : 1u; nx = cnt > 0u ? cnt : 1u;
}
__device__ __forceinline__ void xcd_barrier(const XcdBarrier& b) {
    asm volatile("s_waitcnt vmcnt(0)" ::: "memory");
    __syncthreads();
    if (threadIdx.x == 0) {
        unsigned* bar = b.bar;
        __builtin_amdgcn_s_waitcnt(0);
        unsigned nloc = b.st[0], nx = b.st[1];
        if (nloc == 0u) { xcd_barrier_complete(bar, b.x, nloc, nx); b.st[0] = nloc; b.st[1] = nx; }
        const unsigned old = xb_add(&bar[XB_XSUB(b.x)], 1u);
        const unsigned gen = old / nloc;
        if (old + 1u == (gen + 1u) * nloc) {
            __builtin_amdgcn_fence(__ATOMIC_RELEASE, "agent");
            asm volatile("s_waitcnt vmcnt(0)" ::: "memory");
            const unsigned og = xb_add(&bar[XB_TOP], 1u);
            const unsigned tg = og / nx;
            if (og + 1u == (tg + 1u) * nx) xb_add(&bar[XB_TOPGEN], 1u);
            else XB_SPIN(xb_ld(&bar[XB_TOPGEN]) == tg, bar);
            __builtin_amdgcn_fence(__ATOMIC_ACQUIRE, "agent");
            xb_add(&bar[XB_XGEN(b.x)], 1u);
            asm volatile("s_waitcnt vmcnt(0)" ::: "memory");
        } else {
            XB_SPIN(xb_ld(&bar[XB_XGEN(b.x)]) == gen, bar);
            __builtin_amdgcn_fence(__ATOMIC_ACQUIRE, "agent");
            asm volatile("s_waitcnt vmcnt(0)" ::: "memory");
        }
    }
    __syncthreads();
}

constexpr int N_PHASES = 23;
__global__ void __launch_bounds__(NTHREADS) mk_fwd(Params p) {
    extern __shared__ __attribute__((aligned(16))) unsigned char lds[];
    cg::grid_group grid = cg::this_grid();
#define MKCTX int tid_l_ = (int)threadIdx.x; asm volatile("" : "+v"(tid_l_)); const Ctx C{p, (float*)lds, tid_l_, tid_l_ & 63, tid_l_ >> 6, (int)gridDim.x, (int)blockIdx.x}
    const int lo = p.ph_lo, hi = p.ph_hi;
    if (threadIdx.x < 2) ((volatile LAS unsigned*)((LAS unsigned char*)lds + LDS_ST_OFF))[threadIdx.x] = 0u;
    __syncthreads();
    XcdBarrier xbar; xbar.bar = (unsigned*)(p.ws + WS_BAR); xbar.x = 0; xbar.st = (volatile LAS unsigned*)((LAS unsigned char*)lds + LDS_ST_OFF);
#define SEAM(k) do { if ((k) == 0) { grid.sync(); xbar = xcd_barrier_post((unsigned*)(p.ws + WS_BAR), (volatile LAS unsigned*)((LAS unsigned char*)lds + LDS_ST_OFF)); } else xcd_barrier(xbar); } while (0)
#ifndef REPEAT_MASK
#define REPEAT_MASK 0u
#endif
int rep = 0;
#define PHASE(k, call) if (lo <= (k) && (k) < hi) { MKCTX; rep = 0; call; if ((REPEAT_MASK >> (k)) & 1u) { SEAM(k); rep = 1; call; } if ((k) + 1 < hi) SEAM(k); }
#define PHASEAB(k, callA, callB) if (lo <= (k) && (k) < hi) { MKCTX; callA; callB; if ((REPEAT_MASK >> (k)) & 1u) { SEAM(k); callB; } if ((k) + 1 < hi) SEAM(k); }
    PHASEAB(0, ph_prologue(C), (FAST_ANY_SMALL ? conv_weights<false>(C) : (void)0))
    PHASE(1, ph_adaln(C, 0, 0))
    PHASE(2, (FAST_G1 ? fg1(C, 0) : ph_g1(C, 0)))
    PHASE(3, (FAST_G2 ? fg2(C, 0) : ph_g2(C, 0)))
    PHASE(4, ph_post(C, 0, rep))
    PHASE(5, (FAST_ATTN ? fattn_phase(C, 0, rep) : ph_attn(C, 0)))
    PHASE(6, (FAST_G3 ? fg3(C, 0) : ph_g3(C, 0)))
    PHASE(7, (FAST_G4 ? fg4(C, 0) : ph_g4(C, 0)))
    PHASE(8, ph_adaln(C, 0, 1))
    PHASE(9, (FAST_G5 ? fg5(C) : ph_g5(C)))
    PHASE(10, (FAST_G6 ? fg6(C) : ph_g6(C)))
    PHASE(11, ph_adaln(C, 1, 0))
    PHASE(12, (FAST_G1 ? fg1(C, 1) : ph_g1(C, 1)))
    PHASE(13, (FAST_G2 ? fg2(C, 1) : ph_g2(C, 1)))
    PHASE(14, ph_post(C, 1, rep))
    PHASE(15, (FAST_ATTN ? fattn_phase(C, 1, rep) : ph_attn(C, 1)))
    PHASE(16, (FAST_G3 ? fg3(C, 1) : ph_g3(C, 1)))
    PHASE(17, (FAST_G4 ? fg4(C, 1) : ph_g4(C, 1)))
    PHASEAB(18, ph_adaln(C, 1, 1), (FAST_ANY_MOE ? conv_weights<true>(C) : (void)0))
    PHASE(19, ph_assign(C))
    PHASE(20, (FAST_G7 ? fg7(C) : ph_g7(C)))
    PHASE(21, (FAST_G8 ? fg8(C) : ph_g8(C)))
    PHASE(22, ph_combine(C))
#ifdef EXTRA_SYNCS
    for (int i = 0; i < EXTRA_SYNCS; ++i) xcd_barrier(xbar);
#endif
#ifdef REPEAT_PRO
    grid.sync(); if (blockIdx.x < 0) ph_prologue(C);
#endif
#undef PHASE
#undef PHASEAB
#undef SEAM
}

extern "C" void kernel_launch(void* const* d_in, const int* in_sizes, int n_in, void* d_out, int out_size, void* d_ws, size_t ws_size, hipStream_t stream) {
    static int grid_blocks = 0;
    if (grid_blocks == 0) {
        if (n_in != 38 || ws_size < WS_NEED) { fprintf(stderr, "kernel_launch: unexpected n_in %d / ws_size %zu\n", n_in, ws_size); grid_blocks = -1; return; }
        int dev = 0, cus = 0, per_cu = 0;
        hipGetDevice(&dev);
        hipDeviceGetAttribute(&cus, hipDeviceAttributeMultiprocessorCount, dev);
        hipFuncSetAttribute((const void*)mk_fwd, hipFuncAttributeMaxDynamicSharedMemorySize, LDS_BYTES);
        hipOccupancyMaxActiveBlocksPerMultiprocessor(&per_cu, (const void*)mk_fwd, NTHREADS, LDS_BYTES);
        if (per_cu < 1) per_cu = 1;
        grid_blocks = cus * per_cu;
        (void)hipGetLastError();
    }
    if (grid_blocks < 0) return;
    Params p{};
    for (int i = 0; i < 38; ++i) p.in[i] = (const float*)d_in[i];
    p.out = (float*)d_out; p.ws = (unsigned char*)d_ws; p.ph_lo = 0; p.ph_hi = N_PHASES;
    void* args[] = {&p};
    hipError_t e = hipLaunchCooperativeKernel((const void*)mk_fwd, dim3(grid_blocks), dim3(NTHREADS), args, LDS_BYTES, stream);
    if (e != hipSuccess) fprintf(stderr, "cooperative launch failed: %s (grid %d)\n", hipGetErrorString(e), grid_blocks);
}
```

```cpp
#include <hip/hip_runtime.h>
#include <hip/hip_cooperative_groups.h>
#include <cstdio>
#include <cstdint>
namespace cg = cooperative_groups;

typedef unsigned short bf16_t;
typedef float f32x4 __attribute__((ext_vector_type(4)));
typedef unsigned u32x4 __attribute__((ext_vector_type(4)));
typedef unsigned u32x2 __attribute__((ext_vector_type(2)));

constexpr int DM = 1024, NBATCH = 8, SEQ = 2048, CTXL = 256;
constexpr int NL = NBATCH * SEQ, NC = NBATCH * CTXL, NT = NL + NC;
constexpr int IN_COLS = 7968;
constexpr int C_QA = 0, C_QB = 512, C_QC = 1024, C_CQ = 1536, C_KA = 2048, C_VA = 2176, C_KB = 2304, C_VB = 2432, C_KC = 2560, C_VC = 3072, C_CKV = 3584, C_KR = 3840;
constexpr int PQW = 4096, PGW = 4096, BRW = 2048;
constexpr int DFF = 2816, EFF = 3584, NEXP = 8;
constexpr int MOE_ROWS = 34816;
constexpr float EPS = 1e-6f;
constexpr float LOG2E = 1.4426950408889634f;
constexpr float QSCALE64 = 0.125f * LOG2E, QSCALE96 = 0.10206207261596577f * LOG2E;
constexpr int NTHREADS = 512;
constexpr int LDS_BYTES = 147456;

constexpr size_t MiB = 1u << 20;
constexpr size_t WS_MOD = 0;
constexpr size_t WS_CNT = 512 * 1024;
constexpr size_t WS_ROUTE_E = 1 * MiB;
constexpr size_t WS_ROUTE_W = WS_ROUTE_E + 64 * 1024;
constexpr size_t WS_POS = WS_ROUTE_W + 128 * 1024;
constexpr size_t WS_ROWMAP = WS_POS + 128 * 1024;
constexpr size_t WS_RQ = 1536 * 1024;
constexpr size_t WS_XN = 4 * MiB;
constexpr size_t WS_BR = 4 * MiB;
constexpr size_t WS_WSMALL = 76 * MiB;
constexpr size_t WS_CX = 140 * MiB;
constexpr size_t WS_PQKV = 148 * MiB;
constexpr size_t WS_MERGED = 148 * MiB;
constexpr size_t WS_PG = 292 * MiB;
constexpr size_t WS_H = 292 * MiB;
constexpr size_t WS_QD = 436 * MiB;
constexpr size_t WS_KVD = 463 * MiB;
constexpr size_t WS_OC1 = 499 * MiB;
constexpr size_t WS_HM = 208 * MiB;
constexpr size_t WS_YM = 446 * MiB;
constexpr size_t WS_NEED = 535 * MiB;

__device__ __forceinline__ float bf2f(unsigned h) { return __uint_as_float(h << 16); }
__device__ __forceinline__ unsigned f2bf(float f) { unsigned u = __float_as_uint(f); return (u + 0x7fffu + ((u >> 16) & 1u)) >> 16; }
typedef float f32x2_t __attribute__((ext_vector_type(2))); typedef __bf16 bf16x2_t __attribute__((ext_vector_type(2)));
__device__ __forceinline__ unsigned pk2(float lo, float hi) { f32x2_t v = {lo, hi}; bf16x2_t b = __builtin_convertvector(v, bf16x2_t); return __builtin_bit_cast(unsigned, b); }
__device__ __forceinline__ float wave_sum(float v) {
#pragma unroll
    for (int o = 1; o < 64; o <<= 1) v += __shfl_xor(v, o);
    return v;
}
__device__ __forceinline__ float sigmoidf_(float x) { return 1.f / (1.f + __expf(-x)); }
__device__ __forceinline__ float siluf_(float x) { return x / (1.f + __expf(-x)); }
__device__ __forceinline__ void unpack8(u32x4 raw, float* dst) {
    dst[0] = bf2f(raw.x & 0xffffu); dst[1] = bf2f(raw.x >> 16); dst[2] = bf2f(raw.y & 0xffffu); dst[3] = bf2f(raw.y >> 16);
    dst[4] = bf2f(raw.z & 0xffffu); dst[5] = bf2f(raw.z >> 16); dst[6] = bf2f(raw.w & 0xffffu); dst[7] = bf2f(raw.w >> 16);
}

struct Params { const float* in[38]; float* out; unsigned char* ws; int ph_lo, ph_hi; };

struct Ctx { const Params& P; float* lds_f; int tid, lane, wave, nblk, blk; };

__device__ __forceinline__ void ph_prologue(const Ctx& C) {
    if (C.blk == 0 && C.tid < 32) ((int*)(C.P.ws + WS_CNT))[C.tid] = 0;
    if (C.blk == 0) for (int i = C.tid; i < 3456; i += NTHREADS) ((unsigned*)(C.P.ws + (2u << 20)))[i] = 0u;
    if (C.blk == 0 && C.wave == 1) {
        for (int l = 0; l < 2; ++l) {
            const float a = wave_sum((C.P.in[16])[l * 64 + C.lane] * (C.P.in[17])[l * 64 + C.lane]);
            const float b = wave_sum((C.P.in[18])[l * 64 + C.lane] * (C.P.in[19])[l * 64 + C.lane]);
            const float lam_init = 0.8f - 0.6f * expf(-0.3f * (float)l);
            if (C.lane == 0) ((float*)(C.P.ws + WS_CNT + 128))[l] = expf(a) - expf(b) + lam_init;
        }
    }
    float* sc = C.lds_f;
    float* red = C.lds_f + 9 * 1024;
    for (int i = C.tid; i < 9 * 1024; i += NTHREADS) { const int row = i >> 10, k = i & 1023; const float v = row < 8 ? (C.P.in[1])[row * 1024 + k] : (C.P.in[3])[k]; sc[i] = v / (1.f + expf(-v)); }
    __syncthreads();
    for (int item = C.blk; item < 384; item += C.nblk) {
        const int l = item / 192, cgp = item % 192, cl32 = C.lane & 31, kpar = C.lane >> 5;
        const float* w = (C.P.in[4]) + (size_t)l * 1024 * 6144 + cgp * 32 + cl32;
        float acc[9];
#pragma unroll
        for (int r = 0; r < 9; ++r) acc[r] = 0.f;
#pragma unroll 16
        for (int i = 0; i < 64; ++i) {
            const int k = C.wave * 128 + 2 * i + kpar; const float wv = w[(size_t)k * 6144];
#pragma unroll
            for (int r = 0; r < 9; ++r) acc[r] += sc[r * 1024 + k] * wv;
        }
#pragma unroll
        for (int r = 0; r < 9; ++r) { acc[r] += __shfl_xor(acc[r], 32); if (kpar == 0) red[(C.wave * 9 + r) * 32 + cl32] = acc[r]; }
        __syncthreads();
        for (int i = C.tid; i < 9 * 32; i += NTHREADS) {
            const int r = i >> 5, cl = i & 31; float sm = 0.f;
#pragma unroll
            for (int w8 = 0; w8 < 8; ++w8) sm += red[(w8 * 9 + r) * 32 + cl];
            ((float*)(C.P.ws + WS_MOD))[(size_t)(l * 9 + r) * 6144 + cgp * 32 + cl] = sm + (C.P.in[5])[l * 6144 + cgp * 32 + cl];
        }
        __syncthreads();
    }
}

__device__ __forceinline__ void ph_adaln(const Ctx& C, int l, int which) {
    const float* g = (which == 0 ? (C.P.in[6]) : (C.P.in[7])) + l * 1024;
    const bool router = (l == 1 && which == 1);
    const int nrows = router ? NL : NT;
    const int gw = C.blk * 8 + C.wave, NGW = C.nblk * 8;
    auto load_row = [&](int r, f32x4 (&v)[4]) {
        const float* src;
        if (l == 0 && which == 0) src = r < NL ? (C.P.in[0]) + (size_t)r * 1024 : (C.P.in[2]) + (size_t)(r - NL) * 1024;
        else src = r < NL ? (C.P.out) + (size_t)r * 1024 : ((float*)(C.P.ws + WS_CX)) + (size_t)(r - NL) * 1024;
#pragma unroll
        for (int j = 0; j < 4; ++j) v[j] = ((const f32x4*)src)[C.lane + 64 * j];
    };
    auto finish_row = [&](int r, const f32x4 (&v)[4]) {
        const int mrow = r < NL ? (r >> 11) : 8;
        const float* mod = ((float*)(C.P.ws + WS_MOD)) + (size_t)(l * 9 + mrow) * 6144;
        const float* shift = mod + (which ? 3 : 0) * 1024; const float* scale = mod + (which ? 4 : 1) * 1024;
        float ss = 0.f;
#pragma unroll
        for (int j = 0; j < 4; ++j) ss += (v[j].x * v[j].x + v[j].y * v[j].y) + (v[j].z * v[j].z + v[j].w * v[j].w);
        ss = wave_sum(ss);
        const float rinv = __builtin_amdgcn_rsqf(ss * (1.f / 1024.f) + EPS);
        float y[16];
#pragma unroll
        for (int j = 0; j < 4; ++j) {
            const f32x4 gg = ((const f32x4*)g)[C.lane + 64 * j], sh = ((const f32x4*)shift)[C.lane + 64 * j], sl = ((const f32x4*)scale)[C.lane + 64 * j];
            y[4 * j + 0] = v[j].x * rinv * gg.x * (1.f + sl.x) + sh.x; y[4 * j + 1] = v[j].y * rinv * gg.y * (1.f + sl.y) + sh.y;
            y[4 * j + 2] = v[j].z * rinv * gg.z * (1.f + sl.z) + sh.z; y[4 * j + 3] = v[j].w * rinv * gg.w * (1.f + sl.w) + sh.w;
            u32x2 o; o.x = pk2(y[4 * j + 0], y[4 * j + 1]); o.y = pk2(y[4 * j + 2], y[4 * j + 3]);
            ((u32x2*)(((bf16_t*)(C.P.ws + WS_XN)) + (size_t)r * 1024))[C.lane + 64 * j] = o;
        }
        if (router) {
            float lg[8];
#pragma unroll
            for (int e = 0; e < 8; ++e) lg[e] = 0.f;
#pragma unroll
            for (int j = 0; j < 4; ++j)
#pragma unroll
                for (int q = 0; q < 4; ++q) {
                    const int k = 4 * C.lane + 256 * j + q;
                    const f32x4 w0 = ((const f32x4*)((C.P.in[34]) + (size_t)k * 8))[0], w1 = ((const f32x4*)((C.P.in[34]) + (size_t)k * 8))[1];
                    const float yy = y[4 * j + q];
                    lg[0] += yy * w0.x; lg[1] += yy * w0.y; lg[2] += yy * w0.z; lg[3] += yy * w0.w; lg[4] += yy * w1.x; lg[5] += yy * w1.y; lg[6] += yy * w1.z; lg[7] += yy * w1.w;
                }
#pragma unroll
            for (int e = 0; e < 8; ++e) lg[e] = wave_sum(lg[e]);
            float b0 = lg[0]; int i0 = 0;
#pragma unroll
            for (int e = 1; e < 8; ++e) if (lg[e] > b0) { b0 = lg[e]; i0 = e; }
            float b1 = -3.0e38f; int i1 = 0;
#pragma unroll
            for (int e = 0; e < 8; ++e) if (e != i0 && lg[e] > b1) { b1 = lg[e]; i1 = e; }
            if (C.lane == 0) {
                const float w0 = 1.f / (1.f + expf(b1 - b0));
                ((int*)(C.P.ws + WS_ROUTE_E))[r] = i0 | (i1 << 8); ((float*)(C.P.ws + WS_ROUTE_W))[2 * r] = w0; ((float*)(C.P.ws + WS_ROUTE_W))[2 * r + 1] = 1.f - w0;
                atomicAdd(&((int*)(C.P.ws + WS_CNT))[i0], 1); atomicAdd(&((int*)(C.P.ws + WS_CNT))[i1], 1);
            }
        }
    };
    if (router) {
        for (int r = gw; r < nrows; r += 2 * NGW) {
            const int r2 = r + NGW; const bool h2 = r2 < nrows;
            f32x4 va[4], vb[4];
            load_row(r, va);
            if (h2) load_row(r2, vb);
            finish_row(r, va);
            if (h2) finish_row(r2, vb);
        }
    } else
    for (int r = gw; r < nrows; r += 4 * NGW) {
        const int r2 = r + NGW, r3 = r + 2 * NGW, r4 = r + 3 * NGW; const bool h2 = r2 < nrows, h3 = r3 < nrows, h4 = r4 < nrows;
        f32x4 va[4], vb[4], vc[4], vd[4];
        load_row(r, va);
        if (h2) load_row(r2, vb);
        if (h3) load_row(r3, vc);
        if (h4) load_row(r4, vd);
        finish_row(r, va);
        if (h2) finish_row(r2, vb);
        if (h3) finish_row(r3, vc);
        if (h4) finish_row(r4, vd);
    }
}

template <class AF, class BF>
__device__ __forceinline__ void ngemm_tile(float* lds_f, int tid, int K, AF af, BF bf, float (&acc)[4][4]) {
    float* As = lds_f;
    float* Bs = lds_f + 128 * 33;
    const int ty = tid >> 4, tx = tid & 15;
#pragma unroll
    for (int i = 0; i < 4; ++i)
#pragma unroll
        for (int j = 0; j < 4; ++j) acc[i][j] = 0.f;
    for (int k0 = 0; k0 < K; k0 += 32) {
        {
            const int i = tid >> 2, kq = (tid & 3) * 8; const bf16_t* ap = af(i, k0 + kq); float t[8];
            if (ap) unpack8(*(const u32x4*)ap, t); else {
#pragma unroll
                for (int q = 0; q < 8; ++q) t[q] = 0.f; }
#pragma unroll
            for (int q = 0; q < 8; ++q) As[i * 33 + kq + q] = t[q];
        }
        {
            const int k = tid >> 4, j = (tid & 15) * 4;
#pragma unroll
            for (int q = 0; q < 4; ++q) Bs[k * 64 + j + q] = bf(k0 + k, j + q);
        }
        __syncthreads();
#pragma unroll 8
        for (int kk = 0; kk < 32; ++kk) {
            float a[4];
#pragma unroll
            for (int i = 0; i < 4; ++i) a[i] = As[(ty * 4 + i) * 33 + kk];
            const f32x4 b = *(const f32x4*)&Bs[kk * 64 + tx * 4];
#pragma unroll
            for (int i = 0; i < 4; ++i) { acc[i][0] += a[i] * b.x; acc[i][1] += a[i] * b.y; acc[i][2] += a[i] * b.z; acc[i][3] += a[i] * b.w; }
        }
        __syncthreads();
    }
}
#define NG_EPI(acc, ...) do { const int ty_ = C.tid >> 4, tx_ = C.tid & 15; auto ef_ = __VA_ARGS__; _Pragma("unroll") for (int i_ = 0; i_ < 4; ++i_) ef_(ty_ * 4 + i_, tx_ * 4, acc[i_]); } while (0)

__device__ __forceinline__ void ph_g1(const Ctx& C, int l) {
    const float* W = (C.P.in[8]) + (size_t)l * 1024 * IN_COLS;
    const int n_lat = (NL / 128) * 128, n_ctx = (NC / 128) * (l == 0 ? 128 : 32);
    for (int it = C.blk; it < n_lat + n_ctx; it += C.nblk) {
        int rt, ct;
        if (it < n_lat) { rt = it >> 7; ct = it & 127; }
        else { const int j = it - n_lat; if (l == 0) { rt = NL / 128 + (j >> 7); ct = j & 127; } else { rt = NL / 128 + (j >> 5); ct = 32 + (j & 31); } }
        const int row0 = rt * 128, col0 = ct * 64;
        float acc[4][4];
        ngemm_tile(C.lds_f, C.tid, 1024,
            [&](int i, int k) { return ((bf16_t*)(C.P.ws + WS_XN)) + (size_t)(row0 + i) * 1024 + k; },
            [&](int k, int j) { const int n = col0 + j; return n < 3872 ? W[(size_t)k * IN_COLS + n] : (n < 4096 ? 0.f : W[(size_t)k * IN_COLS + n - 224]); }, acc);
        NG_EPI(acc, [&](int i, int j0, const float* a) {
                const int n = col0 + j0; u32x2 o;
                if (n < 4096) { o.x = pk2(a[0], a[1]); o.y = pk2(a[2], a[3]); *(u32x2*)(((bf16_t*)(C.P.ws + WS_PQKV)) + (size_t)(row0 + i) * PQW + n) = o; }
                else { o.x = pk2(sigmoidf_(a[0]), sigmoidf_(a[1])); o.y = pk2(sigmoidf_(a[2]), sigmoidf_(a[3])); *(u32x2*)(((bf16_t*)(C.P.ws + WS_PG)) + (size_t)(row0 + i) * PGW + n - 4096) = o; }
            });
    }
}
__device__ __forceinline__ void ph_g2(const Ctx& C, int l) {
    const float* Wq = (C.P.in[23]) + (size_t)l * 512 * 768; const float* gq = (C.P.in[21]) + l * 512;
    const float* Wk = (C.P.in[24]) + (size_t)l * 256 * 1024; const float* gk = (C.P.in[22]) + l * 256;
    const int nq = (NT / 128) * 12, nk = (NT / 128) * 16;
    for (int it = C.blk; it < nq + nk; it += C.nblk) {
        float acc[4][4];
        if (it < nq) {
            const int row0 = (it / 12) * 128, col0 = (it % 12) * 64;
            ngemm_tile(C.lds_f, C.tid, 512,
                [&](int i, int k) { return ((bf16_t*)(C.P.ws + WS_PQKV)) + (size_t)(row0 + i) * PQW + C_CQ + k; },
                [&](int k, int j) { return gq[k] * Wq[(size_t)k * 768 + col0 + j]; }, acc);
            NG_EPI(acc, [&](int i, int j0, const float* a) { u32x2 o; o.x = pk2(a[0], a[1]); o.y = pk2(a[2], a[3]); *(u32x2*)(((bf16_t*)(C.P.ws + WS_QD)) + (size_t)(row0 + i) * 768 + col0 + j0) = o; });
        } else {
            const int j2 = it - nq; const int row0 = (j2 / 16) * 128, col0 = (j2 % 16) * 64;
            ngemm_tile(C.lds_f, C.tid, 256,
                [&](int i, int k) { return ((bf16_t*)(C.P.ws + WS_PQKV)) + (size_t)(row0 + i) * PQW + C_CKV + k; },
                [&](int k, int j) { return gk[k] * Wk[(size_t)k * 1024 + col0 + j]; }, acc);
            NG_EPI(acc, [&](int i, int j0, const float* a) { u32x2 o; o.x = pk2(a[0], a[1]); o.y = pk2(a[2], a[3]); *(u32x2*)(((bf16_t*)(C.P.ws + WS_KVD)) + (size_t)(row0 + i) * 1024 + col0 + j0) = o; });
        }
    }
}

__device__ __forceinline__ float inv_freq(int i, int n) { return exp2f(-(float)i / (float)n * 13.287712379549449f); }
__device__ __forceinline__ float grp16_sum(float v) { v += __shfl_xor(v, 1); v += __shfl_xor(v, 2); v += __shfl_xor(v, 4); v += __shfl_xor(v, 8); return v; }
__device__ __forceinline__ float grp8_sum(float v) { v += __shfl_xor(v, 1); v += __shfl_xor(v, 2); v += __shfl_xor(v, 4); return v; }
__device__ __forceinline__ float rms_inv(float ss, float inv_n) { return __builtin_amdgcn_rsqf(ss * inv_n + EPS); }
__device__ __forceinline__ void ph_post(const Ctx& C, int l, int rep = 0) {
    (void)rep;
    const int gw = C.blk * 8 + C.wave, NGW = C.nblk * 8, lane = C.lane, g = lane >> 4, j = lane & 15, jj = lane & 7, g8 = lane >> 3;
    float fh[2], fr[2];
#pragma unroll
    for (int e = 0; e < 2; ++e) { fh[e] = inv_freq((2 * j + e) & 15, 16); fr[e] = inv_freq((2 * jj + e) & 7, 8); }
    float ga[6][4];
    {
        const float* gp[6] = {C.P.in[9], C.P.in[12], C.P.in[14], C.P.in[10], C.P.in[13], C.P.in[15]};
#pragma unroll
        for (int f = 0; f < 6; ++f) { ga[f][0] = gp[f][l * 64 + 2 * j]; ga[f][1] = gp[f][l * 64 + 2 * j + 1]; ga[f][2] = gp[f][l * 64 + 32 + 2 * j]; ga[f][3] = gp[f][l * 64 + 33 + 2 * j]; }
    }
    const f32x4 g_qn = *(const f32x4*)(C.P.in[25] + l * 64 + 4 * j), g_kn = *(const f32x4*)(C.P.in[26] + l * 64 + 4 * j);
    float g_qr[4], g_kr[4];
    g_qr[0] = (C.P.in[27])[l * 32 + 2 * jj]; g_qr[1] = (C.P.in[27])[l * 32 + 2 * jj + 1]; g_qr[2] = (C.P.in[27])[l * 32 + 16 + 2 * jj]; g_qr[3] = (C.P.in[27])[l * 32 + 17 + 2 * jj];
    g_kr[0] = (C.P.in[28])[l * 32 + 2 * jj]; g_kr[1] = (C.P.in[28])[l * 32 + 2 * jj + 1]; g_kr[2] = (C.P.in[28])[l * 32 + 16 + 2 * jj]; g_kr[3] = (C.P.in[28])[l * 32 + 17 + 2 * jj];
    for (int r = gw; r < NT; r += NGW) {
        const bool lat = r < NL; const int t = r & 2047; const float prow = (float)(t >> 6), pcol = (float)(t & 63);
        float ch[2] = {1.f, 1.f}, sh[2] = {0.f, 0.f}, cr[2] = {1.f, 1.f}, sr[2] = {0.f, 0.f};
        if (lat) {
#pragma unroll
            for (int e = 0; e < 2; ++e) { __sincosf((j < 8 ? prow : pcol) * fh[e], &sh[e], &ch[e]); __sincosf((jj < 4 ? prow : pcol) * fr[e], &sr[e], &cr[e]); }
        }
        bf16_t* pq = ((bf16_t*)(C.P.ws + WS_PQKV)) + (size_t)r * PQW;
        bf16_t* kv = ((bf16_t*)(C.P.ws + WS_KVD)) + (size_t)r * 1024;
        bf16_t* qd = ((bf16_t*)(C.P.ws + WS_QD)) + (size_t)r * 768;
        const bool do_q = lat || l == 0;
        const u32x2 ckv_raw = *(const u32x2*)(pq + C_CKV + lane * 4);
        const u32x4 cq_raw = *(const u32x4*)(pq + C_CQ + lane * 8);
#pragma unroll
        for (int it = 6; it < 9; ++it) {
            const int hh = 4 * it + g;
            const int col = it < 6 ? hh * 64 : (it == 6 ? (g < 2 ? C_KA + g * 64 : C_KB + (g - 2) * 64) : C_KC + (hh - 28) * 64);
            const unsigned w0 = *(const unsigned*)(pq + col + 2 * j), w1 = *(const unsigned*)(pq + col + 32 + 2 * j);
            const float x0 = bf2f(w0 & 0xffffu), x1 = bf2f(w0 >> 16), x2 = bf2f(w1 & 0xffffu), x3 = bf2f(w1 >> 16);
            const float rinv = rms_inv(grp16_sum((x0 * x0 + x1 * x1) + (x2 * x2 + x3 * x3)), 1.f / 64.f);
            float ga0, ga1, ga2, ga3;
            if (it < 6) { ga0 = ga[it >> 1][0]; ga1 = ga[it >> 1][1]; ga2 = ga[it >> 1][2]; ga3 = ga[it >> 1][3]; }
            else if (it == 6) { ga0 = g < 2 ? ga[3][0] : ga[4][0]; ga1 = g < 2 ? ga[3][1] : ga[4][1]; ga2 = g < 2 ? ga[3][2] : ga[4][2]; ga3 = g < 2 ? ga[3][3] : ga[4][3]; }
            else { ga0 = ga[5][0]; ga1 = ga[5][1]; ga2 = ga[5][2]; ga3 = ga[5][3]; }
            const float sc = it < 6 ? QSCALE64 : 1.f;
            const float y0 = x0 * rinv * ga0 * sc, y1 = x1 * rinv * ga1 * sc, y2 = x2 * rinv * ga2 * sc, y3 = x3 * rinv * ga3 * sc;
            *(unsigned*)(pq + col + 2 * j) = pk2(y0 * ch[0] - y2 * sh[0], y1 * ch[1] - y3 * sh[1]);
            *(unsigned*)(pq + col + 32 + 2 * j) = pk2(y0 * sh[0] + y2 * ch[0], y1 * sh[1] + y3 * ch[1]);
        }
        {
            const unsigned w0 = lane < 8 ? *(const unsigned*)(pq + C_KR + 2 * jj) : 0u, w1 = lane < 8 ? *(const unsigned*)(pq + C_KR + 16 + 2 * jj) : 0u;
            const float x0 = bf2f(w0 & 0xffffu), x1 = bf2f(w0 >> 16), x2 = bf2f(w1 & 0xffffu), x3 = bf2f(w1 >> 16);
            const float rinv = rms_inv(grp8_sum((x0 * x0 + x1 * x1) + (x2 * x2 + x3 * x3)), 1.f / 32.f);
            const float y0 = x0 * rinv * g_kr[0], y1 = x1 * rinv * g_kr[1], y2 = x2 * rinv * g_kr[2], y3 = x3 * rinv * g_kr[3];
            if (lane < 8) { *(unsigned*)(pq + C_KR + 2 * jj) = pk2(y0 * cr[0] - y2 * sr[0], y1 * cr[1] - y3 * sr[1]); *(unsigned*)(pq + C_KR + 16 + 2 * jj) = pk2(y0 * sr[0] + y2 * cr[0], y1 * sr[1] + y3 * cr[1]); }
        }
        {
            float t4[4] = {bf2f(ckv_raw.x & 0xffffu), bf2f(ckv_raw.x >> 16), bf2f(ckv_raw.y & 0xffffu), bf2f(ckv_raw.y >> 16)};
            const float rkv = rms_inv(wave_sum((t4[0] * t4[0] + t4[1] * t4[1]) + (t4[2] * t4[2] + t4[3] * t4[3])), 1.f / 256.f);
#pragma unroll
            for (int it = 0; it < 2; ++it) {
                bf16_t* p = kv + (4 * it + g) * 128 + 4 * j;
                const u32x2 w = *(const u32x2*)p;
                const float x0 = rkv * bf2f(w.x & 0xffffu), x1 = rkv * bf2f(w.x >> 16), x2 = rkv * bf2f(w.y & 0xffffu), x3 = rkv * bf2f(w.y >> 16);
                const float rinv = rms_inv(grp16_sum((x0 * x0 + x1 * x1) + (x2 * x2 + x3 * x3)), 1.f / 64.f);
                u32x2 o; o.x = pk2(x0 * rinv * g_kn[0], x1 * rinv * g_kn[1]); o.y = pk2(x2 * rinv * g_kn[2], x3 * rinv * g_kn[3]); *(u32x2*)p = o;
            }
            {
                bf16_t* p = kv + g8 * 128 + 64 + jj * 8;
                float v8[8]; unpack8(*(const u32x4*)p, v8);
                u32x4 o; o.x = pk2(rkv * v8[0], rkv * v8[1]); o.y = pk2(rkv * v8[2], rkv * v8[3]); o.z = pk2(rkv * v8[4], rkv * v8[5]); o.w = pk2(rkv * v8[6], rkv * v8[7]); *(u32x4*)p = o;
            }
        }
        if (do_q) {
            float t8[8]; unpack8(cq_raw, t8);
            float ss = 0.f;
#pragma unroll
            for (int q = 0; q < 8; ++q) ss += t8[q] * t8[q];
            const float rq = rms_inv(wave_sum(ss), 1.f / 512.f);
            if (lane == 0) ((float*)(C.P.ws + WS_RQ))[r] = rq;
        }
    }
}

struct AttnArgs {
    const bf16_t* q; int qpitch; const bf16_t* k1; int k1pitch; const bf16_t* k2; int k2pitch; const bf16_t* v; int vpitch;
    float scale, sink; bool has_sink, windowed, qctx, lat_keys; int b, q0, nq;
};
template <int DQK, int DV>
__device__ __forceinline__ void nattn_core(float* lds_f, int tid, const AttnArgs& a, float (&o)[DV]) {
    float* Ks = lds_f; float* Vs = lds_f + 32 * DQK;
    const int qpos = a.q0 + tid; const bool valid = tid < a.nq;
    const size_t qrow = valid ? (a.qctx ? (size_t)(NL + a.b * CTXL + qpos) : (size_t)(a.b * SEQ + qpos)) : (size_t)0;
    float q[DQK];
    {
        const bf16_t* qp = a.q + qrow * a.qpitch;
#pragma unroll
        for (int d8 = 0; d8 < DQK / 8; ++d8) { float t[8]; unpack8(*(const u32x4*)(qp + d8 * 8), t);
#pragma unroll
            for (int i = 0; i < 8; ++i) q[d8 * 8 + i] = t[i] * a.scale; }
    }
    float m = a.has_sink ? a.sink : -1e30f, ls = a.has_sink ? 1.f : 0.f;
#pragma unroll
    for (int d = 0; d < DV; ++d) o[d] = 0.f;
    auto tile = [&](size_t krow0, int kpos0, bool masked) {
        __syncthreads();
        for (int c = tid; c < 32 * DQK / 8; c += NTHREADS) {
            const int key = c / (DQK / 8), d8 = (c % (DQK / 8)) * 8;
            const bf16_t* src = d8 < 64 ? a.k1 + (krow0 + key) * a.k1pitch + d8 : a.k2 + (krow0 + key) * a.k2pitch + (d8 - 64);
            float t[8]; unpack8(*(const u32x4*)src, t);
#pragma unroll
            for (int i = 0; i < 8; ++i) Ks[key * DQK + d8 + i] = t[i];
        }
        for (int c = tid; c < 32 * DV / 8; c += NTHREADS) {
            const int key = c / (DV / 8), d8 = (c % (DV / 8)) * 8;
            float t[8]; unpack8(*(const u32x4*)(a.v + (krow0 + key) * a.vpitch + d8), t);
#pragma unroll
            for (int i = 0; i < 8; ++i) Vs[key * DV + d8 + i] = t[i];
        }
        __syncthreads();
        for (int j = 0; j < 32; ++j) {
            int dist = qpos - (kpos0 + j); dist = dist < 0 ? -dist : dist;
            const bool ok = valid && (!masked || dist <= 128);
            if (ok) {
                float s = 0.f; const f32x4* kp = (const f32x4*)(Ks + j * DQK);
#pragma unroll
                for (int d4 = 0; d4 < DQK / 4; ++d4) { const f32x4 kv = kp[d4]; s += q[4 * d4] * kv.x + q[4 * d4 + 1] * kv.y + q[4 * d4 + 2] * kv.z + q[4 * d4 + 3] * kv.w; }
                if (s > m) { const float corr = exp2f(m - s); ls *= corr;
#pragma unroll
                    for (int d = 0; d < DV; ++d) o[d] *= corr;
                    m = s; }
                const float p = exp2f(s - m); ls += p; const f32x4* vp = (const f32x4*)(Vs + j * DV);
#pragma unroll
                for (int d4 = 0; d4 < DV / 4; ++d4) { const f32x4 vv = vp[d4]; o[4 * d4] += p * vv.x; o[4 * d4 + 1] += p * vv.y; o[4 * d4 + 2] += p * vv.z; o[4 * d4 + 3] += p * vv.w; }
            }
        }
    };
    if (a.lat_keys) {
        int lo = 0, hi = SEQ;
        if (a.windowed) { lo = a.q0 - 128; lo = lo < 0 ? 0 : lo; lo &= ~31; hi = a.q0 + a.nq + 128; hi = hi > SEQ ? SEQ : hi; }
        for (int kp = lo; kp < hi; kp += 32) tile((size_t)(a.b * SEQ + kp), kp, a.windowed);
    }
    for (int kp = 0; kp < CTXL; kp += 32) tile((size_t)(NL + a.b * CTXL + kp), 0, false);
    const float inv = ls > 0.f ? 1.f / ls : 0.f;
#pragma unroll
    for (int d = 0; d < DV; ++d) o[d] *= inv;
    __syncthreads();
}
__device__ __forceinline__ void store_o64(bf16_t* dst, const float (&o)[64]) {
#pragma unroll
    for (int d8 = 0; d8 < 8; ++d8) { u32x4 w; w.x = pk2(o[d8 * 8], o[d8 * 8 + 1]); w.y = pk2(o[d8 * 8 + 2], o[d8 * 8 + 3]); w.z = pk2(o[d8 * 8 + 4], o[d8 * 8 + 5]); w.w = pk2(o[d8 * 8 + 6], o[d8 * 8 + 7]); *(u32x4*)(dst + d8 * 8) = w; }
}
__device__ __forceinline__ void ph_attn(const Ctx& C, int l) {
    const int n_lat = NBATCH * 4 * 28, n_ctx = (l == 0) ? NBATCH * 28 : 0;
    const float lam = __hip_atomic_load(&((float*)(C.P.ws + WS_CNT + 128))[l], __ATOMIC_RELAXED, __HIP_MEMORY_SCOPE_AGENT);
    const float lam_init = 0.8f - 0.6f * expf(-0.3f * (float)l);
    bf16_t* PQKV = (bf16_t*)(C.P.ws + WS_PQKV); bf16_t* BR = (bf16_t*)(C.P.ws + WS_BR);
    for (int it = C.blk; it < n_lat + n_ctx; it += C.nblk) {
        AttnArgs a; int hitem;
        if (it < n_lat) { hitem = it % 28; const int rest = it / 28; a.b = rest >> 2; a.q0 = (rest & 3) * 512; a.nq = 512; a.qctx = false; a.lat_keys = true; }
        else { const int j = it - n_lat; hitem = j % 28; a.b = j / 28; a.q0 = 0; a.nq = CTXL; a.qctx = true; a.lat_keys = false; }
        a.k2 = nullptr; a.k2pitch = 0; a.has_sink = false; a.sink = 0.f; a.windowed = false; a.scale = 1.0f;
        const bool valid = C.tid < a.nq;
        const size_t orow = valid ? (a.qctx ? (size_t)(NL + a.b * CTXL + a.q0 + C.tid) : (size_t)(a.b * SEQ + a.q0 + C.tid)) : (size_t)0;
        float o[64];
        if (hitem < 16) {
            const bool isA = hitem < 8; const int h = hitem & 7, kvh = h >> 2;
            a.q = PQKV + (isA ? C_QA : C_QB) + h * 64; a.qpitch = PQW;
            a.k1 = PQKV + (isA ? C_KA : C_KB) + kvh * 64; a.k1pitch = PQW;
            a.v = PQKV + (isA ? C_VA : C_VB) + kvh * 64; a.vpitch = PQW;
            if (isA) { a.has_sink = true; a.sink = (C.P.in[11])[l * 8 + h] * LOG2E; a.windowed = !a.qctx; }
            nattn_core<64, 64>(C.lds_f, C.tid, a, o);
            if (valid) store_o64(BR + orow * BRW + (isA ? 0 : 512) + h * 64, o);
        } else if (hitem < 20) {
            const int hc = hitem - 16;
            float* sc1 = (float*)(C.P.ws + WS_OC1) + (orow * 4 + hc) * 128;
            float ss = 0.f;
            for (int part = 0; part < 2; ++part)
                for (int ch = 0; ch < 2; ++ch) {
                    a.q = PQKV + C_QC + (2 * hc + part) * 64; a.qpitch = PQW; a.k1 = PQKV + C_KC + (2 * hc + part) * 64; a.k1pitch = PQW;
                    a.v = PQKV + C_VC + hc * 128 + ch * 64; a.vpitch = PQW;
                    nattn_core<64, 64>(C.lds_f, C.tid, a, o);
                    if (valid) {
                        f32x4* s4 = (f32x4*)(sc1 + ch * 64);
                        if (part == 0) {
#pragma unroll
                            for (int d4 = 0; d4 < 16; ++d4) s4[d4] = (f32x4){o[4 * d4], o[4 * d4 + 1], o[4 * d4 + 2], o[4 * d4 + 3]};
                        } else {
#pragma unroll
                            for (int d4 = 0; d4 < 16; ++d4) { const f32x4 o1 = s4[d4];
                                const f32x4 dl = (f32x4){o1.x - lam * o[4 * d4], o1.y - lam * o[4 * d4 + 1], o1.z - lam * o[4 * d4 + 2], o1.w - lam * o[4 * d4 + 3]};
                                ss += (dl.x * dl.x + dl.y * dl.y) + (dl.z * dl.z + dl.w * dl.w); s4[d4] = dl; }
                        }
                    }
                }
            if (valid) {
                const float rs = (1.0f / sqrtf(ss * (1.f / 128.f) + EPS)) * (1.f - lam_init);
                const float* gn = (C.P.in[20]) + l * 128;
                for (int ch = 0; ch < 2; ++ch) {
#pragma unroll
                    for (int d4 = 0; d4 < 16; ++d4) { const f32x4 dl = ((const f32x4*)(sc1 + ch * 64))[d4]; const f32x4 g4 = ((const f32x4*)(gn + ch * 64))[d4];
                        o[4 * d4] = dl.x * rs * g4.x; o[4 * d4 + 1] = dl.y * rs * g4.y; o[4 * d4 + 2] = dl.z * rs * g4.z; o[4 * d4 + 3] = dl.w * rs * g4.w; }
                    store_o64(BR + orow * BRW + 1024 + hc * 128 + ch * 64, o);
                }
            }
        } else {
            const int h = hitem - 20;
            bf16_t* QD = (bf16_t*)(C.P.ws + WS_QD); bf16_t* KVD = (bf16_t*)(C.P.ws + WS_KVD);
            a.q = QD + h * 96; a.qpitch = 768; a.k1 = KVD + h * 128; a.k1pitch = 1024; a.k2 = PQKV + C_KR; a.k2pitch = PQW; a.v = KVD + h * 128 + 64; a.vpitch = 1024;
            nattn_core<96, 64>(C.lds_f, C.tid, a, o);
            if (valid) store_o64(BR + orow * BRW + 1536 + h * 64, o);
        }
    }
}

__device__ __forceinline__ void ph_g3(const Ctx& C, int l) {
    const int nrt = (l == 0 ? NT : NL) / 128;
    for (int it = C.blk; it < nrt * 16; it += C.nblk) {
        const int row0 = (it >> 4) * 128, col0 = (it & 15) * 64;
        const int ty = C.tid >> 4, tx = C.tid & 15;
        float tot[4][4];
#pragma unroll
        for (int i = 0; i < 4; ++i)
#pragma unroll
            for (int j = 0; j < 4; ++j) tot[i][j] = 0.f;
        for (int n = 0; n < 4; ++n) {
            const float* W = (C.P.in[29]) + (size_t)(l * 4 + n) * 512 * 1024;
            float part[4][4];
            ngemm_tile(C.lds_f, C.tid, 512,
                [&](int i, int k) { return ((bf16_t*)(C.P.ws + WS_BR)) + (size_t)(row0 + i) * BRW + n * 512 + k; },
                [&](int k, int j) { return W[(size_t)k * 1024 + col0 + j]; }, part);
#pragma unroll
            for (int i = 0; i < 4; ++i) {
                const u32x2 g = *(const u32x2*)(((bf16_t*)(C.P.ws + WS_PG)) + (size_t)(row0 + ty * 4 + i) * PGW + n * 1024 + col0 + tx * 4);
                tot[i][0] += bf2f(g.x & 0xffffu) * part[i][0]; tot[i][1] += bf2f(g.x >> 16) * part[i][1]; tot[i][2] += bf2f(g.y & 0xffffu) * part[i][2]; tot[i][3] += bf2f(g.y >> 16) * part[i][3];
            }
        }
#pragma unroll
        for (int i = 0; i < 4; ++i) { u32x2 o; o.x = pk2(tot[i][0], tot[i][1]); o.y = pk2(tot[i][2], tot[i][3]); *(u32x2*)(((bf16_t*)(C.P.ws + WS_MERGED)) + (size_t)(row0 + ty * 4 + i) * 1024 + col0 + tx * 4) = o; }
    }
}
__device__ __forceinline__ void resid_store(const Ctx& C, int l, int mi, bool first, int row, int n, const float* a) {
    const int mrow = row < NL ? (row >> 11) : 8;
    const f32x4 mv = *(const f32x4*)(((float*)(C.P.ws + WS_MOD)) + (size_t)(l * 9 + mrow) * 6144 + mi * 1024 + n);
    float* dst = row < NL ? (C.P.out) + (size_t)row * 1024 + n : ((float*)(C.P.ws + WS_CX)) + (size_t)(row - NL) * 1024 + n;
    const float* base = first ? (row < NL ? (C.P.in[0]) + (size_t)row * 1024 + n : (C.P.in[2]) + (size_t)(row - NL) * 1024 + n) : dst;
    const f32x4 b = *(const f32x4*)base;
    *(f32x4*)dst = (f32x4){b.x + mv.x * a[0], b.y + mv.y * a[1], b.z + mv.z * a[2], b.w + mv.w * a[3]};
}
__device__ __forceinline__ void ph_g4(const Ctx& C, int l) {
    const float* W = (C.P.in[30]) + (size_t)l * 1024 * 1024;
    const int nrt = (l == 0 ? NT : NL) / 128;
    for (int it = C.blk; it < nrt * 16; it += C.nblk) {
        const int row0 = (it >> 4) * 128, col0 = (it & 15) * 64;
        float acc[4][4];
        ngemm_tile(C.lds_f, C.tid, 1024,
            [&](int i, int k) { return ((bf16_t*)(C.P.ws + WS_MERGED)) + (size_t)(row0 + i) * 1024 + k; },
            [&](int k, int j) { return W[(size_t)k * 1024 + col0 + j]; }, acc);
        NG_EPI(acc, [&](int i, int j0, const float* a) { resid_store(C, l, 2, l == 0, row0 + i, col0 + j0, a); });
    }
}
__device__ __forceinline__ void ph_g5(const Ctx& C) {
    for (int it = C.blk; it < (NT / 128) * 88; it += C.nblk) {
        const int row0 = (it / 88) * 128, col0 = (it % 88) * 64;
        float acc[4][4];
        ngemm_tile(C.lds_f, C.tid, 1024,
            [&](int i, int k) { return ((bf16_t*)(C.P.ws + WS_XN)) + (size_t)(row0 + i) * 1024 + k; },
            [&](int k, int j) { const int v = col0 + j; return (v & 1) ? (C.P.in[32])[(size_t)k * DFF + (v >> 1)] : (C.P.in[31])[(size_t)k * DFF + (v >> 1)]; }, acc);
        NG_EPI(acc, [&](int i, int j0, const float* a) { const int jj = (col0 + j0) >> 1; *(unsigned*)(((bf16_t*)(C.P.ws + WS_H)) + (size_t)(row0 + i) * DFF + jj) = pk2(siluf_(a[0]) * a[1], siluf_(a[2]) * a[3]); });
    }
}
__device__ __forceinline__ void ph_g6(const Ctx& C) {
    for (int it = C.blk; it < (NT / 128) * 16; it += C.nblk) {
        const int row0 = (it >> 4) * 128, col0 = (it & 15) * 64;
        float acc[4][4];
        ngemm_tile(C.lds_f, C.tid, DFF,
            [&](int i, int k) { return ((bf16_t*)(C.P.ws + WS_H)) + (size_t)(row0 + i) * DFF + k; },
            [&](int k, int j) { return (C.P.in[33])[(size_t)k * 1024 + col0 + j]; }, acc);
        NG_EPI(acc, [&](int i, int j0, const float* a) { resid_store(C, 0, 5, false, row0 + i, col0 + j0, a); });
    }
}

__device__ __forceinline__ void moe_starts(const Ctx& C, int (&cnt)[8], int (&ps)[9]) {
    ps[0] = 0;
#pragma unroll
    for (int e = 0; e < 8; ++e) { cnt[e] = __hip_atomic_load(&((int*)(C.P.ws + WS_CNT))[e], __ATOMIC_RELAXED, __HIP_MEMORY_SCOPE_AGENT); ps[e + 1] = ps[e] + ((cnt[e] + 255) & ~255); }
}
__device__ __forceinline__ void ph_assign(const Ctx& C) {
    int cnt[8], ps[9]; moe_starts(C, cnt, ps);
    const int gw = C.blk * 8 + C.wave, NGW = C.nblk * 8;
    for (int t0 = gw * 64; t0 < NL; t0 += NGW * 64) {
        const int tok = t0 + C.lane; const int ee = ((int*)(C.P.ws + WS_ROUTE_E))[tok];
#pragma unroll
        for (int k = 0; k < 2; ++k) {
            const int my = (ee >> (8 * k)) & 0xff; int pos = 0;
#pragma unroll
            for (int e = 0; e < 8; ++e) {
                const unsigned long long mask = __ballot(my == e);
                if (mask) {
                    int base = 0; const int leader = __ffsll((long long)mask) - 1;
                    if (C.lane == leader) base = atomicAdd(&((int*)(C.P.ws + WS_CNT))[16 + e], (int)__popcll(mask));
                    base = __shfl(base, leader);
                    if (my == e) pos = ps[e] + base + (int)__popcll(mask & ((1ull << C.lane) - 1ull));
                }
            }
            ((int*)(C.P.ws + WS_ROWMAP))[pos] = tok; ((int*)(C.P.ws + WS_POS))[2 * tok + k] = pos;
        }
    }
    if (C.blk == 0) {
#pragma unroll
        for (int e = 0; e < 8; ++e) for (int i = cnt[e] + C.tid; i < ps[e + 1] - ps[e]; i += NTHREADS) ((int*)(C.P.ws + WS_ROWMAP))[ps[e] + i] = -1;
    }
}
__device__ __forceinline__ int moe_expert_of(const int (&ps)[9], int p0) {
    int e = 0;
#pragma unroll
    for (int q = 1; q < 8; ++q) if (p0 >= ps[q]) e = q;
    return e;
}
__device__ __forceinline__ void ph_g7(const Ctx& C) {
    int cnt[8], ps[9]; moe_starts(C, cnt, ps);
    const int nrt = ps[8] / 128;
    for (int it = C.blk; it < nrt * 112; it += C.nblk) {
        const int p0 = (it / 112) * 128, col0 = (it % 112) * 64;
        const int e = moe_expert_of(ps, p0);
        int cnt_e = 0;
#pragma unroll
        for (int q = 0; q < 8; ++q) if (q == e) cnt_e = cnt[q];
        int ps_e = 0;
#pragma unroll
        for (int q = 0; q < 8; ++q) if (q == e) ps_e = ps[q];
        if (p0 >= ps_e + cnt_e) continue;
        const float* W1 = (C.P.in[35]) + (size_t)e * 1024 * EFF; const float* W3 = (C.P.in[36]) + (size_t)e * 1024 * EFF;
        float acc[4][4];
        ngemm_tile(C.lds_f, C.tid, 1024,
            [&](int i, int k) { const int tok = ((int*)(C.P.ws + WS_ROWMAP))[p0 + i]; return tok < 0 ? (const bf16_t*)nullptr : ((bf16_t*)(C.P.ws + WS_XN)) + (size_t)tok * 1024 + k; },
            [&](int k, int j) { const int v = col0 + j; return (v & 1) ? W3[(size_t)k * EFF + (v >> 1)] : W1[(size_t)k * EFF + (v >> 1)]; }, acc);
        NG_EPI(acc, [&](int i, int j0, const float* a) { const int jj = (col0 + j0) >> 1; *(unsigned*)(((bf16_t*)(C.P.ws + WS_HM)) + (size_t)(p0 + i) * EFF + jj) = pk2(siluf_(a[0]) * a[1], siluf_(a[2]) * a[3]); });
    }
}
__device__ __forceinline__ void ph_g8(const Ctx& C) {
    int cnt[8], ps[9]; moe_starts(C, cnt, ps);
    const int nrt = ps[8] / 128;
    for (int it = C.blk; it < nrt * 16; it += C.nblk) {
        const int p0 = (it >> 4) * 128, col0 = (it & 15) * 64;
        const int e = moe_expert_of(ps, p0);
        int cnt_e = 0, ps_e = 0;
#pragma unroll
        for (int q = 0; q < 8; ++q) if (q == e) { cnt_e = cnt[q]; ps_e = ps[q]; }
        if (p0 >= ps_e + cnt_e) continue;
        const float* W2 = (C.P.in[37]) + (size_t)e * EFF * 1024;
        float acc[4][4];
        ngemm_tile(C.lds_f, C.tid, EFF,
            [&](int i, int k) { return ((bf16_t*)(C.P.ws + WS_HM)) + (size_t)(p0 + i) * EFF + k; },
            [&](int k, int j) { return W2[(size_t)k * 1024 + col0 + j]; }, acc);
        NG_EPI(acc, [&](int i, int j0, const float* a) { u32x2 o; o.x = pk2(a[0], a[1]); o.y = pk2(a[2], a[3]); *(u32x2*)(((bf16_t*)(C.P.ws + WS_YM)) + (size_t)(p0 + i) * 1024 + col0 + j0) = o; });
    }
}
__device__ __forceinline__ void ph_combine(const Ctx& C) {
    const int gw = C.blk * 8 + C.wave, NGW = C.nblk * 8;
    for (int r = gw; r < NL; r += NGW) {
        const int p0 = ((int*)(C.P.ws + WS_POS))[2 * r], p1 = ((int*)(C.P.ws + WS_POS))[2 * r + 1]; const float w0 = ((float*)(C.P.ws + WS_ROUTE_W))[2 * r], w1 = ((float*)(C.P.ws + WS_ROUTE_W))[2 * r + 1];
        const float* m5 = ((float*)(C.P.ws + WS_MOD)) + (size_t)(9 + (r >> 11)) * 6144 + 5 * 1024;
#pragma unroll
        for (int j = 0; j < 4; ++j) {
            const int c4 = C.lane + 64 * j;
            const u32x2 a = ((const u32x2*)(((bf16_t*)(C.P.ws + WS_YM)) + (size_t)p0 * 1024))[c4], b = ((const u32x2*)(((bf16_t*)(C.P.ws + WS_YM)) + (size_t)p1 * 1024))[c4];
            const f32x4 mv = ((const f32x4*)m5)[c4]; f32x4 o = ((const f32x4*)((C.P.out) + (size_t)r * 1024))[c4];
            o.x += mv.x * (w0 * bf2f(a.x & 0xffffu) + w1 * bf2f(b.x & 0xffffu)); o.y += mv.y * (w0 * bf2f(a.x >> 16) + w1 * bf2f(b.x >> 16));
            o.z += mv.z * (w0 * bf2f(a.y & 0xffffu) + w1 * bf2f(b.y & 0xffffu)); o.w += mv.w * (w0 * bf2f(a.y >> 16) + w1 * bf2f(b.y >> 16));
            ((f32x4*)((C.P.out) + (size_t)r * 1024))[c4] = o;
        }
    }
}

#define LAS __attribute__((address_space(3)))
typedef short bf16x8 __attribute__((ext_vector_type(8)));
constexpr int BM = 256, BK = 64, HALF = 128, HTB = HALF * BK * 2, NXCD = 8, WGM = 8;
__device__ __forceinline__ int lds_byte(int r, int c) { const int st = (r >> 4) * 2 + (c >> 5), rr = r & 15, cc = c & 31, ob = rr * 64 + cc * 2; return st * 1024 + (ob ^ (((ob >> 9) & 1) << 5)); }
__device__ __forceinline__ void stage_rc(int b, int& R, int& C) { const int st = b / 1024, sb = b % 1024, swz = sb ^ (((sb >> 9) & 1) << 5); R = (st >> 1) * 16 + swz / 64; C = (st & 1) * 32 + (swz % 64) / 2; }
__device__ __forceinline__ int perm32(int rho) { const int n = rho >> 4, i = rho & 15; return 8 * (i >> 2) + 4 * n + (i & 3); }
__device__ __forceinline__ unsigned cvt_pk_bf16(float lo, float hi) { f32x2_t v = {lo, hi}; bf16x2_t b = __builtin_convertvector(v, bf16x2_t); return __builtin_bit_cast(unsigned, b); }

struct GUnit { const char* A; const char* B; int pm, pn, aux; };
__device__ __forceinline__ bool static_order(int nM, int nN, int G, int c, int i, int& pm, int& pn) {
    const int nwg = nM * nN; const long L = (long)i * G + c; if (L >= nwg) return false;
    int wgid = (int)L; { const int q = nwg / NXCD, r = nwg % NXCD, xcd = wgid % NXCD, off = wgid / NXCD; wgid = (xcd < r ? xcd * (q + 1) : r * (q + 1) + (xcd - r) * q) + off; }
    const int nig = WGM * nN, gid = wgid / nig, fm = gid * WGM, gsz = (nM - fm) < WGM ? (nM - fm) : WGM;
    pm = fm + ((wgid % nig) % gsz); pn = (wgid % nig) / gsz; return true;
}

typedef f32x4 Acc[2][2][4][2];
template <bool PERM, bool GATHER, bool HALFN, class Sched, class Epi>
__device__ __forceinline__ void gemm_phase_t(LAS unsigned char* lds, const int K, const int lda, const Sched& S, Epi& E) {
    const int tid = threadIdx.x, wid = __builtin_amdgcn_readfirstlane(tid >> 6), lane = tid & 63, wr = wid >> 2, wc = wid & 3, fr = lane & 15, fq = lane >> 4;
    const int nt = K / BK;
    unsigned voffB[2]; int RA[2], CA[2];
#pragma unroll
    for (int i = 0; i < 2; ++i) { int R, C; stage_rc(tid * 16 + i * 8192, R, C); const int Rb = PERM ? ((R & ~31) + perm32(R & 31)) : R; voffB[i] = (unsigned)(Rb * K + C) * 2u; RA[i] = R; CA[i] = C; }
    const size_t kstep = (size_t)(BK * 2);
    const size_t hstepB = (size_t)HALF * K * 2;
    const unsigned ldsw = (unsigned)wid * 1024u;
    const int aoff = lds_byte(wr * 64 + fr, fq * 8), boff = lds_byte(wc * 32 + fr, fq * 8);
#define PG8_SA(b, h) (((b) * 2 + (h)) * HTB)
#define PG8_SB(b, h) ((4 + (b) * 2 + (h)) * HTB)
#define PG8_STAGE(bufoff, gbase, voff) do { _Pragma("unroll") for (int _i = 0; _i < 2; ++_i) \
        __builtin_amdgcn_global_load_lds((const unsigned*)((const char*)(gbase) + (voff)[_i]), (LAS unsigned*)(lds + (bufoff) + ldsw + _i * 8192), 16, 0, 0); } while (0)
#define PG8_LDA(dst, b, h) do { _Pragma("unroll") for (int m = 0; m < 4; ++m) _Pragma("unroll") for (int k = 0; k < 2; ++k) dst[m][k] = *(const LAS bf16x8*)(lds + PG8_SA(b, h) + aoff + m * 2048 + k * 1024); } while (0)
#define PG8_LDB(dst, b, h) do { _Pragma("unroll") for (int n = 0; n < 2; ++n) _Pragma("unroll") for (int k = 0; k < 2; ++k) dst[n][k] = *(const LAS bf16x8*)(lds + PG8_SB(b, h) + boff + n * 2048 + k * 1024); } while (0)
#define PG8_MMA(ai, bj, At, Bt) do { __builtin_amdgcn_s_setprio(1); _Pragma("unroll") for (int m = 0; m < 4; ++m) _Pragma("unroll") for (int n = 0; n < 2; ++n) _Pragma("unroll") for (int k = 0; k < 2; ++k) \
        acc[ai][bj][m][n] = __builtin_amdgcn_mfma_f32_16x16x32_bf16(Bt[n][k], At[m][k], acc[ai][bj][m][n], 0, 0, 0); __builtin_amdgcn_s_setprio(0); } while (0)
#define PG8_WAIT_V(n) asm volatile("s_waitcnt vmcnt(" #n ")" ::: "memory")
#define PG8_WAIT_L(n) asm volatile("s_waitcnt lgkmcnt(" #n ")" ::: "memory")
#define PG8_BAR __builtin_amdgcn_s_barrier()
#define PG8_SCHED __builtin_amdgcn_sched_barrier(0)
#define PG8_OFFA(u, o) do { _Pragma("unroll") for (int h_ = 0; h_ < 2; ++h_) _Pragma("unroll") for (int i_ = 0; i_ < 2; ++i_) { const int row_ = h_ * HALF + RA[i_]; \
        if constexpr (GATHER) o[h_][i_] = S.row_off(u, row_) + (unsigned)CA[i_] * 2u; else o[h_][i_] = (unsigned)(row_ * lda + CA[i_]) * 2u; } } while (0)
    GUnit cur, nxt; int ui = 0;
    if (!S.next(0, cur)) return;
    Acc acc;
#pragma unroll
    for (int a = 0; a < 2; ++a)
#pragma unroll
        for (int b = 0; b < 2; ++b)
#pragma unroll
            for (int m = 0; m < 4; ++m)
#pragma unroll
                for (int n = 0; n < 2; ++n) acc[a][b][m][n] = (f32x4){0.f, 0.f, 0.f, 0.f};
    bf16x8 At[4][2], B0[2][2], B1[2][2];
    unsigned oc[2][2], on[2][2];
    PG8_OFFA(cur, oc);
#pragma unroll
    for (int h = 0; h < 2; ++h)
#pragma unroll
        for (int i = 0; i < 2; ++i) on[h][i] = oc[h][i];
    const char* cA = cur.A; const char* cB = cur.B;
    if constexpr (HALFN) {
        PG8_STAGE(PG8_SB(0, 0), cB, voffB); PG8_STAGE(PG8_SA(0, 0), cA, oc[0]); PG8_STAGE(PG8_SA(0, 1), cA, oc[1]);
        if (wr == 1) PG8_BAR;
        PG8_WAIT_V(2); PG8_BAR;
        PG8_STAGE(PG8_SB(1, 0), cB + kstep, voffB); PG8_STAGE(PG8_SA(1, 0), cA + kstep, oc[0]);
        PG8_WAIT_V(4); PG8_BAR;
    } else {
    PG8_STAGE(PG8_SB(0, 0), cB, voffB); PG8_STAGE(PG8_SB(0, 1), cB + hstepB, voffB); PG8_STAGE(PG8_SA(0, 0), cA, oc[0]); PG8_STAGE(PG8_SA(0, 1), cA, oc[1]);
    if (wr == 1) PG8_BAR;
    PG8_WAIT_V(2); PG8_BAR;
    PG8_STAGE(PG8_SB(1, 0), cB + kstep, voffB); PG8_STAGE(PG8_SA(1, 0), cA + kstep, oc[0]); PG8_STAGE(PG8_SB(1, 1), cB + hstepB + kstep, voffB);
    PG8_WAIT_V(6); PG8_BAR;
    }
    for (;;) {
        const bool has_next = S.next(ui + 1, nxt);
        const char* nA = has_next ? nxt.A : cA; const char* nB = has_next ? nxt.B : cB;
        if constexpr (GATHER) { if (has_next) PG8_OFFA(nxt, on); }
        for (int t = 0; t < nt; t += 2) {
            const bool last = (t == nt - 2);
            const char* a1 = cA + (size_t)(t + 1) * kstep;
            const char* a2 = last ? nA : cA + (size_t)(t + 2) * kstep; const char* b2 = last ? nB : cB + (size_t)(t + 2) * kstep;
            const char* a3 = a2 + kstep; const char* b3 = b2 + kstep;
            unsigned o2[2][2];
#pragma unroll
            for (int h = 0; h < 2; ++h)
#pragma unroll
                for (int i = 0; i < 2; ++i) { if constexpr (GATHER) o2[h][i] = last ? on[h][i] : oc[h][i]; else o2[h][i] = oc[h][i]; }
            if constexpr (HALFN) {
            PG8_LDB(B0, 0, 0); PG8_SCHED; PG8_LDA(At, 0, 0); PG8_STAGE(PG8_SA(1, 1), a1, oc[1]);
            PG8_WAIT_V(6); PG8_WAIT_L(0); PG8_BAR; PG8_MMA(0, 0, At, B0); PG8_BAR; PG8_SCHED;
            PG8_LDA(At, 0, 1); PG8_STAGE(PG8_SB(0, 0), b2, voffB); PG8_STAGE(PG8_SA(0, 0), a2, o2[0]);
            PG8_WAIT_V(6); PG8_WAIT_L(0); PG8_BAR; PG8_MMA(1, 0, At, B0); PG8_BAR; PG8_SCHED;
            PG8_LDB(B0, 1, 0); PG8_SCHED; PG8_LDA(At, 1, 0); PG8_STAGE(PG8_SA(0, 1), a2, o2[1]);
            PG8_WAIT_V(6); PG8_WAIT_L(0); PG8_BAR; PG8_MMA(0, 0, At, B0); PG8_BAR; PG8_SCHED;
            PG8_LDA(At, 1, 1); PG8_STAGE(PG8_SB(1, 0), b3, voffB); PG8_STAGE(PG8_SA(1, 0), a3, o2[0]);
            PG8_WAIT_V(6); PG8_WAIT_L(0); PG8_BAR; PG8_MMA(1, 0, At, B0); PG8_BAR; PG8_SCHED;
            } else {
            PG8_LDB(B0, 0, 0); PG8_LDB(B1, 0, 1); PG8_SCHED; PG8_LDA(At, 0, 0); PG8_STAGE(PG8_SA(1, 1), a1, oc[1]);
            PG8_WAIT_V(8); PG8_WAIT_L(0); PG8_BAR; PG8_MMA(0, 0, At, B0); PG8_MMA(0, 1, At, B1); PG8_BAR; PG8_SCHED;
            PG8_LDA(At, 0, 1); PG8_STAGE(PG8_SB(0, 0), b2, voffB); PG8_STAGE(PG8_SB(0, 1), b2 + hstepB, voffB); PG8_STAGE(PG8_SA(0, 0), a2, o2[0]);
            PG8_WAIT_V(8); PG8_WAIT_L(0); PG8_BAR; PG8_MMA(1, 0, At, B0); PG8_MMA(1, 1, At, B1); PG8_BAR; PG8_SCHED;
            PG8_LDB(B0, 1, 0); PG8_LDB(B1, 1, 1); PG8_SCHED; PG8_LDA(At, 1, 0); PG8_STAGE(PG8_SA(0, 1), a2, o2[1]);
            PG8_WAIT_V(8); PG8_WAIT_L(0); PG8_BAR; PG8_MMA(0, 0, At, B0); PG8_MMA(0, 1, At, B1); PG8_BAR; PG8_SCHED;
            PG8_LDA(At, 1, 1); PG8_STAGE(PG8_SB(1, 0), b3, voffB); PG8_STAGE(PG8_SB(1, 1), b3 + hstepB, voffB); PG8_STAGE(PG8_SA(1, 0), a3, o2[0]);
            PG8_WAIT_V(8); PG8_WAIT_L(0); PG8_BAR; PG8_MMA(1, 0, At, B0); PG8_MMA(1, 1, At, B1); PG8_BAR; PG8_SCHED;
            }
        }
        if (wr == 0) PG8_BAR;
        E(acc, cur, wr, wc, fr, fq);
        if (!has_next) break;
#pragma unroll
        for (int a = 0; a < 2; ++a)
#pragma unroll
            for (int b = 0; b < 2; ++b)
#pragma unroll
                for (int m = 0; m < 4; ++m)
#pragma unroll
                    for (int n = 0; n < 2; ++n) acc[a][b][m][n] = (f32x4){0.f, 0.f, 0.f, 0.f};
        cur = nxt; cA = nA; cB = nB; ++ui;
        if constexpr (GATHER) {
#pragma unroll
            for (int h = 0; h < 2; ++h)
#pragma unroll
                for (int i = 0; i < 2; ++i) oc[h][i] = on[h][i];
        }
        if (wr == 1) PG8_BAR;
    }
    PG8_WAIT_V(0);
    PG8_BAR;
#undef PG8_SA
#undef PG8_SB
#undef PG8_STAGE
#undef PG8_LDA
#undef PG8_LDB
#undef PG8_MMA
#undef PG8_WAIT_V
#undef PG8_WAIT_L
#undef PG8_BAR
#undef PG8_SCHED
#undef PG8_OFFA
}

template <bool PERM, bool GATHER, class Sched, class Epi>
__device__ __forceinline__ void gemm_phase(LAS unsigned char* lds, const int K, const int lda, const Sched& S, const Epi& E) { Epi E2 = E; gemm_phase_t<PERM, GATHER, false>(lds, K, lda, S, E2); }

__device__ __forceinline__ u32x4 pack8(const f32x4 v0, const f32x4 v1) { u32x4 w; w.x = cvt_pk_bf16(v0[0], v0[1]); w.y = cvt_pk_bf16(v0[2], v0[3]); w.z = cvt_pk_bf16(v1[0], v1[1]); w.w = cvt_pk_bf16(v1[2], v1[3]); return w; }
__device__ __forceinline__ float fsig(float x) { return __builtin_amdgcn_rcpf(1.f + __builtin_amdgcn_exp2f(-LOG2E * x)); }
__device__ __forceinline__ f32x4 sig4(f32x4 v) { return (f32x4){fsig(v[0]), fsig(v[1]), fsig(v[2]), fsig(v[3])}; }
__device__ __forceinline__ void epi_store_bf16(const Acc& acc, bf16_t* O, int ldc, int row0, int col0, bool sig, int wr, int wc, int fr, int fq) {
#pragma unroll
    for (int ai = 0; ai < 2; ++ai)
#pragma unroll
        for (int m = 0; m < 4; ++m) { bf16_t* rowp = O + (size_t)(row0 + ai * HALF + wr * 64 + m * 16 + fr) * ldc + col0 + wc * 32 + 8 * fq;
#pragma unroll
            for (int bj = 0; bj < 2; ++bj) { f32x4 v0 = acc[ai][bj][m][0], v1 = acc[ai][bj][m][1]; if (sig) { v0 = sig4(v0); v1 = sig4(v1); } *(u32x4*)(rowp + bj * HALF) = pack8(v0, v1); } }
}

template <class RM>
__device__ __forceinline__ void transpose_item(const float* W, int K, int N, int ldk, bf16_t* WT, RM rowmap, const float* ksc, float* scr, int item, int lane) {
    const int nblk = N / 32, kb = item / nblk, nb = item % nblk, k0 = 64 * kb, n0 = 32 * nb;
    float tv[32];
#pragma unroll
    for (int i = 0; i < 32; ++i) tv[i] = W[(size_t)(k0 + 2 * i + (lane >> 5)) * N + n0 + (lane & 31)];
    if (ksc) {
#pragma unroll
        for (int i = 0; i < 32; ++i) tv[i] *= ksc[k0 + 2 * i + (lane >> 5)];
    }
#pragma unroll
    for (int i = 0; i < 32; ++i) scr[(2 * i + (lane >> 5)) * 33 + (lane & 31)] = tv[i];
    asm volatile("s_waitcnt lgkmcnt(0)" ::: "memory");
    const int c = lane & 7;
#pragma unroll
    for (int j = 0; j < 4; ++j) { const int n = (lane >> 3) + 8 * j; const float* s = scr + (8 * c) * 33 + n;
        u32x4 o; o.x = pk2(s[0 * 33], s[1 * 33]); o.y = pk2(s[2 * 33], s[3 * 33]); o.z = pk2(s[4 * 33], s[5 * 33]); o.w = pk2(s[6 * 33], s[7 * 33]);
        *(u32x4*)(WT + (size_t)rowmap(n0 + n) * ldk + k0 + 8 * c) = o; }
    asm volatile("s_waitcnt lgkmcnt(0)" ::: "memory");
}

constexpr size_t WS_WIN_T = 76 * MiB;
constexpr size_t WS_WBR_T = 108 * MiB;
constexpr size_t WS_WOUT_T = 116 * MiB;
constexpr size_t WS_WUQ_T = 120 * MiB;
constexpr size_t WS_WUKV_T = 121 * MiB + 512 * 1024;
constexpr size_t WS_FFGU_T = 123 * MiB + 512 * 1024;
constexpr size_t WS_FFD_T = 134 * MiB + 512 * 1024;
constexpr size_t WS_MACC = 184 * MiB;
constexpr size_t WS_W13_T = 40 * MiB;
constexpr size_t WS_W2_T = 152 * MiB;
constexpr int CONV_LDS_OFF = 65536;

template <class RM>
__device__ __forceinline__ void transpose_item64(const float* W, int K, int N, bf16_t* WT, RM rowmap, float* scr, int item, int lane) {
    const int nblk = N / 64, kb = item / nblk, nb = item % nblk, k0 = 64 * kb, n0 = 64 * nb;
#pragma unroll
    for (int h = 0; h < 2; ++h) {
        float tv[32];
#pragma unroll
        for (int i = 0; i < 32; ++i) tv[i] = W[(size_t)(k0 + 32 * h + i) * N + n0 + lane];
#pragma unroll
        for (int i = 0; i < 32; ++i) scr[(32 * h + i) * 65 + lane] = tv[i];
    }
    asm volatile("s_waitcnt lgkmcnt(0)" ::: "memory");
    const int c = lane & 7;
#pragma unroll
    for (int j = 0; j < 8; ++j) { const int n = (lane >> 3) + 8 * j; const float* sp = scr + (8 * c) * 65 + n;
        u32x4 o; o.x = pk2(sp[0 * 65], sp[1 * 65]); o.y = pk2(sp[2 * 65], sp[3 * 65]); o.z = pk2(sp[4 * 65], sp[5 * 65]); o.w = pk2(sp[6 * 65], sp[7 * 65]);
        *(u32x4*)(WT + (size_t)rowmap(n0 + n) * K + k0 + 8 * c) = o; }
    asm volatile("s_waitcnt lgkmcnt(0)" ::: "memory");
}

struct ConvJob { const float* W; bf16_t* WT; const float* ksc; int K, N, kind, nitems, ldk; };
__device__ __forceinline__ int conv_rowmap(int kind, int n) {
    return kind == 0 ? n : (kind == 1 ? (n < 3872 ? n : n + 224) : ((n >> 7) * 256 + (n & 127) + (kind == 3 ? 128 : 0)));
}
__device__ __forceinline__ ConvJob conv_job_small(const Ctx& C, int j) {
    ConvJob J; J.ksc = nullptr; J.kind = 0;
    if (j < 2) { J.W = C.P.in[8] + (size_t)j * 1024 * IN_COLS; J.WT = (bf16_t*)(C.P.ws + WS_WIN_T) + (size_t)j * 8192 * 1024; J.K = 1024; J.N = IN_COLS; J.kind = 1; }
    else if (j < 4) { const int l = j - 2; J.W = C.P.in[23] + (size_t)l * 512 * 768; J.WT = (bf16_t*)(C.P.ws + WS_WUQ_T) + (size_t)l * 768 * 512; J.K = 512; J.N = 768; J.ksc = C.P.in[21] + l * 512; }
    else if (j < 6) { const int l = j - 4; J.W = C.P.in[24] + (size_t)l * 256 * 1024; J.WT = (bf16_t*)(C.P.ws + WS_WUKV_T) + (size_t)l * 1024 * 512; J.K = 256; J.N = 1024; J.ksc = C.P.in[22] + l * 256; J.ldk = 512; }
    else if (j < 14) { const int q = j - 6; J.W = C.P.in[29] + (size_t)q * 512 * 1024; J.WT = (bf16_t*)(C.P.ws + WS_WBR_T) + (size_t)q * 1024 * 512; J.K = 512; J.N = 1024; }
    else if (j < 16) { const int l = j - 14; J.W = C.P.in[30] + (size_t)l * 1024 * 1024; J.WT = (bf16_t*)(C.P.ws + WS_WOUT_T) + (size_t)l * 1024 * 1024; J.K = 1024; J.N = 1024; }
    else if (j == 16) { J.W = C.P.in[31]; J.WT = (bf16_t*)(C.P.ws + WS_FFGU_T); J.K = 1024; J.N = DFF; J.kind = 2; }
    else if (j == 17) { J.W = C.P.in[32]; J.WT = (bf16_t*)(C.P.ws + WS_FFGU_T); J.K = 1024; J.N = DFF; J.kind = 3; }
    else { J.W = C.P.in[33]; J.WT = (bf16_t*)(C.P.ws + WS_FFD_T); J.K = DFF; J.N = 1024; }
    J.nitems = (J.K / 64) * (J.N / 32); if (j < 4 || j >= 6) J.ldk = J.K;
    return J;
}
__device__ __forceinline__ ConvJob conv_job_moe(const Ctx& C, int j) {
    ConvJob J; J.ksc = nullptr; const int e = j / 3, t = j % 3;
    if (t == 0) { J.W = C.P.in[35] + (size_t)e * 1024 * EFF; J.WT = (bf16_t*)(C.P.ws + WS_W13_T) + (size_t)e * 7168 * 1024; J.K = 1024; J.N = EFF; J.kind = 2; }
    else if (t == 1) { J.W = C.P.in[36] + (size_t)e * 1024 * EFF; J.WT = (bf16_t*)(C.P.ws + WS_W13_T) + (size_t)e * 7168 * 1024; J.K = 1024; J.N = EFF; J.kind = 3; }
    else { J.W = C.P.in[37] + (size_t)e * EFF * 1024; J.WT = (bf16_t*)(C.P.ws + WS_W2_T) + (size_t)e * 1024 * EFF; J.K = EFF; J.N = 1024; J.kind = 0; }
    J.nitems = (J.K / 64) * (J.N / 64); J.ldk = J.K;
    return J;
}
template <bool MOE>
__device__ __forceinline__ void conv_weights(const Ctx& C) {
    float* scr = MOE ? C.lds_f + C.wave * (64 * 65) : (float*)((unsigned char*)C.lds_f + CONV_LDS_OFF) + C.wave * (64 * 33);
    const int gw = C.blk * 8 + C.wave, NGW = C.nblk * 8;
    constexpr int NJ = MOE ? 24 : 19;
    int total = 0;
    for (int j = 0; j < NJ; ++j) total += (MOE ? conv_job_moe(C, j) : conv_job_small(C, j)).nitems;
    for (int it = gw; it < total; it += NGW) {
        int r = it;
        for (int j = 0; j < NJ; ++j) {
            const ConvJob J = MOE ? conv_job_moe(C, j) : conv_job_small(C, j);
            if (r < J.nitems) { const int kind = J.kind;
                if constexpr (MOE) transpose_item64(J.W, J.K, J.N, J.WT, [&](int n) { return conv_rowmap(kind, n); }, scr, r, C.lane);
                else transpose_item(J.W, J.K, J.N, J.ldk, J.WT, [&](int n) { return conv_rowmap(kind, n); }, J.ksc, scr, r, C.lane);
                break; }
            r -= J.nitems;
        }
    }
    if (!MOE) {
        const int gt = C.blk * NTHREADS + C.tid, NGT = C.nblk * NTHREADS;
        for (int i = gt; i < 2 * 1024 * 32; i += NGT) { const int row = i >> 5, q = i & 31; ((u32x4*)((bf16_t*)(C.P.ws + WS_WUKV_T) + (size_t)row * 512 + 256))[q] = (u32x4){0u, 0u, 0u, 0u}; }
    }
    if (!MOE) {
        const int gt = C.blk * NTHREADS + C.tid, NGT = C.nblk * NTHREADS;
        for (int i = gt; i < 2 * 224 * 128; i += NGT) { const int l = i / (224 * 128), q = i % (224 * 128);
            ((u32x4*)((bf16_t*)(C.P.ws + WS_WIN_T) + ((size_t)l * 8192 + 3872) * 1024))[q] = (u32x4){0u, 0u, 0u, 0u}; }
    }
}

__device__ __forceinline__ float silu_mul(float g, float u) { return g * u * __builtin_amdgcn_rcpf(1.f + __builtin_amdgcn_exp2f(-LOG2E * g)); }
__device__ __forceinline__ void epi_swiglu(const Acc& acc, bf16_t* O, int ldc, int row0, int col0, int wr, int wc, int fr, int fq) {
#pragma unroll
    for (int ai = 0; ai < 2; ++ai)
#pragma unroll
        for (int m = 0; m < 4; ++m) {
            f32x4 h0, h1;
#pragma unroll
            for (int q = 0; q < 4; ++q) { h0[q] = silu_mul(acc[ai][0][m][0][q], acc[ai][1][m][0][q]); h1[q] = silu_mul(acc[ai][0][m][1][q], acc[ai][1][m][1][q]); }
            *(u32x4*)(O + (size_t)(row0 + ai * HALF + wr * 64 + m * 16 + fr) * ldc + col0 + wc * 32 + 8 * fq) = pack8(h0, h1);
        }
}
__device__ __forceinline__ void epi_resid(const Ctx& C, const Acc& acc, int l, int mi, bool first, int row0, int col0, int wr, int wc, int fr, int fq) {
#pragma unroll
    for (int ai = 0; ai < 2; ++ai)
#pragma unroll
        for (int m = 0; m < 4; ++m) {
            const int row = row0 + ai * HALF + wr * 64 + m * 16 + fr;
            const int mrow = row < NL ? (row >> 11) : 8;
            const float* modp = (const float*)(C.P.ws + WS_MOD) + (size_t)(l * 9 + mrow) * 6144 + mi * 1024;
            float* dst = row < NL ? C.P.out + (size_t)row * 1024 : (float*)(C.P.ws + WS_CX) + (size_t)(row - NL) * 1024;
            const float* base = first ? (row < NL ? C.P.in[0] + (size_t)row * 1024 : C.P.in[2] + (size_t)(row - NL) * 1024) : dst;
#pragma unroll
            for (int bj = 0; bj < 2; ++bj)
#pragma unroll
                for (int n = 0; n < 2; ++n) { const int col = col0 + bj * HALF + wc * 32 + n * 16 + 4 * fq;
                    const f32x4 b = *(const f32x4*)(base + col), mv = *(const f32x4*)(modp + col); *(f32x4*)(dst + col) = b + mv * acc[ai][bj][m][n]; }
        }
}

struct SchedG1 { const char* A; const char* B; int l, G, c;
    __device__ __forceinline__ bool next(int i, GUnit& u) const {
        const long L = (long)i * G + c; int pm, pn;
        if (l == 0) { if (!static_order(NT / 256, 32, G, c, i, pm, pn)) return false; }
        else {
            const int nlat = (NL / 256) * 32;
            if (L < nlat) { static_order(NL / 256, 32, G, c, i, pm, pn); }
            else { const long L2 = L - nlat; if (L2 >= (NC / 256) * 8) return false; pm = NL / 256 + (int)(L2 >> 3); pn = 8 + (int)(L2 & 7); }
        }
        u.pm = pm; u.pn = pn; u.aux = 0; u.A = A + (size_t)pm * 256 * 1024 * 2; u.B = B + (size_t)pn * 256 * 1024 * 2; return true;
    } };
struct EpiG1 { bf16_t* PQKV; bf16_t* PG;
    __device__ __forceinline__ void operator()(const Acc& acc, const GUnit& u, int wr, int wc, int fr, int fq) const {
        if (u.pn < 16) epi_store_bf16(acc, PQKV, PQW, u.pm * 256, u.pn * 256, false, wr, wc, fr, fq);
        else epi_store_bf16(acc, PG, PGW, u.pm * 256, (u.pn - 16) * 256, true, wr, wc, fr, fq);
    } };
__device__ __forceinline__ void fg1(const Ctx& C, int l) {
    const SchedG1 S{(const char*)(C.P.ws + WS_XN), (const char*)(C.P.ws + WS_WIN_T) + (size_t)l * 8192 * 1024 * 2, l, C.nblk, C.blk};
    const EpiG1 E{(bf16_t*)(C.P.ws + WS_PQKV), (bf16_t*)(C.P.ws + WS_PG)};
    gemm_phase<true, false>((LAS unsigned char*)C.lds_f, 1024, 1024, S, E);
}
struct SchedRect { const char* A; const char* B; size_t astep, bstep; int nM, nN, G, c;
    __device__ __forceinline__ bool next(int i, GUnit& u) const {
        int pm, pn; if (!static_order(nM, nN, G, c, i, pm, pn)) return false;
        u.pm = pm; u.pn = pn; u.aux = 0; u.A = A + (size_t)pm * astep; u.B = B + (size_t)pn * bstep; return true;
    } };
struct EpiPlain { bf16_t* O; int ldc;
    __device__ __forceinline__ void operator()(const Acc& acc, const GUnit& u, int wr, int wc, int fr, int fq) const { epi_store_bf16(acc, O, ldc, u.pm * 256, u.pn * 256, false, wr, wc, fr, fq); } };
struct SchedG2 { const char* PQ; const char* Wq; const char* Wk; int G, c;
    __device__ __forceinline__ bool next(int i, GUnit& u) const {
        const int L = i * G + c;
        if (L < (NT / 256) * 3) { u.pm = L / 3; u.pn = L % 3; u.aux = 0; u.A = PQ + (size_t)u.pm * 256 * PQW * 2 + C_CQ * 2; u.B = Wq + (size_t)u.pn * 256 * 512 * 2; return true; }
        const int L2 = L - (NT / 256) * 3; if (L2 >= (NT / 256) * 4) return false;
        u.pm = L2 >> 2; u.pn = L2 & 3; u.aux = 1; u.A = PQ + (size_t)u.pm * 256 * PQW * 2 + C_CKV * 2; u.B = Wk + (size_t)u.pn * 256 * 512 * 2; return true;
    } };
struct EpiG2 { bf16_t* QD; bf16_t* KVD;
    __device__ __forceinline__ void operator()(const Acc& acc, const GUnit& u, int wr, int wc, int fr, int fq) const {
        if (u.aux == 0) epi_store_bf16(acc, QD, 768, u.pm * 256, u.pn * 256, false, wr, wc, fr, fq); else epi_store_bf16(acc, KVD, 1024, u.pm * 256, u.pn * 256, false, wr, wc, fr, fq);
    } };
__device__ __forceinline__ void fg2(const Ctx& C, int l) {
    const SchedG2 S{(const char*)(C.P.ws + WS_PQKV), (const char*)(C.P.ws + WS_WUQ_T) + (size_t)l * 768 * 512 * 2, (const char*)(C.P.ws + WS_WUKV_T) + (size_t)l * 1024 * 512 * 2, C.nblk, C.blk};
    const EpiG2 E{(bf16_t*)(C.P.ws + WS_QD), (bf16_t*)(C.P.ws + WS_KVD)};
    gemm_phase<true, false>((LAS unsigned char*)C.lds_f, 512, PQW, S, E);
}
struct SchedG3 { const char* BR; const char* W; int nM, G, c;
    __device__ __forceinline__ bool next(int i, GUnit& u) const {
        int pm, pn; if (!static_order(nM, 8, G, c, i >> 2, pm, pn)) return false;
        const int n = i & 3; u.pm = pm; u.pn = pn; u.aux = n;
        u.A = BR + (size_t)pm * 256 * BRW * 2 + (size_t)n * 512 * 2; u.B = W + (size_t)n * 1024 * 512 * 2 + (size_t)pn * 128 * 512 * 2; return true;
    } };
struct EpiG3 { const bf16_t* PG; bf16_t* MERGED; f32x4 tot[2][4][2];
    __device__ __forceinline__ void operator()(const Acc& acc, const GUnit& u, int wr, int wc, int fr, int fq) {
        const int n = u.aux;
#pragma unroll
        for (int ai = 0; ai < 2; ++ai)
#pragma unroll
            for (int m = 0; m < 4; ++m) {
                const size_t row = (size_t)(u.pm * 256 + ai * HALF + wr * 64 + m * 16 + fr);
                const int col = u.pn * 128 + wc * 32 + 8 * fq;
                const u32x4 g = *(const u32x4*)(PG + row * PGW + n * 1024 + col);
                float gg[8]; unpack8(g, gg);
                f32x4 v0 = acc[ai][0][m][0], v1 = acc[ai][0][m][1];
                v0 = (f32x4){v0[0] * gg[0], v0[1] * gg[1], v0[2] * gg[2], v0[3] * gg[3]}; v1 = (f32x4){v1[0] * gg[4], v1[1] * gg[5], v1[2] * gg[6], v1[3] * gg[7]};
                if (n > 0) { v0 += tot[ai][m][0]; v1 += tot[ai][m][1]; }
                tot[ai][m][0] = v0; tot[ai][m][1] = v1;
                if (n == 3) *(u32x4*)(MERGED + row * 1024 + col) = pack8(v0, v1);
            }
    } };
__device__ __forceinline__ void fg3(const Ctx& C, int l) {
    const SchedG3 S{(const char*)(C.P.ws + WS_BR), (const char*)(C.P.ws + WS_WBR_T) + (size_t)l * 4 * 1024 * 512 * 2, (l == 0 ? NT : NL) / 256, C.nblk, C.blk};
    EpiG3 E; E.PG = (const bf16_t*)(C.P.ws + WS_PG); E.MERGED = (bf16_t*)(C.P.ws + WS_MERGED);
#pragma unroll
    for (int a = 0; a < 2; ++a)
#pragma unroll
        for (int m = 0; m < 4; ++m) { E.tot[a][m][0] = (f32x4){0.f, 0.f, 0.f, 0.f}; E.tot[a][m][1] = (f32x4){0.f, 0.f, 0.f, 0.f}; }
    gemm_phase_t<true, false, true>((LAS unsigned char*)C.lds_f, 512, BRW, S, E);
}
struct EpiResid { const Ctx& C; int l, mi; bool first;
    __device__ __forceinline__ void operator()(const Acc& acc, const GUnit& u, int wr, int wc, int fr, int fq) const { epi_resid(C, acc, l, mi, first, u.pm * 256, u.pn * 256, wr, wc, fr, fq); } };
__device__ __forceinline__ void fg4(const Ctx& C, int l) {
    const SchedRect S{(const char*)(C.P.ws + WS_MERGED), (const char*)(C.P.ws + WS_WOUT_T) + (size_t)l * 1024 * 1024 * 2, (size_t)256 * 1024 * 2, (size_t)256 * 1024 * 2, (l == 0 ? NT : NL) / 256, 4, C.nblk, C.blk};
    const EpiResid E{C, l, 2, l == 0};
    gemm_phase<false, false>((LAS unsigned char*)C.lds_f, 1024, 1024, S, E);
}
struct EpiSwiglu { bf16_t* O; int ldc;
    __device__ __forceinline__ void operator()(const Acc& acc, const GUnit& u, int wr, int wc, int fr, int fq) const { epi_swiglu(acc, O, ldc, u.pm * 256, u.pn * 128, wr, wc, fr, fq); } };
__device__ __forceinline__ void fg5(const Ctx& C) {
    const SchedRect S{(const char*)(C.P.ws + WS_XN), (const char*)(C.P.ws + WS_FFGU_T), (size_t)256 * 1024 * 2, (size_t)256 * 1024 * 2, NT / 256, 22, C.nblk, C.blk};
    const EpiSwiglu E{(bf16_t*)(C.P.ws + WS_H), DFF};
    gemm_phase<true, false>((LAS unsigned char*)C.lds_f, 1024, 1024, S, E);
}
__device__ __forceinline__ void fg6(const Ctx& C) {
    const SchedRect S{(const char*)(C.P.ws + WS_H), (const char*)(C.P.ws + WS_FFD_T), (size_t)256 * DFF * 2, (size_t)256 * DFF * 2, NT / 256, 4, C.nblk, C.blk};
    const EpiResid E{C, 0, 5, false};
    gemm_phase<false, false>((LAS unsigned char*)C.lds_f, DFF, DFF, S, E);
}
struct SchedG7 { const char* XN; const char* W; const int* ROWMAP; int ps[9]; int nM, G, c;
    __device__ __forceinline__ bool next(int i, GUnit& u) const {
        int pm, pn; if (!static_order(nM, 28, G, c, i, pm, pn)) return false;
        const int e = moe_expert_of(ps, pm * 256);
        u.pm = pm; u.pn = pn; u.aux = e; u.A = XN; u.B = W + (size_t)e * 7168 * 1024 * 2 + (size_t)pn * 256 * 1024 * 2; return true;
    }
    __device__ __forceinline__ unsigned row_off(const GUnit& u, int row) const { int tok = ROWMAP[u.pm * 256 + row]; tok = tok < 0 ? 0 : tok; return (unsigned)tok * 2048u; } };
__device__ __forceinline__ void fg7(const Ctx& C) {
    SchedG7 S; int cnt[8]; moe_starts(C, cnt, S.ps);
    S.XN = (const char*)(C.P.ws + WS_XN); S.W = (const char*)(C.P.ws + WS_W13_T); S.ROWMAP = (const int*)(C.P.ws + WS_ROWMAP); S.nM = S.ps[8] / 256; S.G = C.nblk; S.c = C.blk;
    const EpiSwiglu E{(bf16_t*)(C.P.ws + WS_HM), EFF};
    gemm_phase<true, true>((LAS unsigned char*)C.lds_f, 1024, 1024, S, E);
}
struct SchedG8 { const char* HM; const char* W; int ps[9]; int nM, G, c;
    __device__ __forceinline__ bool next(int i, GUnit& u) const {
        int pm, pn; if (!static_order(nM, 4, G, c, i, pm, pn)) return false;
        const int e = moe_expert_of(ps, pm * 256);
        u.pm = pm; u.pn = pn; u.aux = e; u.A = HM + (size_t)pm * 256 * EFF * 2; u.B = W + (size_t)e * 1024 * EFF * 2 + (size_t)pn * 256 * EFF * 2; return true;
    } };
__device__ __forceinline__ void fg8(const Ctx& C) {
    SchedG8 S; int cnt[8]; moe_starts(C, cnt, S.ps);
    S.HM = (const char*)(C.P.ws + WS_HM); S.W = (const char*)(C.P.ws + WS_W2_T); S.nM = S.ps[8] / 256; S.G = C.nblk; S.c = C.blk;
    const EpiPlain E{(bf16_t*)(C.P.ws + WS_YM), 1024};
    gemm_phase<true, false>((LAS unsigned char*)C.lds_f, EFF, EFF, S, E);
}

#ifndef FAST_G1
#define FAST_G1 1
#endif
#ifndef FAST_G2
#define FAST_G2 1
#endif
#ifndef FAST_G3
#define FAST_G3 1
#endif
#ifndef FAST_G4
#define FAST_G4 1
#endif
#ifndef FAST_G5
#define FAST_G5 1
#endif
#ifndef FAST_G6
#define FAST_G6 1
#endif
#ifndef FAST_G7
#define FAST_G7 1
#endif
#ifndef FAST_G8
#define FAST_G8 1
#endif
#define FAST_ANY_SMALL (FAST_G1 || FAST_G2 || FAST_G3 || FAST_G4 || FAST_G5 || FAST_G6)
#define FAST_ANY_MOE (FAST_G7 || FAST_G8)

typedef float f32x16 __attribute__((ext_vector_type(16)));
typedef short s16x4 __attribute__((ext_vector_type(4)));
constexpr int FA_STG = 28672, FA_VOFF = 12288, FA_WSF = 4 * FA_STG, FA_IDX = FA_WSF + 2048;
__device__ __forceinline__ int crow(int r, int hi) { return (r & 3) + 8 * (r >> 2) + 4 * hi; }
struct FAttn {
    const bf16_t* q; int qpitch; const bf16_t* k1; int k1pitch; const bf16_t* k2; int k2pitch; const bf16_t* v; int vpitch;
    int qrow0, qpos0, krow_lat, t0, nlat, krow_ctx; bool masked, has_sink; float sink2;
    const float* qgain; const float* qgain2; const float* rq; bool lat;
};
__device__ __forceinline__ s16x4 ds_tr(const LAS unsigned char* p) { return __builtin_bit_cast(s16x4, __builtin_amdgcn_ds_read_tr16_b64_v4i16((LAS s16x4*)p)); }
__device__ __forceinline__ float xhalf(float v) { return __shfl_xor(v, 32); }
__device__ __forceinline__ unsigned cvtpk(float lo, float hi) { f32x2_t v = {lo, hi}; bf16x2_t b = __builtin_convertvector(v, bf16x2_t); return __builtin_bit_cast(unsigned, b); }
#define FA_WAITV(n) asm volatile("s_waitcnt vmcnt(" #n ")" ::: "memory")
__device__ __forceinline__ void glds16(const void* gsrc, unsigned lds_dst) { unsigned keep;
    asm volatile("s_mov_b32 %0, m0\n\ts_mov_b32 m0, %2\n\ts_nop 0\n\tglobal_load_lds_dwordx4 %1, off\n\ts_mov_b32 m0, %0" : "=&s"(keep) : "v"(gsrc), "s"(lds_dst) : "memory"); }
__device__ __forceinline__ float max3f(float a, float b, float c) { float r; asm("v_max3_f32 %0, %1, %2, %3" : "=v"(r) : "v"(a), "v"(b), "v"(c)); return r; }
__device__ __forceinline__ float xhalf_max(float v) { auto rr = __builtin_amdgcn_permlane32_swap(__float_as_uint(v), __float_as_uint(v), false, false); return fmaxf(__uint_as_float(rr[0]), __uint_as_float(rr[1])); }
__device__ __forceinline__ float xhalf_sum(float v) { auto rr = __builtin_amdgcn_permlane32_swap(__float_as_uint(v), __float_as_uint(v), false, false); return __uint_as_float(rr[0]) + __uint_as_float(rr[1]); }
template <int DQK, int DV>
__device__ __forceinline__ void fattn_core(LAS unsigned char* lds, const FAttn& a, f32x16 (&o)[DV / 32]) {
    constexpr bool NEGM = (DV == 64 && DQK == 64);
    constexpr bool PIPE = (DV == 64);
    const int tid = threadIdx.x, lane = tid & 63, r32 = lane & 31, hi = lane >> 5; const int wid = __builtin_amdgcn_readfirstlane(tid >> 6);
    LAS float* wsf = (LAS float*)(lds + FA_WSF) + wid * 64;
    const int ntiles = a.nlat + 4;
    auto tile_row = [&](int tt) { return tt < a.nlat ? a.krow_lat + 64 * (a.t0 + tt) : a.krow_ctx + 64 * (tt - a.nlat); };
    const unsigned lds0 = (unsigned)(size_t)lds;
    auto issue = [&](int tt) {
        const size_t krow = (size_t)tile_row(tt); const unsigned sb = lds0 + (unsigned)((tt & 3) * FA_STG);
        glds16(a.k1 + (krow + lane) * a.k1pitch + wid * 8, (unsigned)__builtin_amdgcn_readfirstlane(sb + wid * 1024));
        if constexpr (DQK == 96) { if (wid < 4) glds16(a.k2 + (krow + lane) * a.k2pitch + wid * 8, (unsigned)__builtin_amdgcn_readfirstlane(sb + (8 + wid) * 1024)); }
#pragma unroll
        for (int j = 0; j < DV / 64; ++j) { const int cw = j * 8 + wid;
            glds16(a.v + (krow + 16 * (cw & 3) + (lane >> 2)) * a.vpitch + (cw >> 2) * 32 + (lane & 3) * 8, (unsigned)__builtin_amdgcn_readfirstlane(sb + FA_VOFF + cw * 1024)); }
    };
    auto wait_tiles = [&](int tiles_left) {
        if (tiles_left <= 0) FA_WAITV(0);
        else if constexpr (DQK == 96) { if (tiles_left == 1) { if (wid < 4) FA_WAITV(3); else FA_WAITV(2); } else { if (wid < 4) FA_WAITV(6); else FA_WAITV(4); } }
        else if constexpr (DV == 128) { if (tiles_left == 1) FA_WAITV(3); else FA_WAITV(6); }
        else { if (tiles_left == 1) FA_WAITV(2); else FA_WAITV(4); }
    };
    bf16x8 qr[DQK / 16];
    {
        const int row = a.qrow0 + wid * 32 + r32;
        const bf16_t* qp = a.q + (size_t)row * a.qpitch + hi * 8;
        float v[DQK / 16][8];
#pragma unroll
        for (int d0 = 0; d0 < DQK / 16; ++d0) unpack8(*(const u32x4*)(qp + d0 * 16), v[d0]);
        const int tq = a.qpos0 + wid * 32 + r32; const float prow = (float)(tq >> 6), pcol = (float)(tq & 63);
        if constexpr (DQK == 64) {
            float ss = 0.f;
#pragma unroll
            for (int d0 = 0; d0 < 4; ++d0)
#pragma unroll
                for (int j = 0; j < 8; ++j) ss += v[d0][j] * v[d0][j];
            const float rinv = __builtin_amdgcn_rsqf(xhalf_sum(ss) * (1.f / 64.f) + EPS) * QSCALE64;
#pragma unroll
            for (int d0 = 0; d0 < 4; ++d0) { const f32x4 g0 = *(const f32x4*)(a.qgain + 16 * d0 + 8 * hi), g1 = *(const f32x4*)(a.qgain + 16 * d0 + 8 * hi + 4);
#pragma unroll
                for (int j = 0; j < 4; ++j) { v[d0][j] *= rinv * g0[j]; v[d0][4 + j] *= rinv * g1[j]; } }
            if (a.lat) {
#pragma unroll
                for (int j = 0; j < 8; ++j) { const float f = inv_freq(8 * hi + j, 16); float s0, c0, s1, c1; __sincosf(prow * f, &s0, &c0); __sincosf(pcol * f, &s1, &c1);
                    const float x1 = v[0][j], x2 = v[2][j], y1 = v[1][j], y2 = v[3][j];
                    v[0][j] = x1 * c0 - x2 * s0; v[2][j] = x1 * s0 + x2 * c0; v[1][j] = y1 * c1 - y2 * s1; v[3][j] = y1 * s1 + y2 * c1; }
            }
        } else {
            const float rq = a.rq[row];
            float ssn = 0.f, ssr = 0.f;
#pragma unroll
            for (int d0 = 0; d0 < 6; ++d0)
#pragma unroll
                for (int j = 0; j < 8; ++j) { v[d0][j] *= rq; if (d0 < 4) ssn += v[d0][j] * v[d0][j]; else ssr += v[d0][j] * v[d0][j]; }
            const float rn = __builtin_amdgcn_rsqf(xhalf_sum(ssn) * (1.f / 64.f) + EPS) * QSCALE96, rr = __builtin_amdgcn_rsqf(xhalf_sum(ssr) * (1.f / 32.f) + EPS) * QSCALE96;
#pragma unroll
            for (int d0 = 0; d0 < 6; ++d0) { const float* gp = d0 < 4 ? a.qgain + 16 * d0 + 8 * hi : a.qgain2 + 16 * (d0 - 4) + 8 * hi; const float rs = d0 < 4 ? rn : rr;
                const f32x4 g0 = *(const f32x4*)gp, g1 = *(const f32x4*)(gp + 4);
#pragma unroll
                for (int j = 0; j < 4; ++j) { v[d0][j] *= rs * g0[j]; v[d0][4 + j] *= rs * g1[j]; } }
            if (a.lat) {
#pragma unroll
                for (int j = 0; j < 8; ++j) { const float f = inv_freq(j, 8); float s0, c0; __sincosf((hi == 0 ? prow : pcol) * f, &s0, &c0);
                    const float x1 = v[4][j], x2 = v[5][j]; v[4][j] = x1 * c0 - x2 * s0; v[5][j] = x1 * s0 + x2 * c0; }
            }
        }
#pragma unroll
        for (int d0 = 0; d0 < DQK / 16; ++d0) { u32x4 w; w.x = cvtpk(v[d0][0], v[d0][1]); w.y = cvtpk(v[d0][2], v[d0][3]); w.z = cvtpk(v[d0][4], v[d0][5]); w.w = cvtpk(v[d0][6], v[d0][7]); qr[d0] = __builtin_bit_cast(bf16x8, w); }
    }
    asm volatile("s_waitcnt vmcnt(0)" ::: "memory");
    issue(0); issue(1); issue(2);
    float m = a.has_sink ? a.sink2 : 0.f, l = a.has_sink ? (hi == 0 ? 1.f : 0.f) : 0.f;
    f32x16 negm;
#pragma unroll
    for (int r = 0; r < 16; ++r) negm[r] = NEGM ? -m : 0.f;
#pragma unroll
    for (int d0 = 0; d0 < DV / 32; ++d0)
#pragma unroll
        for (int r = 0; r < 16; ++r) o[d0][r] = 0.f;
    const int qpos = a.qpos0 + wid * 32 + r32;
    auto qk = [&](int tt, f32x16& p0, f32x16& p1) {
        const LAS unsigned char* kb = lds + (tt & 3) * FA_STG + hi * 1024 + r32 * 16;
#pragma unroll
        for (int dd = 0; dd < DQK / 32; ++dd) {
            bf16x8 kf[4];
#pragma unroll
            for (int e = 0; e < 2; ++e) { kf[2 * e] = *(const LAS bf16x8*)(kb + (2 * dd + e) * 2048); kf[2 * e + 1] = *(const LAS bf16x8*)(kb + (2 * dd + e) * 2048 + 512); }
#pragma unroll
            for (int e = 0; e < 2; ++e) { const int d0 = 2 * dd + e;
                p0 = __builtin_amdgcn_mfma_f32_32x32x16_bf16(kf[2 * e], qr[d0], d0 == 0 ? negm : p0, 0, 0, 0); p1 = __builtin_amdgcn_mfma_f32_32x32x16_bf16(kf[2 * e + 1], qr[d0], d0 == 0 ? negm : p1, 0, 0, 0); }
        }
    };
    auto step = [&](int t, f32x16& pc0, f32x16& pc1, f32x16& pn0, f32x16& pn1) {
        wait_tiles(t + 2 < ntiles ? 1 : 0);
        __builtin_amdgcn_s_barrier();
        asm volatile("" ::: "memory");
        if (t + 3 < ntiles) issue(t + 3);
        if constexpr (!PIPE) qk(t, pc0, pc1);
        const LAS unsigned char* vp = lds + (t & 3) * FA_STG + FA_VOFF + ((lane >> 4) & 1) * 32 + (lane & 3) * 8 + (4 * hi + ((lane & 15) >> 2)) * 64;
        s16x4 vlo[4], vhh[4];
#pragma unroll
        for (int ks = 0; ks < 4; ++ks) { vlo[ks] = ds_tr(vp + ks * 1024); vhh[ks] = ds_tr(vp + ks * 1024 + 512); }
        if constexpr (!NEGM) {
#pragma unroll
            for (int r = 0; r < 16; ++r) { pc0[r] -= m; pc1[r] -= m; }
        }
        if (a.masked && t < a.nlat) {
            const int kbase = 64 * (a.t0 + t) + 4 * hi - qpos;
#pragma unroll
            for (int r = 0; r < 16; ++r) { const int d = kbase + (r & 3) + 8 * (r >> 2); if (d > 128 || d < -128) pc0[r] = -1e30f; if (d + 32 > 128 || d + 32 < -128) pc1[r] = -1e30f; }
        }
        float mt = max3f(pc0[0], pc0[1], pc1[0]), mu = max3f(pc0[2], pc0[3], pc1[1]); mt = max3f(mt, pc1[2], pc1[3]);
#pragma unroll
        for (int r = 4; r < 16; r += 4) { mt = max3f(mt, pc0[r], pc0[r + 1]); mu = max3f(mu, pc0[r + 2], pc0[r + 3]); mt = max3f(mt, pc1[r], pc1[r + 1]); mu = max3f(mu, pc1[r + 2], pc1[r + 3]); }
        mt = xhalf_max(fmaxf(mt, mu));
        if (__any(mt > 6.0f)) {
            const float dl = fmaxf(mt, 0.f), alpha = __builtin_amdgcn_exp2f(-dl);
            m += dl; l *= alpha;
#pragma unroll
            for (int r = 0; r < 16; ++r) { pc0[r] -= dl; pc1[r] -= dl; }
            if constexpr (NEGM) {
#pragma unroll
                for (int r = 0; r < 16; ++r) negm[r] = -m;
            }
            if (hi == 0) wsf[r32] = alpha;
#pragma unroll
            for (int r4 = 0; r4 < 4; ++r4) { const f32x4 al = *(const LAS f32x4*)(wsf + 8 * r4 + 4 * hi);
#pragma unroll
                for (int d0 = 0; d0 < DV / 32; ++d0) { o[d0][4 * r4] *= al[0]; o[d0][4 * r4 + 1] *= al[1]; o[d0][4 * r4 + 2] *= al[2]; o[d0][4 * r4 + 3] *= al[3]; } }
        }
        if constexpr (PIPE) qk(t + 1, pn0, pn1);
        float ls = 0.f;
#pragma unroll
        for (int r = 0; r < 16; ++r) { pc0[r] = __builtin_amdgcn_exp2f(pc0[r]); pc1[r] = __builtin_amdgcn_exp2f(pc1[r]); ls += pc0[r] + pc1[r]; }
        l += ls;
        bf16x8 pa[4];
#pragma unroll
        for (int s = 0; s < 2; ++s) {
            u32x4 w0, w1;
            w0.x = cvtpk(pc0[8 * s], pc0[8 * s + 1]); w0.y = cvtpk(pc0[8 * s + 2], pc0[8 * s + 3]); w0.z = cvtpk(pc0[8 * s + 4], pc0[8 * s + 5]); w0.w = cvtpk(pc0[8 * s + 6], pc0[8 * s + 7]);
            w1.x = cvtpk(pc1[8 * s], pc1[8 * s + 1]); w1.y = cvtpk(pc1[8 * s + 2], pc1[8 * s + 3]); w1.z = cvtpk(pc1[8 * s + 4], pc1[8 * s + 5]); w1.w = cvtpk(pc1[8 * s + 6], pc1[8 * s + 7]);
            pa[s] = __builtin_bit_cast(bf16x8, w0); pa[2 + s] = __builtin_bit_cast(bf16x8, w1);
        }
#pragma unroll
        for (int d0 = 0; d0 < DV / 32; ++d0) {
#pragma unroll
            for (int ks = 0; ks < 4; ++ks) { const bf16x8 vf = (bf16x8){vlo[ks][0], vlo[ks][1], vlo[ks][2], vlo[ks][3], vhh[ks][0], vhh[ks][1], vhh[ks][2], vhh[ks][3]};
                o[d0] = __builtin_amdgcn_mfma_f32_32x32x16_bf16(pa[ks], vf, o[d0], 0, 0, 0); }
            if (d0 + 1 < DV / 32) {
#pragma unroll
                for (int ks = 0; ks < 4; ++ks) { vlo[ks] = ds_tr(vp + (d0 + 1) * 4096 + ks * 1024); vhh[ks] = ds_tr(vp + (d0 + 1) * 4096 + ks * 1024 + 512); }
            }
        }
        if constexpr (PIPE) {
#pragma unroll
            for (int i = 0; i < DQK / 8; ++i) { __builtin_amdgcn_sched_group_barrier(0x008, 1, 0); __builtin_amdgcn_sched_group_barrier(0x002, 80 / (DQK / 8), 0); }
        }
    };
    f32x16 pA0, pA1, pB0, pB1;
    wait_tiles(2); __builtin_amdgcn_s_barrier(); asm volatile("" ::: "memory");
    if constexpr (PIPE) { qk(0, pA0, pA1); for (int t = 0; t < ntiles; t += 2) { step(t, pA0, pA1, pB0, pB1); step(t + 1, pB0, pB1, pA0, pA1); } }
    else { for (int t = 0; t < ntiles; ++t) step(t, pA0, pA1, pA0, pA1); }
    l = xhalf_sum(l);
    if (hi == 0) wsf[r32] = l > 0.f ? 1.f / l : 0.f;
#pragma unroll
    for (int r4 = 0; r4 < 4; ++r4) { const f32x4 il = *(const LAS f32x4*)(wsf + 8 * r4 + 4 * hi);
#pragma unroll
        for (int d0 = 0; d0 < DV / 32; ++d0) { o[d0][4 * r4] *= il[0]; o[d0][4 * r4 + 1] *= il[1]; o[d0][4 * r4 + 2] *= il[2]; o[d0][4 * r4 + 3] *= il[3]; } }
    __syncthreads();
}
template <int NB>
__device__ __forceinline__ void fattn_store(bf16_t* dst  , int row0, const f32x16 (&o)[NB], int lane) {
    const int r32 = lane & 31, hi = lane >> 5;
#pragma unroll
    for (int d0 = 0; d0 < NB; ++d0)
#pragma unroll
        for (int r = 0; r < 16; ++r) dst[(size_t)(row0 + crow(r, hi)) * BRW + 32 * d0 + r32] = (bf16_t)f2bf(o[d0][r]);
}
__device__ __forceinline__ void fattn_phase(const Ctx& C, int l, int rep = 0) {
    LAS unsigned char* lds = (LAS unsigned char*)C.lds_f;
    const int n_lat = 1792, total = n_lat + (l == 0 ? NBATCH * 28 : 0);
    int* counter = (int*)(C.P.ws + WS_CNT) + 24 + l + 2 * rep;
    const float lam = __hip_atomic_load(&((float*)(C.P.ws + WS_CNT + 128))[l], __ATOMIC_RELAXED, __HIP_MEMORY_SCOPE_AGENT);
    const float lam_init = 0.8f - 0.6f * expf(-0.3f * (float)l);
    const int wid = __builtin_amdgcn_readfirstlane(C.tid >> 6);
    for (;;) {
        unsigned char* wsb = C.P.ws; asm volatile("" : "+s"(wsb));
        bf16_t* PQKV = (bf16_t*)(wsb + WS_PQKV); bf16_t* BR = (bf16_t*)(wsb + WS_BR); bf16_t* QD = (bf16_t*)(wsb + WS_QD); bf16_t* KVD = (bf16_t*)(wsb + WS_KVD);
        if (C.tid == 0) *(LAS int*)(lds + FA_IDX) = atomicAdd(counter, 1);
        __syncthreads();
        const int idx = __builtin_amdgcn_readfirstlane(*(LAS int*)(lds + FA_IDX));
        __syncthreads();
        if (idx >= total) break;
        int mixer, b, h, qb; bool isctx = false;
        if (idx < 256) { mixer = 2; b = idx >> 5; h = (idx >> 3) & 3; qb = idx & 7; }
        else if (idx < n_lat) { const int j = (idx - 256) & 511; mixer = idx < 768 ? 3 : (idx < 1280 ? 1 : 0); b = j >> 6; h = (j >> 3) & 7; qb = j & 7; }
        else { const int j = idx - n_lat, hitem = j % 28; b = j / 28; qb = 0; isctx = true; mixer = hitem < 8 ? 0 : (hitem < 16 ? 1 : (hitem < 20 ? 2 : 3)); h = hitem < 16 ? (hitem & 7) : (hitem < 20 ? hitem - 16 : hitem - 20); }
        FAttn a;
        a.qrow0 = isctx ? NL + b * CTXL : b * SEQ + qb * 256; a.qpos0 = qb * 256;
        a.krow_lat = b * SEQ; a.t0 = 0; a.nlat = isctx ? 0 : 32; a.krow_ctx = NL + b * CTXL; a.masked = false; a.has_sink = false; a.sink2 = 0.f;
        a.k2 = nullptr; a.k2pitch = 0; a.qgain2 = nullptr; a.rq = nullptr; a.lat = !isctx;
        a.qgain = (mixer == 0 ? C.P.in[9] : (mixer == 1 ? C.P.in[12] : (mixer == 2 ? C.P.in[14] : C.P.in[25]))) + l * 64;
        const int row0 = a.qrow0 + wid * 32;
        if (mixer <= 1) {
            const bool isA = mixer == 0; const int kvh = h >> 2;
            a.q = PQKV + (isA ? C_QA : C_QB) + h * 64; a.qpitch = PQW; a.k1 = PQKV + (isA ? C_KA : C_KB) + kvh * 64; a.k1pitch = PQW; a.v = PQKV + (isA ? C_VA : C_VB) + kvh * 64; a.vpitch = PQW;
            if (isA) { a.has_sink = true; a.sink2 = (C.P.in[11])[l * 8 + h] * LOG2E;
                if (!isctx) { a.masked = true; const int ta = 4 * qb - 2, tb = 4 * qb + 6; a.t0 = ta < 0 ? 0 : ta; a.nlat = (tb > 32 ? 32 : tb) - a.t0; } }
            f32x16 o[2]; fattn_core<64, 64>(lds, a, o);
            fattn_store<2>(BR + (isA ? 0 : 512) + h * 64, row0, o, C.lane);
        } else if (mixer == 2) {
            const int hc = h; float* OC1 = (float*)(wsb + WS_OC1);
            a.v = PQKV + C_VC + hc * 128; a.vpitch = PQW; a.qpitch = PQW; a.k1pitch = PQW;
            const int r32 = C.lane & 31, hi = C.lane >> 5;
            f32x16 o[4];
            a.q = PQKV + C_QC + (2 * hc) * 64; a.k1 = PQKV + C_KC + (2 * hc) * 64;
            fattn_core<64, 128>(lds, a, o);
#pragma unroll
            for (int d0 = 0; d0 < 4; ++d0)
#pragma unroll
                for (int r = 0; r < 16; ++r) OC1[((size_t)(row0 + crow(r, hi)) * 4 + hc) * 128 + 32 * d0 + r32] = o[d0][r];
            a.q = PQKV + C_QC + (2 * hc + 1) * 64; a.k1 = PQKV + C_KC + (2 * hc + 1) * 64;
            fattn_core<64, 128>(lds, a, o);
            float ss[16];
#pragma unroll
            for (int r = 0; r < 16; ++r) ss[r] = 0.f;
#pragma unroll
            for (int d0 = 0; d0 < 4; ++d0)
#pragma unroll
                for (int r = 0; r < 16; ++r) { const float o1 = OC1[((size_t)(row0 + crow(r, hi)) * 4 + hc) * 128 + 32 * d0 + r32]; const float dl = o1 - lam * o[d0][r]; o[d0][r] = dl; ss[r] += dl * dl; }
#pragma unroll
            for (int r = 0; r < 16; ++r) {
#pragma unroll
                for (int sft = 1; sft < 32; sft <<= 1) ss[r] += __shfl_xor(ss[r], sft);
                ss[r] = (1.0f / sqrtf(ss[r] * (1.f / 128.f) + EPS)) * (1.f - lam_init);
            }
            const float* gn = (C.P.in[20]) + l * 128;
#pragma unroll
            for (int d0 = 0; d0 < 4; ++d0) { const float g = gn[32 * d0 + r32];
#pragma unroll
                for (int r = 0; r < 16; ++r) o[d0][r] *= ss[r] * g; }
            fattn_store<4>(BR + 1024 + hc * 128, row0, o, C.lane);
        } else {
            a.qgain2 = C.P.in[27] + l * 32; a.rq = (const float*)(wsb + WS_RQ);
            a.q = QD + h * 96; a.qpitch = 768; a.k1 = KVD + h * 128; a.k1pitch = 1024; a.k2 = PQKV + C_KR; a.k2pitch = PQW; a.v = KVD + h * 128 + 64; a.vpitch = 1024;
            f32x16 o[2]; fattn_core<96, 64>(lds, a, o);
            fattn_store<2>(BR + 1536 + h * 64, row0, o, C.lane);
        }
    }
}
#ifndef FAST_ATTN
#define FAST_ATTN 1
#endif

#define XB_TMO      128
#define XB_XCNT(j)  (256  + 64 * (j))
#define XB_XSUB(j)  (1280 + 64 * (j))
#define XB_XGEN(j)  (2304 + 64 * (j))
#define XB_TOP      3328
#define XB_TOPGEN   3392
#define XCD_BAR_WORDS 3456
#define XB_SPIN_CAP (1u << 22)
constexpr size_t WS_BAR = 2 * MiB;
constexpr int LDS_ST_OFF = LDS_BYTES - 64;
__device__ __forceinline__ unsigned xb_ld(unsigned* p)              { return __hip_atomic_load(p, __ATOMIC_RELAXED, __HIP_MEMORY_SCOPE_AGENT); }
__device__ __forceinline__ unsigned xb_add(unsigned* p, unsigned v) { return __hip_atomic_fetch_add(p, v, __ATOMIC_RELAXED, __HIP_MEMORY_SCOPE_AGENT); }
__device__ __forceinline__ unsigned xb_xcc_id() { return (unsigned)__builtin_amdgcn_s_getreg((3 << 11) | 20) & 0xFu; }
#define XB_SPIN(cond, bar) do { unsigned _sp = 0; while (cond) { __builtin_amdgcn_s_sleep(1); \
    if ((++_sp & 255u) == 0u) { if (xb_ld(&(bar)[XB_TMO])) break; if (_sp > XB_SPIN_CAP) { atomicAdd(&(bar)[XB_TMO], 1u); break; } } } } while (0)
struct XcdBarrier { unsigned* bar; unsigned x; volatile LAS unsigned* st; };
__device__ __forceinline__ XcdBarrier xcd_barrier_post(unsigned* bar, volatile LAS unsigned* st) {
    XcdBarrier b; b.bar = bar; b.x = xb_xcc_id(); b.st = st;
    if (threadIdx.x == 0) (void)xb_add(&bar[XB_XCNT(b.x)], 1u);
    return b;
}
__device__ __forceinline__ void xcd_barrier_complete(unsigned* bar, unsigned x, unsigned& nloc, unsigned& nx) {
    const unsigned G = gridDim.x * gridDim.y * gridDim.z;
    unsigned sum, cnt, mine, sp = 0u;
    for (;;) {
        sum = 0u; cnt = 0u; mine = 0u;
#pragma unroll
        for (unsigned j = 0; j < 16; ++j) { const unsigned c = xb_ld(&bar[XB_XCNT(j)]); sum += c; cnt += (c > 0u) ? 1u : 0u; mine = (j == x) ? c : mine; }
        if (sum == G) break;
        __builtin_amdgcn_s_sleep(1);
        if ((++sp & 255u) == 0u) { if (xb_ld(&bar[XB_TMO])) break; if (sp > XB_SPIN_CAP) { atomicAdd(&bar[XB_TMO], 1u); break; } }
    }
    nloc = mine > 0u ? mine : 1u; nx = cnt > 0u ? cnt : 1u;
}
__device__ __forceinline__ void xcd_barrier(const XcdBarrier& b) {
    asm volatile("s_waitcnt vmcnt(0)" ::: "memory");
    __syncthreads();
    if (threadIdx.x == 0) {
        unsigned* bar = b.bar;
        __builtin_amdgcn_s_waitcnt(0);
        unsigned nloc = b.st[0], nx = b.st[1];
        if (nloc == 0u) { xcd_barrier_complete(bar, b.x, nloc, nx); b.st[0] = nloc; b.st[1] = nx; }
        const unsigned old = xb_add(&bar[XB_XSUB(b.x)], 1u);
        const unsigned gen = old / nloc;
        if (old + 1u == (gen + 1u) * nloc) {
            __builtin_amdgcn_fence(__ATOMIC_RELEASE, "agent");
            asm volatile("s_waitcnt vmcnt(0)" ::: "memory");
            const unsigned og = xb_add(&bar[XB_TOP], 1u);
            const unsigned tg = og / nx;
            if (og + 1u == (tg + 1u) * nx) xb_add(&bar[XB_TOPGEN], 1u);
            else XB_SPIN(xb_ld(&bar[XB_TOPGEN]) == tg, bar);
            __builtin_amdgcn_fence(__ATOMIC_ACQUIRE, "agent");
            xb_add(&bar[XB_XGEN(b.x)], 1u);
            asm volatile("s_waitcnt vmcnt(0)" ::: "memory");
        } else {
            XB_SPIN(xb_ld(&bar[XB_XGEN(b.x)]) == gen, bar);
            __builtin_amdgcn_fence(__ATOMIC_ACQUIRE, "agent");
            asm volatile("s_waitcnt vmcnt(0)" ::: "memory");
        }
    }
    __syncthreads();
}

constexpr int N_PHASES = 23;
__global__ void __launch_bounds__(NTHREADS) mk_fwd(Params p) {
    extern __shared__ __attribute__((aligned(16))) unsigned char lds[];
    cg::grid_group grid = cg::this_grid();
#define MKCTX int tid_l_ = (int)threadIdx.x; asm volatile("" : "+v"(tid_l_)); const Ctx C{p, (float*)lds, tid_l_, tid_l_ & 63, tid_l_ >> 6, (int)gridDim.x, (int)blockIdx.x}
    const int lo = p.ph_lo, hi = p.ph_hi;
    if (threadIdx.x < 2) ((volatile LAS unsigned*)((LAS unsigned char*)lds + LDS_ST_OFF))[threadIdx.x] = 0u;
    __syncthreads();
    XcdBarrier xbar; xbar.bar = (unsigned*)(p.ws + WS_BAR); xbar.x = 0; xbar.st = (volatile LAS unsigned*)((LAS unsigned char*)lds + LDS_ST_OFF);
#define SEAM(k) do { if ((k) == 0) { grid.sync(); xbar = xcd_barrier_post((unsigned*)(p.ws + WS_BAR), (volatile LAS unsigned*)((LAS unsigned char*)lds + LDS_ST_OFF)); } else xcd_barrier(xbar); } while (0)
#ifndef REPEAT_MASK
#define REPEAT_MASK 0u
#endif
int rep = 0;
#define PHASE(k, call) if (lo <= (k) && (k) < hi) { MKCTX; rep = 0; call; if ((REPEAT_MASK >> (k)) & 1u) { SEAM(k); rep = 1; call; } if ((k) + 1 < hi) SEAM(k); }
#define PHASEAB(k, callA, callB) if (lo <= (k) && (k) < hi) { MKCTX; callA; callB; if ((REPEAT_MASK >> (k)) & 1u) { SEAM(k); callB; } if ((k) + 1 < hi) SEAM(k); }
    PHASEAB(0, ph_prologue(C), (FAST_ANY_SMALL ? conv_weights<false>(C) : (void)0))
    PHASE(1, ph_adaln(C, 0, 0))
    PHASE(2, (FAST_G1 ? fg1(C, 0) : ph_g1(C, 0)))
    PHASE(3, (FAST_G2 ? fg2(C, 0) : ph_g2(C, 0)))
    PHASE(4, ph_post(C, 0, rep))
    PHASE(5, (FAST_ATTN ? fattn_phase(C, 0, rep) : ph_attn(C, 0)))
    PHASE(6, (FAST_G3 ? fg3(C, 0) : ph_g3(C, 0)))
    PHASE(7, (FAST_G4 ? fg4(C, 0) : ph_g4(C, 0)))
    PHASE(8, ph_adaln(C, 0, 1))
    PHASE(9, (FAST_G5 ? fg5(C) : ph_g5(C)))
    PHASE(10, (FAST_G6 ? fg6(C) : ph_g6(C)))
    PHASE(11, ph_adaln(C, 1, 0))
    PHASE(12, (FAST_G1 ? fg1(C, 1) : ph_g1(C, 1)))
    PHASE(13, (FAST_G2 ? fg2(C, 1) : ph_g2(C, 1)))
    PHASE(14, ph_post(C, 1, rep))
    PHASE(15, (FAST_ATTN ? fattn_phase(C, 1, rep) : ph_attn(C, 1)))
    PHASE(16, (FAST_G3 ? fg3(C, 1) : ph_g3(C, 1)))
    PHASE(17, (FAST_G4 ? fg4(C, 1) : ph_g4(C, 1)))
    PHASEAB(18, ph_adaln(C, 1, 1), (FAST_ANY_MOE ? conv_weights<true>(C) : (void)0))
    PHASE(19, ph_assign(C))
    PHASE(20, (FAST_G7 ? fg7(C) : ph_g7(C)))
    PHASE(21, (FAST_G8 ? fg8(C) : ph_g8(C)))
    PHASE(22, ph_combine(C))
#ifdef EXTRA_SYNCS
    for (int i = 0; i < EXTRA_SYNCS; ++i) xcd_barrier(xbar);
#endif
#ifdef REPEAT_PRO
    grid.sync(); if (blockIdx.x < 0) ph_prologue(C);
#endif
#undef PHASE
#undef PHASEAB
#undef SEAM
}

extern "C" void kernel_launch(void* const* d_in, const int* in_sizes, int n_in, void* d_out, int out_size, void* d_ws, size_t ws_size, hipStream_t stream) {
    static int grid_blocks = 0;
    if (grid_blocks == 0) {
        if (n_in != 38 || ws_size < WS_NEED) { fprintf(stderr, "kernel_launch: unexpected n_in %d / ws_size %zu\n", n_in, ws_size); grid_blocks = -1; return; }
        int dev = 0, cus = 0, per_cu = 0;
        hipGetDevice(&dev);
        hipDeviceGetAttribute(&cus, hipDeviceAttributeMultiprocessorCount, dev);
        hipFuncSetAttribute((const void*)mk_fwd, hipFuncAttributeMaxDynamicSharedMemorySize, LDS_BYTES);
        hipOccupancyMaxActiveBlocksPerMultiprocessor(&per_cu, (const void*)mk_fwd, NTHREADS, LDS_BYTES);
        if (per_cu < 1) per_cu = 1;
        grid_blocks = cus * per_cu;
        (void)hipGetLastError();
    }
    if (grid_blocks < 0) return;
    Params p{};
    for (int i = 0; i < 38; ++i) p.in[i] = (const float*)d_in[i];
    p.out = (float*)d_out; p.ws = (unsigned char*)d_ws; p.ph_lo = 0; p.ph_hi = N_PHASES;
    void* args[] = {&p};
    hipError_t e = hipLaunchCooperativeKernel((const void*)mk_fwd, dim3(grid_blocks), dim3(NTHREADS), args, LDS_BYTES, stream);
    if (e != hipSuccess) fprintf(stderr, "cooperative launch failed: %s (grid %d)\n", hipGetErrorString(e), grid_blocks);
}
```

```cpp
#include <hip/hip_runtime.h>
#include <hip/hip_cooperative_groups.h>
#include <cstdio>
#include <cstdint>
namespace cg = cooperative_groups;

typedef unsigned short bf16_t;
typedef float f32x4 __attribute__((ext_vector_type(4)));
typedef unsigned u32x4 __attribute__((ext_vector_type(4)));
typedef unsigned u32x2 __attribute__((ext_vector_type(2)));

constexpr int DM = 1024, NBATCH = 8, SEQ = 2048, CTXL = 256;
constexpr int NL = NBATCH * SEQ, NC = NBATCH * CTXL, NT = NL + NC;
constexpr int IN_COLS = 7968;
constexpr int C_QA = 0, C_QB = 512, C_QC = 1024, C_CQ = 1536, C_KA = 2048, C_VA = 2176, C_KB = 2304, C_VB = 2432, C_KC = 2560, C_VC = 3072, C_CKV = 3584, C_KR = 3840;
constexpr int PQW = 4096, PGW = 4096, BRW = 2048;
constexpr int DFF = 2816, EFF = 3584, NEXP = 8;
constexpr int MOE_ROWS = 34816;
constexpr float EPS = 1e-6f;
constexpr float LOG2E = 1.4426950408889634f;
constexpr float QSCALE64 = 0.125f * LOG2E, QSCALE96 = 0.10206207261596577f * LOG2E;
constexpr int NTHREADS = 512;
constexpr int LDS_BYTES = 147456;

constexpr size_t MiB = 1u << 20;
constexpr size_t WS_MOD = 0;
constexpr size_t WS_CNT = 512 * 1024;
constexpr size_t WS_ROUTE_E = 1 * MiB;
constexpr size_t WS_ROUTE_W = WS_ROUTE_E + 64 * 1024;
constexpr size_t WS_POS = WS_ROUTE_W + 128 * 1024;
constexpr size_t WS_ROWMAP = WS_POS + 128 * 1024;
constexpr size_t WS_RQ = 1536 * 1024;
constexpr size_t WS_XN = 4 * MiB;
constexpr size_t WS_BR = 4 * MiB;
constexpr size_t WS_WSMALL = 76 * MiB;
constexpr size_t WS_CX = 140 * MiB;
constexpr size_t WS_PQKV = 148 * MiB;
constexpr size_t WS_MERGED = 148 * MiB;
constexpr size_t WS_PG = 292 * MiB;
constexpr size_t WS_H = 292 * MiB;
constexpr size_t WS_QD = 436 * MiB;
constexpr size_t WS_KVD = 463 * MiB;
constexpr size_t WS_OC1 = 499 * MiB;
constexpr size_t WS_HM = 208 * MiB;
constexpr size_t WS_YM = 446 * MiB;
constexpr size_t WS_NEED = 535 * MiB;

__device__ __forceinline__ float bf2f(unsigned h) { return __uint_as_float(h << 16); }
__device__ __forceinline__ unsigned f2bf(float f) { unsigned u = __float_as_uint(f); return (u + 0x7fffu + ((u >> 16) & 1u)) >> 16; }
typedef float f32x2_t __attribute__((ext_vector_type(2))); typedef __bf16 bf16x2_t __attribute__((ext_vector_type(2)));
__device__ __forceinline__ unsigned pk2(float lo, float hi) { f32x2_t v = {lo, hi}; bf16x2_t b = __builtin_convertvector(v, bf16x2_t); return __builtin_bit_cast(unsigned, b); }
__device__ __forceinline__ float wave_sum(float v) {
#pragma unroll
    for (int o = 1; o < 64; o <<= 1) v += __shfl_xor(v, o);
    return v;
}
__device__ __forceinline__ float sigmoidf_(float x) { return 1.f / (1.f + __expf(-x)); }
__device__ __forceinline__ float siluf_(float x) { return x / (1.f + __expf(-x)); }
__device__ __forceinline__ void unpack8(u32x4 raw, float* dst) {
    dst[0] = bf2f(raw.x & 0xffffu); dst[1] = bf2f(raw.x >> 16); dst[2] = bf2f(raw.y & 0xffffu); dst[3] = bf2f(raw.y >> 16);
    dst[4] = bf2f(raw.z & 0xffffu); dst[5] = bf2f(raw.z >> 16); dst[6] = bf2f(raw.w & 0xffffu); dst[7] = bf2f(raw.w >> 16);
}

struct Params { const float* in[38]; float* out; unsigned char* ws; int ph_lo, ph_hi; };

struct Ctx { const Params& P; float* lds_f; int tid, lane, wave, nblk, blk; };

__device__ __forceinline__ void ph_prologue(const Ctx& C) {
    if (C.blk == 0 && C.tid < 32) ((int*)(C.P.ws + WS_CNT))[C.tid] = 0;
    if (C.blk == 0) for (int i = C.tid; i < 3456; i += NTHREADS) ((unsigned*)(C.P.ws + (2u << 20)))[i] = 0u;
    if (C.blk == 0 && C.wave == 1) {
        for (int l = 0; l < 2; ++l) {
            const float a = wave_sum((C.P.in[16])[l * 64 + C.lane] * (C.P.in[17])[l * 64 + C.lane]);
            const float b = wave_sum((C.P.in[18])[l * 64 + C.lane] * (C.P.in[19])[l * 64 + C.lane]);
            const float lam_init = 0.8f - 0.6f * expf(-0.3f * (float)l);
            if (C.lane == 0) ((float*)(C.P.ws + WS_CNT + 128))[l] = expf(a) - expf(b) + lam_init;
        }
    }
    float* sc = C.lds_f;
    float* red = C.lds_f + 9 * 1024;
    for (int i = C.tid; i < 9 * 1024; i += NTHREADS) { const int row = i >> 10, k = i & 1023; const float v = row < 8 ? (C.P.in[1])[row * 1024 + k] : (C.P.in[3])[k]; sc[i] = v / (1.f + expf(-v)); }
    __syncthreads();
    for (int item = C.blk; item < 384; item += C.nblk) {
        const int l = item / 192, cgp = item % 192, cl32 = C.lane & 31, kpar = C.lane >> 5;
        const float* w = (C.P.in[4]) + (size_t)l * 1024 * 6144 + cgp * 32 + cl32;
        float acc[9];
#pragma unroll
        for (int r = 0; r < 9; ++r) acc[r] = 0.f;
#pragma unroll 16
        for (int i = 0; i < 64; ++i) {
            const int k = C.wave * 128 + 2 * i + kpar; const float wv = w[(size_t)k * 6144];
#pragma unroll
            for (int r = 0; r < 9; ++r) acc[r] += sc[r * 1024 + k] * wv;
        }
#pragma unroll
        for (int r = 0; r < 9; ++r) { acc[r] += __shfl_xor(acc[r], 32); if (kpar == 0) red[(C.wave * 9 + r) * 32 + cl32] = acc[r]; }
        __syncthreads();
        for (int i = C.tid; i < 9 * 32; i += NTHREADS) {
            const int r = i >> 5, cl = i & 31; float sm = 0.f;
#pragma unroll
            for (int w8 = 0; w8 < 8; ++w8) sm += red[(w8 * 9 + r) * 32 + cl];
            ((float*)(C.P.ws + WS_MOD))[(size_t)(l * 9 + r) * 6144 + cgp * 32 + cl] = sm + (C.P.in[5])[l * 6144 + cgp * 32 + cl];
        }
        __syncthreads();
    }
}

__device__ __forceinline__ void ph_adaln(const Ctx& C, int l, int which) {
    const float* g = (which == 0 ? (C.P.in[6]) : (C.P.in[7])) + l * 1024;
    const bool router = (l == 1 && which == 1);
    const int nrows = router ? NL : NT;
    const int gw = C.blk * 8 + C.wave, NGW = C.nblk * 8;
    auto load_row = [&](int r, f32x4 (&v)[4]) {
        const float* src;
        if (l == 0 && which == 0) src = r < NL ? (C.P.in[0]) + (size_t)r * 1024 : (C.P.in[2]) + (size_t)(r - NL) * 1024;
        else src = r < NL ? (C.P.out) + (size_t)r * 1024 : ((float*)(C.P.ws + WS_CX)) + (size_t)(r - NL) * 1024;
#pragma unroll
        for (int j = 0; j < 4; ++j) v[j] = ((const f32x4*)src)[C.lane + 64 * j];
    };
    auto finish_row = [&](int r, const f32x4 (&v)[4]) {
        const int mrow = r < NL ? (r >> 11) : 8;
        const float* mod = ((float*)(C.P.ws + WS_MOD)) + (size_t)(l * 9 + mrow) * 6144;
        const float* shift = mod + (which ? 3 : 0) * 1024; const float* scale = mod + (which ? 4 : 1) * 1024;
        float ss = 0.f;
#pragma unroll
        for (int j = 0; j < 4; ++j) ss += (v[j].x * v[j].x + v[j].y * v[j].y) + (v[j].z * v[j].z + v[j].w * v[j].w);
        ss = wave_sum(ss);
        const float rinv = __builtin_amdgcn_rsqf(ss * (1.f / 1024.f) + EPS);
        float y[16];
#pragma unroll
        for (int j = 0; j < 4; ++j) {
            const f32x4 gg = ((const f32x4*)g)[C.lane + 64 * j], sh = ((const f32x4*)shift)[C.lane + 64 * j], sl = ((const f32x4*)scale)[C.lane + 64 * j];
            y[4 * j + 0] = v[j].x * rinv * gg.x * (1.f + sl.x) + sh.x; y[4 * j + 1] = v[j].y * rinv * gg.y * (1.f + sl.y) + sh.y;
            y[4 * j + 2] = v[j].z * rinv * gg.z * (1.f + sl.z) + sh.z; y[4 * j + 3] = v[j].w * rinv * gg.w * (1.f + sl.w) + sh.w;
            u32x2 o; o.x = pk2(y[4 * j + 0], y[4 * j + 1]); o.y = pk2(y[4 * j + 2], y[4 * j + 3]);
            ((u32x2*)(((bf16_t*)(C.P.ws + WS_XN)) + (size_t)r * 1024))[C.lane + 64 * j] = o;
        }
        if (router) {
            float lg[8];
#pragma unroll
            for (int e = 0; e < 8; ++e) lg[e] = 0.f;
#pragma unroll
            for (int j = 0; j < 4; ++j)
#pragma unroll
                for (int q = 0; q < 4; ++q) {
                    const int k = 4 * C.lane + 256 * j + q;
                    const f32x4 w0 = ((const f32x4*)((C.P.in[34]) + (size_t)k * 8))[0], w1 = ((const f32x4*)((C.P.in[34]) + (size_t)k * 8))[1];
                    const float yy = y[4 * j + q];
                    lg[0] += yy * w0.x; lg[1] += yy * w0.y; lg[2] += yy * w0.z; lg[3] += yy * w0.w; lg[4] += yy * w1.x; lg[5] += yy * w1.y; lg[6] += yy * w1.z; lg[7] += yy * w1.w;
                }
#pragma unroll
            for (int e = 0; e < 8; ++e) lg[e] = wave_sum(lg[e]);
            float b0 = lg[0]; int i0 = 0;
#pragma unroll
            for (int e = 1; e < 8; ++e) if (lg[e] > b0) { b0 = lg[e]; i0 = e; }
            float b1 = -3.0e38f; int i1 = 0;
#pragma unroll
            for (int e = 0; e < 8; ++e) if (e != i0 && lg[e] > b1) { b1 = lg[e]; i1 = e; }
            if (C.lane == 0) {
                const float w0 = 1.f / (1.f + expf(b1 - b0));
                ((int*)(C.P.ws + WS_ROUTE_E))[r] = i0 | (i1 << 8); ((float*)(C.P.ws + WS_ROUTE_W))[2 * r] = w0; ((float*)(C.P.ws + WS_ROUTE_W))[2 * r + 1] = 1.f - w0;
                atomicAdd(&((int*)(C.P.ws + WS_CNT))[i0], 1); atomicAdd(&((int*)(C.P.ws + WS_CNT))[i1], 1);
            }
        }
    };
    if (router) {
        for (int r = gw; r < nrows; r += 2 * NGW) {
            const int r2 = r + NGW; const bool h2 = r2 < nrows;
            f32x4 va[4], vb[4];
            load_row(r, va);
            if (h2) load_row(r2, vb);
            finish_row(r, va);
            if (h2) finish_row(r2, vb);
        }
    } else
    for (int r = gw; r < nrows; r += 4 * NGW) {
        const int r2 = r + NGW, r3 = r + 2 * NGW, r4 = r + 3 * NGW; const bool h2 = r2 < nrows, h3 = r3 < nrows, h4 = r4 < nrows;
        f32x4 va[4], vb[4], vc[4], vd[4];
        load_row(r, va);
        if (h2) load_row(r2, vb);
        if (h3) load_row(r3, vc);
        if (h4) load_row(r4, vd);
        finish_row(r, va);
        if (h2) finish_row(r2, vb);
        if (h3) finish_row(r3, vc);
        if (h4) finish_row(r4, vd);
    }
}

template <class AF, class BF>
__device__ __forceinline__ void ngemm_tile(float* lds_f, int tid, int K, AF af, BF bf, float (&acc)[4][4]) {
    float* As = lds_f;
    float* Bs = lds_f + 128 * 33;
    const int ty = tid >> 4, tx = tid & 15;
#pragma unroll
    for (int i = 0; i < 4; ++i)
#pragma unroll
        for (int j = 0; j < 4; ++j) acc[i][j] = 0.f;
    for (int k0 = 0; k0 < K; k0 += 32) {
        {
            const int i = tid >> 2, kq = (tid & 3) * 8; const bf16_t* ap = af(i, k0 + kq); float t[8];
            if (ap) unpack8(*(const u32x4*)ap, t); else {
#pragma unroll
                for (int q = 0; q < 8; ++q) t[q] = 0.f; }
#pragma unroll
            for (int q = 0; q < 8; ++q) As[i * 33 + kq + q] = t[q];
        }
        {
            const int k = tid >> 4, j = (tid & 15) * 4;
#pragma unroll
            for (int q = 0; q < 4; ++q) Bs[k * 64 + j + q] = bf(k0 + k, j + q);
        }
        __syncthreads();
#pragma unroll 8
        for (int kk = 0; kk < 32; ++kk) {
            float a[4];
#pragma unroll
            for (int i = 0; i < 4; ++i) a[i] = As[(ty * 4 + i) * 33 + kk];
            const f32x4 b = *(const f32x4*)&Bs[kk * 64 + tx * 4];
#pragma unroll
            for (int i = 0; i < 4; ++i) { acc[i][0] += a[i] * b.x; acc[i][1] += a[i] * b.y; acc[i][2] += a[i] * b.z; acc[i][3] += a[i] * b.w; }
        }
        __syncthreads();
    }
}
#define NG_EPI(acc, ...) do { const int ty_ = C.tid >> 4, tx_ = C.tid & 15; auto ef_ = __VA_ARGS__; _Pragma("unroll") for (int i_ = 0; i_ < 4; ++i_) ef_(ty_ * 4 + i_, tx_ * 4, acc[i_]); } while (0)

__device__ __forceinline__ void ph_g1(const Ctx& C, int l) {
    const float* W = (C.P.in[8]) + (size_t)l * 1024 * IN_COLS;
    const int n_lat = (NL / 128) * 128, n_ctx = (NC / 128) * (l == 0 ? 128 : 32);
    for (int it = C.blk; it < n_lat + n_ctx; it += C.nblk) {
        int rt, ct;
        if (it < n_lat) { rt = it >> 7; ct = it & 127; }
        else { const int j = it - n_lat; if (l == 0) { rt = NL / 128 + (j >> 7); ct = j & 127; } else { rt = NL / 128 + (j >> 5); ct = 32 + (j & 31); } }
        const int row0 = rt * 128, col0 = ct * 64;
        float acc[4][4];
        ngemm_tile(C.lds_f, C.tid, 1024,
            [&](int i, int k) { return ((bf16_t*)(C.P.ws + WS_XN)) + (size_t)(row0 + i) * 1024 + k; },
            [&](int k, int j) { const int n = col0 + j; return n < 3872 ? W[(size_t)k * IN_COLS + n] : (n < 4096 ? 0.f : W[(size_t)k * IN_COLS + n - 224]); }, acc);
        NG_EPI(acc, [&](int i, int j0, const float* a) {
                const int n = col0 + j0; u32x2 o;
                if (n < 4096) { o.x = pk2(a[0], a[1]); o.y = pk2(a[2], a[3]); *(u32x2*)(((bf16_t*)(C.P.ws + WS_PQKV)) + (size_t)(row0 + i) * PQW + n) = o; }
                else { o.x = pk2(sigmoidf_(a[0]), sigmoidf_(a[1])); o.y = pk2(sigmoidf_(a[2]), sigmoidf_(a[3])); *(u32x2*)(((bf16_t*)(C.P.ws + WS_PG)) + (size_t)(row0 + i) * PGW + n - 4096) = o; }
            });
    }
}
__device__ __forceinline__ void ph_g2(const Ctx& C, int l) {
    const float* Wq = (C.P.in[23]) + (size_t)l * 512 * 768; const float* gq = (C.P.in[21]) + l * 512;
    const float* Wk = (C.P.in[24]) + (size_t)l * 256 * 1024; const float* gk = (C.P.in[22]) + l * 256;
    const int nq = (NT / 128) * 12, nk = (NT / 128) * 16;
    for (int it = C.blk; it < nq + nk; it += C.nblk) {
        float acc[4][4];
        if (it < nq) {
            const int row0 = (it / 12) * 128, col0 = (it % 12) * 64;
            ngemm_tile(C.lds_f, C.tid, 512,
                [&](int i, int k) { return ((bf16_t*)(C.P.ws + WS_PQKV)) + (size_t)(row0 + i) * PQW + C_CQ + k; },
                [&](int k, int j) { return gq[k] * Wq[(size_t)k * 768 + col0 + j]; }, acc);
            NG_EPI(acc, [&](int i, int j0, const float* a) { u32x2 o; o.x = pk2(a[0], a[1]); o.y = pk2(a[2], a[3]); *(u32x2*)(((bf16_t*)(C.P.ws + WS_QD)) + (size_t)(row0 + i) * 768 + col0 + j0) = o; });
        } else {
            const int j2 = it - nq; const int row0 = (j2 / 16) * 128, col0 = (j2 % 16) * 64;
            ngemm_tile(C.lds_f, C.tid, 256,
                [&](int i, int k) { return ((bf16_t*)(C.P.ws + WS_PQKV)) + (size_t)(row0 + i) * PQW + C_CKV + k; },
                [&](int k, int j) { return gk[k] * Wk[(size_t)k * 1024 + col0 + j]; }, acc);
            NG_EPI(acc, [&](int i, int j0, const float* a) { u32x2 o; o.x = pk2(a[0], a[1]); o.y = pk2(a[2], a[3]); *(u32x2*)(((bf16_t*)(C.P.ws + WS_KVD)) + (size_t)(row0 + i) * 1024 + col0 + j0) = o; });
        }
    }
}

__device__ __forceinline__ float inv_freq(int i, int n) { return exp2f(-(float)i / (float)n * 13.287712379549449f); }
__device__ __forceinline__ float grp16_sum(float v) { v += __shfl_xor(v, 1); v += __shfl_xor(v, 2); v += __shfl_xor(v, 4); v += __shfl_xor(v, 8); return v; }
__device__ __forceinline__ float grp8_sum(float v) { v += __shfl_xor(v, 1); v += __shfl_xor(v, 2); v += __shfl_xor(v, 4); return v; }
__device__ __forceinline__ float rms_inv(float ss, float inv_n) { return __builtin_amdgcn_rsqf(ss * inv_n + EPS); }
__device__ __forceinline__ void ph_post(const Ctx& C, int l, int rep = 0) {
    (void)rep;
    const int gw = C.blk * 8 + C.wave, NGW = C.nblk * 8, lane = C.lane, g = lane >> 4, j = lane & 15, jj = lane & 7, g8 = lane >> 3;
    float fh[2], fr[2];
#pragma unroll
    for (int e = 0; e < 2; ++e) { fh[e] = inv_freq((2 * j + e) & 15, 16); fr[e] = inv_freq((2 * jj + e) & 7, 8); }
    float ga[6][4];
    {
        const float* gp[6] = {C.P.in[9], C.P.in[12], C.P.in[14], C.P.in[10], C.P.in[13], C.P.in[15]};
#pragma unroll
        for (int f = 0; f < 6; ++f) { ga[f][0] = gp[f][l * 64 + 2 * j]; ga[f][1] = gp[f][l * 64 + 2 * j + 1]; ga[f][2] = gp[f][l * 64 + 32 + 2 * j]; ga[f][3] = gp[f][l * 64 + 33 + 2 * j]; }
    }
    const f32x4 g_qn = *(const f32x4*)(C.P.in[25] + l * 64 + 4 * j), g_kn = *(const f32x4*)(C.P.in[26] + l * 64 + 4 * j);
    float g_qr[4], g_kr[4];
    g_qr[0] = (C.P.in[27])[l * 32 + 2 * jj]; g_qr[1] = (C.P.in[27])[l * 32 + 2 * jj + 1]; g_qr[2] = (C.P.in[27])[l * 32 + 16 + 2 * jj]; g_qr[3] = (C.P.in[27])[l * 32 + 17 + 2 * jj];
    g_kr[0] = (C.P.in[28])[l * 32 + 2 * jj]; g_kr[1] = (C.P.in[28])[l * 32 + 2 * jj + 1]; g_kr[2] = (C.P.in[28])[l * 32 + 16 + 2 * jj]; g_kr[3] = (C.P.in[28])[l * 32 + 17 + 2 * jj];
    for (int r = gw; r < NT; r += NGW) {
        const bool lat = r < NL; const int t = r & 2047; const float prow = (float)(t >> 6), pcol = (float)(t & 63);
        float ch[2] = {1.f, 1.f}, sh[2] = {0.f, 0.f}, cr[2] = {1.f, 1.f}, sr[2] = {0.f, 0.f};
        if (lat) {
#pragma unroll
            for (int e = 0; e < 2; ++e) { __sincosf((j < 8 ? prow : pcol) * fh[e], &sh[e], &ch[e]); __sincosf((jj < 4 ? prow : pcol) * fr[e], &sr[e], &cr[e]); }
        }
        bf16_t* pq = ((bf16_t*)(C.P.ws + WS_PQKV)) + (size_t)r * PQW;
        bf16_t* kv = ((bf16_t*)(C.P.ws + WS_KVD)) + (size_t)r * 1024;
        bf16_t* qd = ((bf16_t*)(C.P.ws + WS_QD)) + (size_t)r * 768;
        const bool do_q = lat || l == 0;
        const u32x2 ckv_raw = *(const u32x2*)(pq + C_CKV + lane * 4);
        const u32x4 cq_raw = *(const u32x4*)(pq + C_CQ + lane * 8);
#pragma unroll
        for (int it = 6; it < 9; ++it) {
            const int hh = 4 * it + g;
            const int col = it < 6 ? hh * 64 : (it == 6 ? (g < 2 ? C_KA + g * 64 : C_KB + (g - 2) * 64) : C_KC + (hh - 28) * 64);
            const unsigned w0 = *(const unsigned*)(pq + col + 2 * j), w1 = *(const unsigned*)(pq + col + 32 + 2 * j);
            const float x0 = bf2f(w0 & 0xffffu), x1 = bf2f(w0 >> 16), x2 = bf2f(w1 & 0xffffu), x3 = bf2f(w1 >> 16);
            const float rinv = rms_inv(grp16_sum((x0 * x0 + x1 * x1) + (x2 * x2 + x3 * x3)), 1.f / 64.f);
            float ga0, ga1, ga2, ga3;
            if (it < 6) { ga0 = ga[it >> 1][0]; ga1 = ga[it >> 1][1]; ga2 = ga[it >> 1][2]; ga3 = ga[it >> 1][3]; }
            else if (it == 6) { ga0 = g < 2 ? ga[3][0] : ga[4][0]; ga1 = g < 2 ? ga[3][1] : ga[4][1]; ga2 = g < 2 ? ga[3][2] : ga[4][2]; ga3 = g < 2 ? ga[3][3] : ga[4][3]; }
            else { ga0 = ga[5][0]; ga1 = ga[5][1]; ga2 = ga[5][2]; ga3 = ga[5][3]; }
            const float sc = it < 6 ? QSCALE64 : 1.f;
            const float y0 = x0 * rinv * ga0 * sc, y1 = x1 * rinv * ga1 * sc, y2 = x2 * rinv * ga2 * sc, y3 = x3 * rinv * ga3 * sc;
            *(unsigned*)(pq + col + 2 * j) = pk2(y0 * ch[0] - y2 * sh[0], y1 * ch[1] - y3 * sh[1]);
            *(unsigned*)(pq + col + 32 + 2 * j) = pk2(y0 * sh[0] + y2 * ch[0], y1 * sh[1] + y3 * ch[1]);
        }
        {
            const unsigned w0 = lane < 8 ? *(const unsigned*)(pq + C_KR + 2 * jj) : 0u, w1 = lane < 8 ? *(const unsigned*)(pq + C_KR + 16 + 2 * jj) : 0u;
            const float x0 = bf2f(w0 & 0xffffu), x1 = bf2f(w0 >> 16), x2 = bf2f(w1 & 0xffffu), x3 = bf2f(w1 >> 16);
            const float rinv = rms_inv(grp8_sum((x0 * x0 + x1 * x1) + (x2 * x2 + x3 * x3)), 1.f / 32.f);
            const float y0 = x0 * rinv * g_kr[0], y1 = x1 * rinv * g_kr[1], y2 = x2 * rinv * g_kr[2], y3 = x3 * rinv * g_kr[3];
            if (lane < 8) { *(unsigned*)(pq + C_KR + 2 * jj) = pk2(y0 * cr[0] - y2 * sr[0], y1 * cr[1] - y3 * sr[1]); *(unsigned*)(pq + C_KR + 16 + 2 * jj) = pk2(y0 * sr[0] + y2 * cr[0], y1 * sr[1] + y3 * cr[1]); }
        }
        {
            float t4[4] = {bf2f(ckv_raw.x & 0xffffu), bf2f(ckv_raw.x >> 16), bf2f(ckv_raw.y & 0xffffu), bf2f(ckv_raw.y >> 16)};
            const float rkv = rms_inv(wave_sum((t4[0] * t4[0] + t4[1] * t4[1]) + (t4[2] * t4[2] + t4[3] * t4[3])), 1.f / 256.f);
#pragma unroll
            for (int it = 0; it < 2; ++it) {
                bf16_t* p = kv + (4 * it + g) * 128 + 4 * j;
                const u32x2 w = *(const u32x2*)p;
                const float x0 = rkv * bf2f(w.x & 0xffffu), x1 = rkv * bf2f(w.x >> 16), x2 = rkv * bf2f(w.y & 0xffffu), x3 = rkv * bf2f(w.y >> 16);
                const float rinv = rms_inv(grp16_sum((x0 * x0 + x1 * x1) + (x2 * x2 + x3 * x3)), 1.f / 64.f);
                u32x2 o; o.x = pk2(x0 * rinv * g_kn[0], x1 * rinv * g_kn[1]); o.y = pk2(x2 * rinv * g_kn[2], x3 * rinv * g_kn[3]); *(u32x2*)p = o;
            }
            {
                bf16_t* p = kv + g8 * 128 + 64 + jj * 8;
                float v8[8]; unpack8(*(const u32x4*)p, v8);
                u32x4 o; o.x = pk2(rkv * v8[0], rkv * v8[1]); o.y = pk2(rkv * v8[2], rkv * v8[3]); o.z = pk2(rkv * v8[4], rkv * v8[5]); o.w = pk2(rkv * v8[6], rkv * v8[7]); *(u32x4*)p = o;
            }
        }
        if (do_q) {
            float t8[8]; unpack8(cq_raw, t8);
            float ss = 0.f;
#pragma unroll
            for (int q = 0; q < 8; ++q) ss += t8[q] * t8[q];
            const float rq = rms_inv(wave_sum(ss), 1.f / 512.f);
            if (lane == 0) ((float*)(C.P.ws + WS_RQ))[r] = rq;
        }
    }
}

struct AttnArgs {
    const bf16_t* q; int qpitch; const bf16_t* k1; int k1pitch; const bf16_t* k2; int k2pitch; const bf16_t* v; int vpitch;
    float scale, sink; bool has_sink, windowed, qctx, lat_keys; int b, q0, nq;
};
template <int DQK, int DV>
__device__ __forceinline__ void nattn_core(float* lds_f, int tid, const AttnArgs& a, float (&o)[DV]) {
    float* Ks = lds_f; float* Vs = lds_f + 32 * DQK;
    const int qpos = a.q0 + tid; const bool valid = tid < a.nq;
    const size_t qrow = valid ? (a.qctx ? (size_t)(NL + a.b * CTXL + qpos) : (size_t)(a.b * SEQ + qpos)) : (size_t)0;
    float q[DQK];
    {
        const bf16_t* qp = a.q + qrow * a.qpitch;
#pragma unroll
        for (int d8 = 0; d8 < DQK / 8; ++d8) { float t[8]; unpack8(*(const u32x4*)(qp + d8 * 8), t);
#pragma unroll
            for (int i = 0; i < 8; ++i) q[d8 * 8 + i] = t[i] * a.scale; }
    }
    float m = a.has_sink ? a.sink : -1e30f, ls = a.has_sink ? 1.f : 0.f;
#pragma unroll
    for (int d = 0; d < DV; ++d) o[d] = 0.f;
    auto tile = [&](size_t krow0, int kpos0, bool masked) {
        __syncthreads();
        for (int c = tid; c < 32 * DQK / 8; c += NTHREADS) {
            const int key = c / (DQK / 8), d8 = (c % (DQK / 8)) * 8;
            const bf16_t* src = d8 < 64 ? a.k1 + (krow0 + key) * a.k1pitch + d8 : a.k2 + (krow0 + key) * a.k2pitch + (d8 - 64);
            float t[8]; unpack8(*(const u32x4*)src, t);
#pragma unroll
            for (int i = 0; i < 8; ++i) Ks[key * DQK + d8 + i] = t[i];
        }
        for (int c = tid; c < 32 * DV / 8; c += NTHREADS) {
            const int key = c / (DV / 8), d8 = (c % (DV / 8)) * 8;
            float t[8]; unpack8(*(const u32x4*)(a.v + (krow0 + key) * a.vpitch + d8), t);
#pragma unroll
            for (int i = 0; i < 8; ++i) Vs[key * DV + d8 + i] = t[i];
        }
        __syncthreads();
        for (int j = 0; j < 32; ++j) {
            int dist = qpos - (kpos0 + j); dist = dist < 0 ? -dist : dist;
            const bool ok = valid && (!masked || dist <= 128);
            if (ok) {
                float s = 0.f; const f32x4* kp = (const f32x4*)(Ks + j * DQK);
#pragma unroll
                for (int d4 = 0; d4 < DQK / 4; ++d4) { const f32x4 kv = kp[d4]; s += q[4 * d4] * kv.x + q[4 * d4 + 1] * kv.y + q[4 * d4 + 2] * kv.z + q[4 * d4 + 3] * kv.w; }
                if (s > m) { const float corr = exp2f(m - s); ls *= corr;
#pragma unroll
                    for (int d = 0; d < DV; ++d) o[d] *= corr;
                    m = s; }
                const float p = exp2f(s - m); ls += p; const f32x4* vp = (const f32x4*)(Vs + j * DV);
#pragma unroll
                for (int d4 = 0; d4 < DV / 4; ++d4) { const f32x4 vv = vp[d4]; o[4 * d4] += p * vv.x; o[4 * d4 + 1] += p * vv.y; o[4 * d4 + 2] += p * vv.z; o[4 * d4 + 3] += p * vv.w; }
            }
        }
    };
    if (a.lat_keys) {
        int lo = 0, hi = SEQ;
        if (a.windowed) { lo = a.q0 - 128; lo = lo < 0 ? 0 : lo; lo &= ~31; hi = a.q0 + a.nq + 128; hi = hi > SEQ ? SEQ : hi; }
        for (int kp = lo; kp < hi; kp += 32) tile((size_t)(a.b * SEQ + kp), kp, a.windowed);
    }
    for (int kp = 0; kp < CTXL; kp += 32) tile((size_t)(NL + a.b * CTXL + kp), 0, false);
    const float inv = ls > 0.f ? 1.f / ls : 0.f;
#pragma unroll
    for (int d = 0; d < DV; ++d) o[d] *= inv;
    __syncthreads();
}
__device__ __forceinline__ void store_o64(bf16_t* dst, const float (&o)[64]) {
#pragma unroll
    for (int d8 = 0; d8 < 8; ++d8) { u32x4 w; w.x = pk2(o[d8 * 8], o[d8 * 8 + 1]); w.y = pk2(o[d8 * 8 + 2], o[d8 * 8 + 3]); w.z = pk2(o[d8 * 8 + 4], o[d8 * 8 + 5]); w.w = pk2(o[d8 * 8 + 6], o[d8 * 8 + 7]); *(u32x4*)(dst + d8 * 8) = w; }
}
__device__ __forceinline__ void ph_attn(const Ctx& C, int l) {
    const int n_lat = NBATCH * 4 * 28, n_ctx = (l == 0) ? NBATCH * 28 : 0;
    const float lam = __hip_atomic_load(&((float*)(C.P.ws + WS_CNT + 128))[l], __ATOMIC_RELAXED, __HIP_MEMORY_SCOPE_AGENT);
    const float lam_init = 0.8f - 0.6f * expf(-0.3f * (float)l);
    bf16_t* PQKV = (bf16_t*)(C.P.ws + WS_PQKV); bf16_t* BR = (bf16_t*)(C.P.ws + WS_BR);
    for (int it = C.blk; it < n_lat + n_ctx; it += C.nblk) {
        AttnArgs a; int hitem;
        if (it < n_lat) { hitem = it % 28; const int rest = it / 28; a.b = rest >> 2; a.q0 = (rest & 3) * 512; a.nq = 512; a.qctx = false; a.lat_keys = true; }
        else { const int j = it - n_lat; hitem = j % 28; a.b = j / 28; a.q0 = 0; a.nq = CTXL; a.qctx = true; a.lat_keys = false; }
        a.k2 = nullptr; a.k2pitch = 0; a.has_sink = false; a.sink = 0.f; a.windowed = false; a.scale = 1.0f;
        const bool valid = C.tid < a.nq;
        const size_t orow = valid ? (a.qctx ? (size_t)(NL + a.b * CTXL + a.q0 + C.tid) : (size_t)(a.b * SEQ + a.q0 + C.tid)) : (size_t)0;
        float o[64];
        if (hitem < 16) {
            const bool isA = hitem < 8; const int h = hitem & 7, kvh = h >> 2;
            a.q = PQKV + (isA ? C_QA : C_QB) + h * 64; a.qpitch = PQW;
            a.k1 = PQKV + (isA ? C_KA : C_KB) + kvh * 64; a.k1pitch = PQW;
            a.v = PQKV + (isA ? C_VA : C_VB) + kvh * 64; a.vpitch = PQW;
            if (isA) { a.has_sink = true; a.sink = (C.P.in[11])[l * 8 + h] * LOG2E; a.windowed = !a.qctx; }
            nattn_core<64, 64>(C.lds_f, C.tid, a, o);
            if (valid) store_o64(BR + orow * BRW + (isA ? 0 : 512) + h * 64, o);
        } else if (hitem < 20) {
            const int hc = hitem - 16;
            float* sc1 = (float*)(C.P.ws + WS_OC1) + (orow * 4 + hc) * 128;
            float ss = 0.f;
            for (int part = 0; part < 2; ++part)
                for (int ch = 0; ch < 2; ++ch) {
                    a.q = PQKV + C_QC + (2 * hc + part) * 64; a.qpitch = PQW; a.k1 = PQKV + C_KC + (2 * hc + part) * 64; a.k1pitch = PQW;
                    a.v = PQKV + C_VC + hc * 128 + ch * 64; a.vpitch = PQW;
                    nattn_core<64, 64>(C.lds_f, C.tid, a, o);
                    if (valid) {
                        f32x4* s4 = (f32x4*)(sc1 + ch * 64);
                        if (part == 0) {
#pragma unroll
                            for (int d4 = 0; d4 < 16; ++d4) s4[d4] = (f32x4){o[4 * d4], o[4 * d4 + 1], o[4 * d4 + 2], o[4 * d4 + 3]};
                        } else {
#pragma unroll
                            for (int d4 = 0; d4 < 16; ++d4) { const f32x4 o1 = s4[d4];
                                const f32x4 dl = (f32x4){o1.x - lam * o[4 * d4], o1.y - lam * o[4 * d4 + 1], o1.z - lam * o[4 * d4 + 2], o1.w - lam * o[4 * d4 + 3]};
                                ss += (dl.x * dl.x + dl.y * dl.y) + (dl.z * dl.z + dl.w * dl.w); s4[d4] = dl; }
                        }
                    }
                }
            if (valid) {
                const float rs = (1.0f / sqrtf(ss * (1.f / 128.f) + EPS)) * (1.f - lam_init);
                const float* gn = (C.P.in[20]) + l * 128;
                for (int ch = 0; ch < 2; ++ch) {
#pragma unroll
                    for (int d4 = 0; d4 < 16; ++d4) { const f32x4 dl = ((const f32x4*)(sc1 + ch * 64))[d4]; const f32x4 g4 = ((const f32x4*)(gn + ch * 64))[d4];
                        o[4 * d4] = dl.x * rs * g4.x; o[4 * d4 + 1] = dl.y * rs * g4.y; o[4 * d4 + 2] = dl.z * rs * g4.z; o[4 * d4 + 3] = dl.w * rs * g4.w; }
                    store_o64(BR + orow * BRW + 1024 + hc * 128 + ch * 64, o);
                }
            }
        } else {
            const int h = hitem - 20;
            bf16_t* QD = (bf16_t*)(C.P.ws + WS_QD); bf16_t* KVD = (bf16_t*)(C.P.ws + WS_KVD);
            a.q = QD + h * 96; a.qpitch = 768; a.k1 = KVD + h * 128; a.k1pitch = 1024; a.k2 = PQKV + C_KR; a.k2pitch = PQW; a.v = KVD + h * 128 + 64; a.vpitch = 1024;
            nattn_core<96, 64>(C.lds_f, C.tid, a, o);
            if (valid) store_o64(BR + orow * BRW + 1536 + h * 64, o);
        }
    }
}

__device__ __forceinline__ void ph_g3(const Ctx& C, int l) {
    const int nrt = (l == 0 ? NT : NL) / 128;
    for (int it = C.blk; it < nrt * 16; it += C.nblk) {
        const int row0 = (it >> 4) * 128, col0 = (it & 15) * 64;
        const int ty = C.tid >> 4, tx = C.tid & 15;
        float tot[4][4];
#pragma unroll
        for (int i = 0; i < 4; ++i)
#pragma unroll
            for (int j = 0; j < 4; ++j) tot[i][j] = 0.f;
        for (int n = 0; n < 4; ++n) {
            const float* W = (C.P.in[29]) + (size_t)(l * 4 + n) * 512 * 1024;
            float part[4][4];
            ngemm_tile(C.lds_f, C.tid, 512,
                [&](int i, int k) { return ((bf16_t*)(C.P.ws + WS_BR)) + (size_t)(row0 + i) * BRW + n * 512 + k; },
                [&](int k, int j) { return W[(size_t)k * 1024 + col0 + j]; }, part);
#pragma unroll
            for (int i = 0; i < 4; ++i) {
                const u32x2 g = *(const u32x2*)(((bf16_t*)(C.P.ws + WS_PG)) + (size_t)(row0 + ty * 4 + i) * PGW + n * 1024 + col0 + tx * 4);
                tot[i][0] += bf2f(g.x & 0xffffu) * part[i][0]; tot[i][1] += bf2f(g.x >> 16) * part[i][1]; tot[i][2] += bf2f(g.y & 0xffffu) * part[i][2]; tot[i][3] += bf2f(g.y >> 16) * part[i][3];
            }
        }
#pragma unroll
        for (int i = 0; i < 4; ++i) { u32x2 o; o.x = pk2(tot[i][0], tot[i][1]); o.y = pk2(tot[i][2], tot[i][3]); *(u32x2*)(((bf16_t*)(C.P.ws + WS_MERGED)) + (size_t)(row0 + ty * 4 + i) * 1024 + col0 + tx * 4) = o; }
    }
}
__device__ __forceinline__ void resid_store(const Ctx& C, int l, int mi, bool first, int row, int n, const float* a) {
    const int mrow = row < NL ? (row >> 11) : 8;
    const f32x4 mv = *(const f32x4*)(((float*)(C.P.ws + WS_MOD)) + (size_t)(l * 9 + mrow) * 6144 + mi * 1024 + n);
    float* dst = row < NL ? (C.P.out) + (size_t)row * 1024 + n : ((float*)(C.P.ws + WS_CX)) + (size_t)(row - NL) * 1024 + n;
    const float* base = first ? (row < NL ? (C.P.in[0]) + (size_t)row * 1024 + n : (C.P.in[2]) + (size_t)(row - NL) * 1024 + n) : dst;
    const f32x4 b = *(const f32x4*)base;
    *(f32x4*)dst = (f32x4){b.x + mv.x * a[0], b.y + mv.y * a[1], b.z + mv.z * a[2], b.w + mv.w * a[3]};
}
__device__ __forceinline__ void ph_g4(const Ctx& C, int l) {
    const float* W = (C.P.in[30]) + (size_t)l * 1024 * 1024;
    const int nrt = (l == 0 ? NT : NL) / 128;
    for (int it = C.blk; it < nrt * 16; it += C.nblk) {
        const int row0 = (it >> 4) * 128, col0 = (it & 15) * 64;
        float acc[4][4];
        ngemm_tile(C.lds_f, C.tid, 1024,
            [&](int i, int k) { return ((bf16_t*)(C.P.ws + WS_MERGED)) + (size_t)(row0 + i) * 1024 + k; },
            [&](int k, int j) { return W[(size_t)k * 1024 + col0 + j]; }, acc);
        NG_EPI(acc, [&](int i, int j0, const float* a) { resid_store(C, l, 2, l == 0, row0 + i, col0 + j0, a); });
    }
}
__device__ __forceinline__ void ph_g5(const Ctx& C) {
    for (int it = C.blk; it < (NT / 128) * 88; it += C.nblk) {
        const int row0 = (it / 88) * 128, col0 = (it % 88) * 64;
        float acc[4][4];
        ngemm_tile(C.lds_f, C.tid, 1024,
            [&](int i, int k) { return ((bf16_t*)(C.P.ws + WS_XN)) + (size_t)(row0 + i) * 1024 + k; },
            [&](int k, int j) { const int v = col0 + j; return (v & 1) ? (C.P.in[32])[(size_t)k * DFF + (v >> 1)] : (C.P.in[31])[(size_t)k * DFF + (v >> 1)]; }, acc);
        NG_EPI(acc, [&](int i, int j0, const float* a) { const int jj = (col0 + j0) >> 1; *(unsigned*)(((bf16_t*)(C.P.ws + WS_H)) + (size_t)(row0 + i) * DFF + jj) = pk2(siluf_(a[0]) * a[1], siluf_(a[2]) * a[3]); });
    }
}
__device__ __forceinline__ void ph_g6(const Ctx& C) {
    for (int it = C.blk; it < (NT / 128) * 16; it += C.nblk) {
        const int row0 = (it >> 4) * 128, col0 = (it & 15) * 64;
        float acc[4][4];
        ngemm_tile(C.lds_f, C.tid, DFF,
            [&](int i, int k) { return ((bf16_t*)(C.P.ws + WS_H)) + (size_t)(row0 + i) * DFF + k; },
            [&](int k, int j) { return (C.P.in[33])[(size_t)k * 1024 + col0 + j]; }, acc);
        NG_EPI(acc, [&](int i, int j0, const float* a) { resid_store(C, 0, 5, false, row0 + i, col0 + j0, a); });
    }
}

__device__ __forceinline__ void moe_starts(const Ctx& C, int (&cnt)[8], int (&ps)[9]) {
    ps[0] = 0;
#pragma unroll
    for (int e = 0; e < 8; ++e) { cnt[e] = __hip_atomic_load(&((int*)(C.P.ws + WS_CNT))[e], __ATOMIC_RELAXED, __HIP_MEMORY_SCOPE_AGENT); ps[e + 1] = ps[e] + ((cnt[e] + 255) & ~255); }
}
__device__ __forceinline__ void ph_assign(const Ctx& C) {
    int cnt[8], ps[9]; moe_starts(C, cnt, ps);
    const int gw = C.blk * 8 + C.wave, NGW = C.nblk * 8;
    for (int t0 = gw * 64; t0 < NL; t0 += NGW * 64) {
        const int tok = t0 + C.lane; const int ee = ((int*)(C.P.ws + WS_ROUTE_E))[tok];
#pragma unroll
        for (int k = 0; k < 2; ++k) {
            const int my = (ee >> (8 * k)) & 0xff; int pos = 0;
#pragma unroll
            for (int e = 0; e < 8; ++e) {
                const unsigned long long mask = __ballot(my == e);
                if (mask) {
                    int base = 0; const int leader = __ffsll((long long)mask) - 1;
                    if (C.lane == leader) base = atomicAdd(&((int*)(C.P.ws + WS_CNT))[16 + e], (int)__popcll(mask));
                    base = __shfl(base, leader);
                    if (my == e) pos = ps[e] + base + (int)__popcll(mask & ((1ull << C.lane) - 1ull));
                }
            }
            ((int*)(C.P.ws + WS_ROWMAP))[pos] = tok; ((int*)(C.P.ws + WS_POS))[2 * tok + k] = pos;
        }
    }
    if (C.blk == 0) {
#pragma unroll
        for (int e = 0; e < 8; ++e) for (int i = cnt[e] + C.tid; i < ps[e + 1] - ps[e]; i += NTHREADS) ((int*)(C.P.ws + WS_ROWMAP))[ps[e] + i] = -1;
    }
}
__device__ __forceinline__ int moe_expert_of(const int (&ps)[9], int p0) {
    int e = 0;
#pragma unroll
    for (int q = 1; q < 8; ++q) if (p0 >= ps[q]) e = q;
    return e;
}
__device__ __forceinline__ void ph_g7(const Ctx& C) {
    int cnt[8], ps[9]; moe_starts(C, cnt, ps);
    const int nrt = ps[8] / 128;
    for (int it = C.blk; it < nrt * 112; it += C.nblk) {
        const int p0 = (it / 112) * 128, col0 = (it % 112) * 64;
        const int e = moe_expert_of(ps, p0);
        int cnt_e = 0;
#pragma unroll
        for (int q = 0; q < 8; ++q) if (q == e) cnt_e = cnt[q];
        int ps_e = 0;
#pragma unroll
        for (int q = 0; q < 8; ++q) if (q == e) ps_e = ps[q];
        if (p0 >= ps_e + cnt_e) continue;
        const float* W1 = (C.P.in[35]) + (size_t)e * 1024 * EFF; const float* W3 = (C.P.in[36]) + (size_t)e * 1024 * EFF;
        float acc[4][4];
        ngemm_tile(C.lds_f, C.tid, 1024,
            [&](int i, int k) { const int tok = ((int*)(C.P.ws + WS_ROWMAP))[p0 + i]; return tok < 0 ? (const bf16_t*)nullptr : ((bf16_t*)(C.P.ws + WS_XN)) + (size_t)tok * 1024 + k; },
            [&](int k, int j) { const int v = col0 + j; return (v & 1) ? W3[(size_t)k * EFF + (v >> 1)] : W1[(size_t)k * EFF + (v >> 1)]; }, acc);
        NG_EPI(acc, [&](int i, int j0, const float* a) { const int jj = (col0 + j0) >> 1; *(unsigned*)(((bf16_t*)(C.P.ws + WS_HM)) + (size_t)(p0 + i) * EFF + jj) = pk2(siluf_(a[0]) * a[1], siluf_(a[2]) * a[3]); });
    }
}
__device__ __forceinline__ void ph_g8(const Ctx& C) {
    int cnt[8], ps[9]; moe_starts(C, cnt, ps);
    const int nrt = ps[8] / 128;
    for (int it = C.blk; it < nrt * 16; it += C.nblk) {
        const int p0 = (it >> 4) * 128, col0 = (it & 15) * 64;
        const int e = moe_expert_of(ps, p0);
        int cnt_e = 0, ps_e = 0;
#pragma unroll
        for (int q = 0; q < 8; ++q) if (q == e) { cnt_e = cnt[q]; ps_e = ps[q]; }
        if (p0 >= ps_e + cnt_e) continue;
        const float* W2 = (C.P.in[37]) + (size_t)e * EFF * 1024;
        float acc[4][4];
        ngemm_tile(C.lds_f, C.tid, EFF,
            [&](int i, int k) { return ((bf16_t*)(C.P.ws + WS_HM)) + (size_t)(p0 + i) * EFF + k; },
            [&](int k, int j) { return W2[(size_t)k * 1024 + col0 + j]; }, acc);
        NG_EPI(acc, [&](int i, int j0, const float* a) { u32x2 o; o.x = pk2(a[0], a[1]); o.y = pk2(a[2], a[3]); *(u32x2*)(((bf16_t*)(C.P.ws + WS_YM)) + (size_t)(p0 + i) * 1024 + col0 + j0) = o; });
    }
}
__device__ __forceinline__ void ph_combine(const Ctx& C) {
    const int gw = C.blk * 8 + C.wave, NGW = C.nblk * 8;
    for (int r = gw; r < NL; r += NGW) {
        const int p0 = ((int*)(C.P.ws + WS_POS))[2 * r], p1 = ((int*)(C.P.ws + WS_POS))[2 * r + 1]; const float w0 = ((float*)(C.P.ws + WS_ROUTE_W))[2 * r], w1 = ((float*)(C.P.ws + WS_ROUTE_W))[2 * r + 1];
        const float* m5 = ((float*)(C.P.ws + WS_MOD)) + (size_t)(9 + (r >> 11)) * 6144 + 5 * 1024;
#pragma unroll
        for (int j = 0; j < 4; ++j) {
            const int c4 = C.lane + 64 * j;
            const u32x2 a = ((const u32x2*)(((bf16_t*)(C.P.ws + WS_YM)) + (size_t)p0 * 1024))[c4], b = ((const u32x2*)(((bf16_t*)(C.P.ws + WS_YM)) + (size_t)p1 * 1024))[c4];
            const f32x4 mv = ((const f32x4*)m5)[c4]; f32x4 o = ((const f32x4*)((C.P.out) + (size_t)r * 1024))[c4];
            o.x += mv.x * (w0 * bf2f(a.x & 0xffffu) + w1 * bf2f(b.x & 0xffffu)); o.y += mv.y * (w0 * bf2f(a.x >> 16) + w1 * bf2f(b.x >> 16));
            o.z += mv.z * (w0 * bf2f(a.y & 0xffffu) + w1 * bf2f(b.y & 0xffffu)); o.w += mv.w * (w0 * bf2f(a.y >> 16) + w1 * bf2f(b.y >> 16));
            ((f32x4*)((C.P.out) + (size_t)r * 1024))[c4] = o;
        }
    }
}

#define LAS __attribute__((address_space(3)))
typedef short bf16x8 __attribute__((ext_vector_type(8)));
constexpr int BM = 256, BK = 64, HALF = 128, HTB = HALF * BK * 2, NXCD = 8, WGM = 8;
__device__ __forceinline__ int lds_byte(int r, int c) { const int st = (r >> 4) * 2 + (c >> 5), rr = r & 15, cc = c & 31, ob = rr * 64 + cc * 2; return st * 1024 + (ob ^ (((ob >> 9) & 1) << 5)); }
__device__ __forceinline__ void stage_rc(int b, int& R, int& C) { const int st = b / 1024, sb = b % 1024, swz = sb ^ (((sb >> 9) & 1) << 5); R = (st >> 1) * 16 + swz / 64; C = (st & 1) * 32 + (swz % 64) / 2; }
__device__ __forceinline__ int perm32(int rho) { const int n = rho >> 4, i = rho & 15; return 8 * (i >> 2) + 4 * n + (i & 3); }
__device__ __forceinline__ unsigned cvt_pk_bf16(float lo, float hi) { f32x2_t v = {lo, hi}; bf16x2_t b = __builtin_convertvector(v, bf16x2_t); return __builtin_bit_cast(unsigned, b); }

struct GUnit { const char* A; const char* B; int pm, pn, aux; };
__device__ __forceinline__ bool static_order(int nM, int nN, int G, int c, int i, int& pm, int& pn) {
    const int nwg = nM * nN; const long L = (long)i * G + c; if (L >= nwg) return false;
    int wgid = (int)L; { const int q = nwg / NXCD, r = nwg % NXCD, xcd = wgid % NXCD, off = wgid / NXCD; wgid = (xcd < r ? xcd * (q + 1) : r * (q + 1) + (xcd - r) * q) + off; }
    const int nig = WGM * nN, gid = wgid / nig, fm = gid * WGM, gsz = (nM - fm) < WGM ? (nM - fm) : WGM;
    pm = fm + ((wgid % nig) % gsz); pn = (wgid % nig) / gsz; return true;
}

typedef f32x4 Acc[2][2][4][2];
template <bool PERM, bool GATHER, bool HALFN, class Sched, class Epi>
__device__ __forceinline__ void gemm_phase_t(LAS unsigned char* lds, const int K, const int lda, const Sched& S, Epi& E) {
    const int tid = threadIdx.x, wid = __builtin_amdgcn_readfirstlane(tid >> 6), lane = tid & 63, wr = wid >> 2, wc = wid & 3, fr = lane & 15, fq = lane >> 4;
    const int nt = K / BK;
    unsigned voffB[2]; int RA[2], CA[2];
#pragma unroll
    for (int i = 0; i < 2; ++i) { int R, C; stage_rc(tid * 16 + i * 8192, R, C); const int Rb = PERM ? ((R & ~31) + perm32(R & 31)) : R; voffB[i] = (unsigned)(Rb * K + C) * 2u; RA[i] = R; CA[i] = C; }
    const size_t kstep = (size_t)(BK * 2);
    const size_t hstepB = (size_t)HALF * K * 2;
    const unsigned ldsw = (unsigned)wid * 1024u;
    const int aoff = lds_byte(wr * 64 + fr, fq * 8), boff = lds_byte(wc * 32 + fr, fq * 8);
#define PG8_SA(b, h) (((b) * 2 + (h)) * HTB)
#define PG8_SB(b, h) ((4 + (b) * 2 + (h)) * HTB)
#define PG8_STAGE(bufoff, gbase, voff) do { _Pragma("unroll") for (int _i = 0; _i < 2; ++_i) \
        __builtin_amdgcn_global_load_lds((const unsigned*)((const char*)(gbase) + (voff)[_i]), (LAS unsigned*)(lds + (bufoff) + ldsw + _i * 8192), 16, 0, 0); } while (0)
#define PG8_LDA(dst, b, h) do { _Pragma("unroll") for (int m = 0; m < 4; ++m) _Pragma("unroll") for (int k = 0; k < 2; ++k) dst[m][k] = *(const LAS bf16x8*)(lds + PG8_SA(b, h) + aoff + m * 2048 + k * 1024); } while (0)
#define PG8_LDB(dst, b, h) do { _Pragma("unroll") for (int n = 0; n < 2; ++n) _Pragma("unroll") for (int k = 0; k < 2; ++k) dst[n][k] = *(const LAS bf16x8*)(lds + PG8_SB(b, h) + boff + n * 2048 + k * 1024); } while (0)
#define PG8_MMA(ai, bj, At, Bt) do { __builtin_amdgcn_s_setprio(1); _Pragma("unroll") for (int m = 0; m < 4; ++m) _Pragma("unroll") for (int n = 0; n < 2; ++n) _Pragma("unroll") for (int k = 0; k < 2; ++k) \
        acc[ai][bj][m][n] = __builtin_amdgcn_mfma_f32_16x16x32_bf16(Bt[n][k], At[m][k], acc[ai][bj][m][n], 0, 0, 0); __builtin_amdgcn_s_setprio(0); } while (0)
#define PG8_WAIT_V(n) asm volatile("s_waitcnt vmcnt(" #n ")" ::: "memory")
#define PG8_WAIT_L(n) asm volatile("s_waitcnt lgkmcnt(" #n ")" ::: "memory")
#define PG8_BAR __builtin_amdgcn_s_barrier()
#define PG8_SCHED __builtin_amdgcn_sched_barrier(0)
#define PG8_OFFA(u, o) do { _Pragma("unroll") for (int h_ = 0; h_ < 2; ++h_) _Pragma("unroll") for (int i_ = 0; i_ < 2; ++i_) { const int row_ = h_ * HALF + RA[i_]; \
        if constexpr (GATHER) o[h_][i_] = S.row_off(u, row_) + (unsigned)CA[i_] * 2u; else o[h_][i_] = (unsigned)(row_ * lda + CA[i_]) * 2u; } } while (0)
    GUnit cur, nxt; int ui = 0;
    if (!S.next(0, cur)) return;
    Acc acc;
#pragma unroll
    for (int a = 0; a < 2; ++a)
#pragma unroll
        for (int b = 0; b < 2; ++b)
#pragma unroll
            for (int m = 0; m < 4; ++m)
#pragma unroll
                for (int n = 0; n < 2; ++n) acc[a][b][m][n] = (f32x4){0.f, 0.f, 0.f, 0.f};
    bf16x8 At[4][2], B0[2][2], B1[2][2];
    unsigned oc[2][2], on[2][2];
    PG8_OFFA(cur, oc);
#pragma unroll
    for (int h = 0; h < 2; ++h)
#pragma unroll
        for (int i = 0; i < 2; ++i) on[h][i] = oc[h][i];
    const char* cA = cur.A; const char* cB = cur.B;
    if constexpr (HALFN) {
        PG8_STAGE(PG8_SB(0, 0), cB, voffB); PG8_STAGE(PG8_SA(0, 0), cA, oc[0]); PG8_STAGE(PG8_SA(0, 1), cA, oc[1]);
        if (wr == 1) PG8_BAR;
        PG8_WAIT_V(2); PG8_BAR;
        PG8_STAGE(PG8_SB(1, 0), cB + kstep, voffB); PG8_STAGE(PG8_SA(1, 0), cA + kstep, oc[0]);
        PG8_WAIT_V(4); PG8_BAR;
    } else {
    PG8_STAGE(PG8_SB(0, 0), cB, voffB); PG8_STAGE(PG8_SB(0, 1), cB + hstepB, voffB); PG8_STAGE(PG8_SA(0, 0), cA, oc[0]); PG8_STAGE(PG8_SA(0, 1), cA, oc[1]);
    if (wr == 1) PG8_BAR;
    PG8_WAIT_V(2); PG8_BAR;
    PG8_STAGE(PG8_SB(1, 0), cB + kstep, voffB); PG8_STAGE(PG8_SA(1, 0), cA + kstep, oc[0]); PG8_STAGE(PG8_SB(1, 1), cB + hstepB + kstep, voffB);
    PG8_WAIT_V(6); PG8_BAR;
    }
    for (;;) {
        const bool has_next = S.next(ui + 1, nxt);
        const char* nA = has_next ? nxt.A : cA; const char* nB = has_next ? nxt.B : cB;
        if constexpr (GATHER) { if (has_next) PG8_OFFA(nxt, on); }
        for (int t = 0; t < nt; t += 2) {
            const bool last = (t == nt - 2);
            const char* a1 = cA + (size_t)(t + 1) * kstep;
            const char* a2 = last ? nA : cA + (size_t)(t + 2) * kstep; const char* b2 = last ? nB : cB + (size_t)(t + 2) * kstep;
            const char* a3 = a2 + kstep; const char* b3 = b2 + kstep;
            unsigned o2[2][2];
#pragma unroll
            for (int h = 0; h < 2; ++h)
#pragma unroll
                for (int i = 0; i < 2; ++i) { if constexpr (GATHER) o2[h][i] = last ? on[h][i] : oc[h][i]; else o2[h][i] = oc[h][i]; }
            if constexpr (HALFN) {
            PG8_LDB(B0, 0, 0); PG8_SCHED; PG8_LDA(At, 0, 0); PG8_STAGE(PG8_SA(1, 1), a1, oc[1]);
            PG8_WAIT_V(6); PG8_WAIT_L(0); PG8_BAR; PG8_MMA(0, 0, At, B0); PG8_BAR; PG8_SCHED;
            PG8_LDA(At, 0, 1); PG8_STAGE(PG8_SB(0, 0), b2, voffB); PG8_STAGE(PG8_SA(0, 0), a2, o2[0]);
            PG8_WAIT_V(6); PG8_WAIT_L(0); PG8_BAR; PG8_MMA(1, 0, At, B0); PG8_BAR; PG8_SCHED;
            PG8_LDB(B0, 1, 0); PG8_SCHED; PG8_LDA(At, 1, 0); PG8_STAGE(PG8_SA(0, 1), a2, o2[1]);
            PG8_WAIT_V(6); PG8_WAIT_L(0); PG8_BAR; PG8_MMA(0, 0, At, B0); PG8_BAR; PG8_SCHED;
            PG8_LDA(At, 1, 1); PG8_STAGE(PG8_SB(1, 0), b3, voffB); PG8_STAGE(PG8_SA(1, 0), a3, o2[0]);
            PG8_WAIT_V(6); PG8_WAIT_L(0); PG8_BAR; PG8_MMA(1, 0, At, B0); PG8_BAR; PG8_SCHED;
            } else {
            PG8_LDB(B0, 0, 0); PG8_LDB(B1, 0, 1); PG8_SCHED; PG8_LDA(At, 0, 0); PG8_STAGE(PG8_SA(1, 1), a1, oc[1]);
            PG8_WAIT_V(8); PG8_WAIT_L(0); PG8_BAR; PG8_MMA(0, 0, At, B0); PG8_MMA(0, 1, At, B1); PG8_BAR; PG8_SCHED;
            PG8_LDA(At, 0, 1); PG8_STAGE(PG8_SB(0, 0), b2, voffB); PG8_STAGE(PG8_SB(0, 1), b2 + hstepB, voffB); PG8_STAGE(PG8_SA(0, 0), a2, o2[0]);
            PG8_WAIT_V(8); PG8_WAIT_L(0); PG8_BAR; PG8_MMA(1, 0, At, B0); PG8_MMA(1, 1, At, B1); PG8_BAR; PG8_SCHED;
            PG8_LDB(B0, 1, 0); PG8_LDB(B1, 1, 1); PG8_SCHED; PG8_LDA(At, 1, 0); PG8_STAGE(PG8_SA(0, 1), a2, o2[1]);
            PG8_WAIT_V(8); PG8_WAIT_L(0); PG8_BAR; PG8_MMA(0, 0, At, B0); PG8_MMA(0, 1, At, B1); PG8_BAR; PG8_SCHED;
            PG8_LDA(At, 1, 1); PG8_STAGE(PG8_SB(1, 0), b3, voffB); PG8_STAGE(PG8_SB(1, 1), b3 + hstepB, voffB); PG8_STAGE(PG8_SA(1, 0), a3, o2[0]);
            PG8_WAIT_V(8); PG8_WAIT_L(0); PG8_BAR; PG8_MMA(1, 0, At, B0); PG8_MMA(1, 1, At, B1); PG8_BAR; PG8_SCHED;
            }
        }
        if (wr == 0) PG8_BAR;
        E(acc, cur, wr, wc, fr, fq);
        if (!has_next) break;
#pragma unroll
        for (int a = 0; a < 2; ++a)
#pragma unroll
            for (int b = 0; b < 2; ++b)
#pragma unroll
                for (int m = 0; m < 4; ++m)
#pragma unroll
                    for (int n = 0; n < 2; ++n) acc[a][b][m][n] = (f32x4){0.f, 0.f, 0.f, 0.f};
        cur = nxt; cA = nA; cB = nB; ++ui;
        if constexpr (GATHER) {
#pragma unroll
            for (int h = 0; h < 2; ++h)
#pragma unroll
                for (int i = 0; i < 2; ++i) oc[h][i] = on[h][i];
        }
        if (wr == 1) PG8_BAR;
    }
    PG8_WAIT_V(0);
    PG8_BAR;
#undef PG8_SA
#undef PG8_SB
#undef PG8_STAGE
#undef PG8_LDA
#undef PG8_LDB
#undef PG8_MMA
#undef PG8_WAIT_V
#undef PG8_WAIT_L
#undef PG8_BAR
#undef PG8_SCHED
#undef PG8_OFFA
}

template <bool PERM, bool GATHER, class Sched, class Epi>
__device__ __forceinline__ void gemm_phase(LAS unsigned char* lds, const int K, const int lda, const Sched& S, const Epi& E) { Epi E2 = E; gemm_phase_t<PERM, GATHER, false>(lds, K, lda, S, E2); }

__device__ __forceinline__ u32x4 pack8(const f32x4 v0, const f32x4 v1) { u32x4 w; w.x = cvt_pk_bf16(v0[0], v0[1]); w.y = cvt_pk_bf16(v0[2], v0[3]); w.z = cvt_pk_bf16(v1[0], v1[1]); w.w = cvt_pk_bf16(v1[2], v1[3]); return w; }
__device__ __forceinline__ float fsig(float x) { return __builtin_amdgcn_rcpf(1.f + __builtin_amdgcn_exp2f(-LOG2E * x)); }
__device__ __forceinline__ f32x4 sig4(f32x4 v) { return (f32x4){fsig(v[0]), fsig(v[1]), fsig(v[2]), fsig(v[3])}; }
__device__ __forceinline__ void epi_store_bf16(const Acc& acc, bf16_t* O, int ldc, int row0, int col0, bool sig, int wr, int wc, int fr, int fq) {
#pragma unroll
    for (int ai = 0; ai < 2; ++ai)
#pragma unroll
        for (int m = 0; m < 4; ++m) { bf16_t* rowp = O + (size_t)(row0 + ai * HALF + wr * 64 + m * 16 + fr) * ldc + col0 + wc * 32 + 8 * fq;
#pragma unroll
            for (int bj = 0; bj < 2; ++bj) { f32x4 v0 = acc[ai][bj][m][0], v1 = acc[ai][bj][m][1]; if (sig) { v0 = sig4(v0); v1 = sig4(v1); } *(u32x4*)(rowp + bj * HALF) = pack8(v0, v1); } }
}

template <class RM>
__device__ __forceinline__ void transpose_item(const float* W, int K, int N, int ldk, bf16_t* WT, RM rowmap, const float* ksc, float* scr, int k0, int n0, int lane) {
    float tv[32];
#pragma unroll
    for (int i = 0; i < 32; ++i) tv[i] = W[(size_t)(k0 + 2 * i + (lane >> 5)) * N + n0 + (lane & 31)];
    if (ksc) {
#pragma unroll
        for (int i = 0; i < 32; ++i) tv[i] *= ksc[k0 + 2 * i + (lane >> 5)];
    }
#pragma unroll
    for (int i = 0; i < 32; ++i) scr[(2 * i + (lane >> 5)) * 33 + (lane & 31)] = tv[i];
    asm volatile("s_waitcnt lgkmcnt(0)" ::: "memory");
    const int c = lane & 7;
#pragma unroll
    for (int j = 0; j < 4; ++j) { const int n = (lane >> 3) + 8 * j; const float* s = scr + (8 * c) * 33 + n;
        u32x4 o; o.x = pk2(s[0 * 33], s[1 * 33]); o.y = pk2(s[2 * 33], s[3 * 33]); o.z = pk2(s[4 * 33], s[5 * 33]); o.w = pk2(s[6 * 33], s[7 * 33]);
        *(u32x4*)(WT + (size_t)rowmap(n0 + n) * ldk + k0 + 8 * c) = o; }
    asm volatile("s_waitcnt lgkmcnt(0)" ::: "memory");
}

constexpr size_t WS_WIN_T = 76 * MiB;
constexpr size_t WS_WBR_T = 108 * MiB;
constexpr size_t WS_WOUT_T = 116 * MiB;
constexpr size_t WS_WUQ_T = 120 * MiB;
constexpr size_t WS_WUKV_T = 121 * MiB + 512 * 1024;
constexpr size_t WS_FFGU_T = 123 * MiB + 512 * 1024;
constexpr size_t WS_FFD_T = 134 * MiB + 512 * 1024;
constexpr size_t WS_MACC = 184 * MiB;
constexpr size_t WS_W13_T = 40 * MiB;
constexpr size_t WS_W2_T = 152 * MiB;
constexpr int CONV_LDS_OFF = 65536;

template <class RM>
__device__ __forceinline__ void transpose_item64(const float* W, int K, int N, int ldk, bf16_t* WT, RM rowmap, const float* ksc, float* scr, int k0, int n0, int lane) {
#pragma unroll
    for (int h = 0; h < 2; ++h) {
        float tv[32];
#pragma unroll
        for (int i = 0; i < 32; ++i) tv[i] = W[(size_t)(k0 + 32 * h + i) * N + n0 + lane];
        if (ksc) {
#pragma unroll
            for (int i = 0; i < 32; ++i) tv[i] *= ksc[k0 + 32 * h + i];
        }
#pragma unroll
        for (int i = 0; i < 32; ++i) scr[(32 * h + i) * 65 + lane] = tv[i];
    }
    asm volatile("s_waitcnt lgkmcnt(0)" ::: "memory");
    const int c = lane & 7;
#pragma unroll
    for (int j = 0; j < 8; ++j) { const int n = (lane >> 3) + 8 * j; const float* sp = scr + (8 * c) * 65 + n;
        u32x4 o; o.x = pk2(sp[0 * 65], sp[1 * 65]); o.y = pk2(sp[2 * 65], sp[3 * 65]); o.z = pk2(sp[4 * 65], sp[5 * 65]); o.w = pk2(sp[6 * 65], sp[7 * 65]);
        *(u32x4*)(WT + (size_t)rowmap(n0 + n) * ldk + k0 + 8 * c) = o; }
    asm volatile("s_waitcnt lgkmcnt(0)" ::: "memory");
}

struct ConvJob { const float* W; bf16_t* WT; const float* ksc; int K, N, kind, nitems, ldk; };
__device__ __forceinline__ int conv_rowmap(int kind, int n) {
    return kind == 0 ? n : (kind == 1 ? (n < 3872 ? n : n + 224) : ((n >> 7) * 256 + (n & 127) + (kind == 3 ? 128 : 0)));
}
__device__ __forceinline__ ConvJob conv_job_small(const Ctx& C, int j) {
    ConvJob J; J.ksc = nullptr; J.kind = 0;
    if (j < 2) { J.W = C.P.in[8] + (size_t)j * 1024 * IN_COLS; J.WT = (bf16_t*)(C.P.ws + WS_WIN_T) + (size_t)j * 8192 * 1024; J.K = 1024; J.N = IN_COLS; J.kind = 1; }
    else if (j < 4) { const int l = j - 2; J.W = C.P.in[23] + (size_t)l * 512 * 768; J.WT = (bf16_t*)(C.P.ws + WS_WUQ_T) + (size_t)l * 768 * 512; J.K = 512; J.N = 768; J.ksc = C.P.in[21] + l * 512; }
    else if (j < 6) { const int l = j - 4; J.W = C.P.in[24] + (size_t)l * 256 * 1024; J.WT = (bf16_t*)(C.P.ws + WS_WUKV_T) + (size_t)l * 1024 * 512; J.K = 256; J.N = 1024; J.ksc = C.P.in[22] + l * 256; J.ldk = 512; }
    else if (j < 14) { const int q = j - 6; J.W = C.P.in[29] + (size_t)q * 512 * 1024; J.WT = (bf16_t*)(C.P.ws + WS_WBR_T) + (size_t)q * 1024 * 512; J.K = 512; J.N = 1024; }
    else if (j < 16) { const int l = j - 14; J.W = C.P.in[30] + (size_t)l * 1024 * 1024; J.WT = (bf16_t*)(C.P.ws + WS_WOUT_T) + (size_t)l * 1024 * 1024; J.K = 1024; J.N = 1024; }
    else if (j == 16) { J.W = C.P.in[31]; J.WT = (bf16_t*)(C.P.ws + WS_FFGU_T); J.K = 1024; J.N = DFF; J.kind = 2; }
    else if (j == 17) { J.W = C.P.in[32]; J.WT = (bf16_t*)(C.P.ws + WS_FFGU_T); J.K = 1024; J.N = DFF; J.kind = 3; }
    else { J.W = C.P.in[33]; J.WT = (bf16_t*)(C.P.ws + WS_FFD_T); J.K = DFF; J.N = 1024; }
    J.nitems = (J.K / 64) * ((J.N + 63) / 64); if (j < 4 || j >= 6) J.ldk = J.K;
    return J;
}
__device__ __forceinline__ ConvJob conv_job_moe(const Ctx& C, int j) {
    ConvJob J; J.ksc = nullptr; const int e = j / 3, t = j % 3;
    if (t == 0) { J.W = C.P.in[35] + (size_t)e * 1024 * EFF; J.WT = (bf16_t*)(C.P.ws + WS_W13_T) + (size_t)e * 7168 * 1024; J.K = 1024; J.N = EFF; J.kind = 2; }
    else if (t == 1) { J.W = C.P.in[36] + (size_t)e * 1024 * EFF; J.WT = (bf16_t*)(C.P.ws + WS_W13_T) + (size_t)e * 7168 * 1024; J.K = 1024; J.N = EFF; J.kind = 3; }
    else { J.W = C.P.in[37] + (size_t)e * EFF * 1024; J.WT = (bf16_t*)(C.P.ws + WS_W2_T) + (size_t)e * 1024 * EFF; J.K = EFF; J.N = 1024; J.kind = 0; }
    J.nitems = (J.K / 64) * (J.N / 64); J.ldk = J.K;
    return J;
}
template <bool MOE>
__device__ __forceinline__ void conv_weights(const Ctx& C) {
    float* scr = C.lds_f + C.wave * (64 * 65);
    const int gw = C.blk * 8 + C.wave, NGW = C.nblk * 8;
    constexpr int NJ = MOE ? 24 : 19;
    int total = 0;
    for (int j = 0; j < NJ; ++j) total += (MOE ? conv_job_moe(C, j) : conv_job_small(C, j)).nitems;
    for (int it = gw; it < total; it += NGW) {
        int r = it;
        for (int j = 0; j < NJ; ++j) {
            const ConvJob J = MOE ? conv_job_moe(C, j) : conv_job_small(C, j);
            if (r < J.nitems) { const int kind = J.kind; const int nblk = (J.N + 63) / 64, k0 = 64 * (r / nblk), n0 = 64 * (r % nblk);
                if (n0 + 64 <= J.N) transpose_item64(J.W, J.K, J.N, J.ldk, J.WT, [&](int n) { return conv_rowmap(kind, n); }, J.ksc, scr, k0, n0, C.lane);
                else transpose_item(J.W, J.K, J.N, J.ldk, J.WT, [&](int n) { return conv_rowmap(kind, n); }, J.ksc, scr, k0, n0, C.lane);
                break; }
            r -= J.nitems;
        }
    }
    if (!MOE) {
        const int gt = C.blk * NTHREADS + C.tid, NGT = C.nblk * NTHREADS;
        for (int i = gt; i < 2 * 1024 * 32; i += NGT) { const int row = i >> 5, q = i & 31; ((u32x4*)((bf16_t*)(C.P.ws + WS_WUKV_T) + (size_t)row * 512 + 256))[q] = (u32x4){0u, 0u, 0u, 0u}; }
    }
    if (!MOE) {
        const int gt = C.blk * NTHREADS + C.tid, NGT = C.nblk * NTHREADS;
        for (int i = gt; i < 2 * 224 * 128; i += NGT) { const int l = i / (224 * 128), q = i % (224 * 128);
            ((u32x4*)((bf16_t*)(C.P.ws + WS_WIN_T) + ((size_t)l * 8192 + 3872) * 1024))[q] = (u32x4){0u, 0u, 0u, 0u}; }
    }
}

__device__ __forceinline__ float silu_mul(float g, float u) { return g * u * __builtin_amdgcn_rcpf(1.f + __builtin_amdgcn_exp2f(-LOG2E * g)); }
__device__ __forceinline__ void epi_swiglu(const Acc& acc, bf16_t* O, int ldc, int row0, int col0, int wr, int wc, int fr, int fq) {
#pragma unroll
    for (int ai = 0; ai < 2; ++ai)
#pragma unroll
        for (int m = 0; m < 4; ++m) {
            f32x4 h0, h1;
#pragma unroll
            for (int q = 0; q < 4; ++q) { h0[q] = silu_mul(acc[ai][0][m][0][q], acc[ai][1][m][0][q]); h1[q] = silu_mul(acc[ai][0][m][1][q], acc[ai][1][m][1][q]); }
            *(u32x4*)(O + (size_t)(row0 + ai * HALF + wr * 64 + m * 16 + fr) * ldc + col0 + wc * 32 + 8 * fq) = pack8(h0, h1);
        }
}
__device__ __forceinline__ void epi_resid(const Ctx& C, const Acc& acc, int l, int mi, bool first, int row0, int col0, int wr, int wc, int fr, int fq) {
#pragma unroll
    for (int ai = 0; ai < 2; ++ai)
#pragma unroll
        for (int m = 0; m < 4; ++m) {
            const int row = row0 + ai * HALF + wr * 64 + m * 16 + fr;
            const int mrow = row < NL ? (row >> 11) : 8;
            const float* modp = (const float*)(C.P.ws + WS_MOD) + (size_t)(l * 9 + mrow) * 6144 + mi * 1024;
            float* dst = row < NL ? C.P.out + (size_t)row * 1024 : (float*)(C.P.ws + WS_CX) + (size_t)(row - NL) * 1024;
            const float* base = first ? (row < NL ? C.P.in[0] + (size_t)row * 1024 : C.P.in[2] + (size_t)(row - NL) * 1024) : dst;
#pragma unroll
            for (int bj = 0; bj < 2; ++bj)
#pragma unroll
                for (int n = 0; n < 2; ++n) { const int col = col0 + bj * HALF + wc * 32 + n * 16 + 4 * fq;
                    const f32x4 b = *(const f32x4*)(base + col), mv = *(const f32x4*)(modp + col); *(f32x4*)(dst + col) = b + mv * acc[ai][bj][m][n]; }
        }
}

struct SchedG1 { const char* A; const char* B; int l, G, c;
    __device__ __forceinline__ bool next(int i, GUnit& u) const {
        const long L = (long)i * G + c; int pm, pn;
        if (l == 0) { if (!static_order(NT / 256, 32, G, c, i, pm, pn)) return false; }
        else {
            const int nlat = (NL / 256) * 32;
            if (L < nlat) { static_order(NL / 256, 32, G, c, i, pm, pn); }
            else { const long L2 = L - nlat; if (L2 >= (NC / 256) * 8) return false; pm = NL / 256 + (int)(L2 >> 3); pn = 8 + (int)(L2 & 7); }
        }
        u.pm = pm; u.pn = pn; u.aux = 0; u.A = A + (size_t)pm * 256 * 1024 * 2; u.B = B + (size_t)pn * 256 * 1024 * 2; return true;
    } };
struct EpiG1 { bf16_t* PQKV; bf16_t* PG;
    __device__ __forceinline__ void operator()(const Acc& acc, const GUnit& u, int wr, int wc, int fr, int fq) const {
        if (u.pn < 16) epi_store_bf16(acc, PQKV, PQW, u.pm * 256, u.pn * 256, false, wr, wc, fr, fq);
        else epi_store_bf16(acc, PG, PGW, u.pm * 256, (u.pn - 16) * 256, true, wr, wc, fr, fq);
    } };
__device__ __forceinline__ void fg1(const Ctx& C, int l) {
    const SchedG1 S{(const char*)(C.P.ws + WS_XN), (const char*)(C.P.ws + WS_WIN_T) + (size_t)l * 8192 * 1024 * 2, l, C.nblk, C.blk};
    const EpiG1 E{(bf16_t*)(C.P.ws + WS_PQKV), (bf16_t*)(C.P.ws + WS_PG)};
    gemm_phase<true, false>((LAS unsigned char*)C.lds_f, 1024, 1024, S, E);
}
struct SchedRect { const char* A; const char* B; size_t astep, bstep; int nM, nN, G, c;
    __device__ __forceinline__ bool next(int i, GUnit& u) const {
        int pm, pn; if (!static_order(nM, nN, G, c, i, pm, pn)) return false;
        u.pm = pm; u.pn = pn; u.aux = 0; u.A = A + (size_t)pm * astep; u.B = B + (size_t)pn * bstep; return true;
    } };
struct EpiPlain { bf16_t* O; int ldc;
    __device__ __forceinline__ void operator()(const Acc& acc, const GUnit& u, int wr, int wc, int fr, int fq) const { epi_store_bf16(acc, O, ldc, u.pm * 256, u.pn * 256, false, wr, wc, fr, fq); } };
struct SchedG2 { const char* PQ; const char* Wq; const char* Wk; int G, c;
    __device__ __forceinline__ bool next(int i, GUnit& u) const {
        const int L = i * G + c;
        if (L < (NT / 256) * 3) { u.pm = L / 3; u.pn = L % 3; u.aux = 0; u.A = PQ + (size_t)u.pm * 256 * PQW * 2 + C_CQ * 2; u.B = Wq + (size_t)u.pn * 256 * 512 * 2; return true; }
        const int L2 = L - (NT / 256) * 3; if (L2 >= (NT / 256) * 4) return false;
        u.pm = L2 >> 2; u.pn = L2 & 3; u.aux = 1; u.A = PQ + (size_t)u.pm * 256 * PQW * 2 + C_CKV * 2; u.B = Wk + (size_t)u.pn * 256 * 512 * 2; return true;
    } };
struct EpiG2 { bf16_t* QD; bf16_t* KVD;
    __device__ __forceinline__ void operator()(const Acc& acc, const GUnit& u, int wr, int wc, int fr, int fq) const {
        if (u.aux == 0) epi_store_bf16(acc, QD, 768, u.pm * 256, u.pn * 256, false, wr, wc, fr, fq); else epi_store_bf16(acc, KVD, 1024, u.pm * 256, u.pn * 256, false, wr, wc, fr, fq);
    } };
__device__ __forceinline__ void fg2(const Ctx& C, int l) {
    const SchedG2 S{(const char*)(C.P.ws + WS_PQKV), (const char*)(C.P.ws + WS_WUQ_T) + (size_t)l * 768 * 512 * 2, (const char*)(C.P.ws + WS_WUKV_T) + (size_t)l * 1024 * 512 * 2, C.nblk, C.blk};
    const EpiG2 E{(bf16_t*)(C.P.ws + WS_QD), (bf16_t*)(C.P.ws + WS_KVD)};
    gemm_phase<true, false>((LAS unsigned char*)C.lds_f, 512, PQW, S, E);
}
struct SchedG3 { const char* BR; const char* W; int nM, G, c;
    __device__ __forceinline__ bool next(int i, GUnit& u) const {
        int pm, pn; if (!static_order(nM, 8, G, c, i >> 2, pm, pn)) return false;
        const int n = i & 3; u.pm = pm; u.pn = pn; u.aux = n;
        u.A = BR + (size_t)pm * 256 * BRW * 2 + (size_t)n * 512 * 2; u.B = W + (size_t)n * 1024 * 512 * 2 + (size_t)pn * 128 * 512 * 2; return true;
    } };
struct EpiG3 { const bf16_t* PG; bf16_t* MERGED; f32x4 tot[2][4][2];
    __device__ __forceinline__ void operator()(const Acc& acc, const GUnit& u, int wr, int wc, int fr, int fq) {
        const int n = u.aux;
#pragma unroll
        for (int ai = 0; ai < 2; ++ai)
#pragma unroll
            for (int m = 0; m < 4; ++m) {
                const size_t row = (size_t)(u.pm * 256 + ai * HALF + wr * 64 + m * 16 + fr);
                const int col = u.pn * 128 + wc * 32 + 8 * fq;
                const u32x4 g = *(const u32x4*)(PG + row * PGW + n * 1024 + col);
                float gg[8]; unpack8(g, gg);
                f32x4 v0 = acc[ai][0][m][0], v1 = acc[ai][0][m][1];
                v0 = (f32x4){v0[0] * gg[0], v0[1] * gg[1], v0[2] * gg[2], v0[3] * gg[3]}; v1 = (f32x4){v1[0] * gg[4], v1[1] * gg[5], v1[2] * gg[6], v1[3] * gg[7]};
                if (n > 0) { v0 += tot[ai][m][0]; v1 += tot[ai][m][1]; }
                tot[ai][m][0] = v0; tot[ai][m][1] = v1;
                if (n == 3) *(u32x4*)(MERGED + row * 1024 + col) = pack8(v0, v1);
            }
    } };
__device__ __forceinline__ void fg3(const Ctx& C, int l) {
    const SchedG3 S{(const char*)(C.P.ws + WS_BR), (const char*)(C.P.ws + WS_WBR_T) + (size_t)l * 4 * 1024 * 512 * 2, (l == 0 ? NT : NL) / 256, C.nblk, C.blk};
    EpiG3 E; E.PG = (const bf16_t*)(C.P.ws + WS_PG); E.MERGED = (bf16_t*)(C.P.ws + WS_MERGED);
#pragma unroll
    for (int a = 0; a < 2; ++a)
#pragma unroll
        for (int m = 0; m < 4; ++m) { E.tot[a][m][0] = (f32x4){0.f, 0.f, 0.f, 0.f}; E.tot[a][m][1] = (f32x4){0.f, 0.f, 0.f, 0.f}; }
    gemm_phase_t<true, false, true>((LAS unsigned char*)C.lds_f, 512, BRW, S, E);
}
struct EpiResid { const Ctx& C; int l, mi; bool first;
    __device__ __forceinline__ void operator()(const Acc& acc, const GUnit& u, int wr, int wc, int fr, int fq) const { epi_resid(C, acc, l, mi, first, u.pm * 256, u.pn * 256, wr, wc, fr, fq); } };
__device__ __forceinline__ void fg4(const Ctx& C, int l) {
    const SchedRect S{(const char*)(C.P.ws + WS_MERGED), (const char*)(C.P.ws + WS_WOUT_T) + (size_t)l * 1024 * 1024 * 2, (size_t)256 * 1024 * 2, (size_t)256 * 1024 * 2, (l == 0 ? NT : NL) / 256, 4, C.nblk, C.blk};
    const EpiResid E{C, l, 2, l == 0};
    gemm_phase<false, false>((LAS unsigned char*)C.lds_f, 1024, 1024, S, E);
}
struct EpiSwiglu { bf16_t* O; int ldc;
    __device__ __forceinline__ void operator()(const Acc& acc, const GUnit& u, int wr, int wc, int fr, int fq) const { epi_swiglu(acc, O, ldc, u.pm * 256, u.pn * 128, wr, wc, fr, fq); } };
__device__ __forceinline__ void fg5(const Ctx& C) {
    const SchedRect S{(const char*)(C.P.ws + WS_XN), (const char*)(C.P.ws + WS_FFGU_T), (size_t)256 * 1024 * 2, (size_t)256 * 1024 * 2, NT / 256, 22, C.nblk, C.blk};
    const EpiSwiglu E{(bf16_t*)(C.P.ws + WS_H), DFF};
    gemm_phase<true, false>((LAS unsigned char*)C.lds_f, 1024, 1024, S, E);
}
__device__ __forceinline__ void fg6(const Ctx& C) {
    const SchedRect S{(const char*)(C.P.ws + WS_H), (const char*)(C.P.ws + WS_FFD_T), (size_t)256 * DFF * 2, (size_t)256 * DFF * 2, NT / 256, 4, C.nblk, C.blk};
    const EpiResid E{C, 0, 5, false};
    gemm_phase<false, false>((LAS unsigned char*)C.lds_f, DFF, DFF, S, E);
}
struct SchedG7 { const char* XN; const char* W; const int* ROWMAP; int ps[9]; int nM, G, c;
    __device__ __forceinline__ bool next(int i, GUnit& u) const {
        int pm, pn; if (!static_order(nM, 28, G, c, i, pm, pn)) return false;
        const int e = moe_expert_of(ps, pm * 256);
        u.pm = pm; u.pn = pn; u.aux = e; u.A = XN; u.B = W + (size_t)e * 7168 * 1024 * 2 + (size_t)pn * 256 * 1024 * 2; return true;
    }
    __device__ __forceinline__ unsigned row_off(const GUnit& u, int row) const { int tok = ROWMAP[u.pm * 256 + row]; tok = tok < 0 ? 0 : tok; return (unsigned)tok * 2048u; } };
__device__ __forceinline__ void fg7(const Ctx& C) {
    SchedG7 S; int cnt[8]; moe_starts(C, cnt, S.ps);
    S.XN = (const char*)(C.P.ws + WS_XN); S.W = (const char*)(C.P.ws + WS_W13_T); S.ROWMAP = (const int*)(C.P.ws + WS_ROWMAP); S.nM = S.ps[8] / 256; S.G = C.nblk; S.c = C.blk;
    const EpiSwiglu E{(bf16_t*)(C.P.ws + WS_HM), EFF};
    gemm_phase<true, true>((LAS unsigned char*)C.lds_f, 1024, 1024, S, E);
}
struct SchedG8 { const char* HM; const char* W; int ps[9]; int nM, G, c;
    __device__ __forceinline__ bool next(int i, GUnit& u) const {
        int pm, pn; if (!static_order(nM, 4, G, c, i, pm, pn)) return false;
        const int e = moe_expert_of(ps, pm * 256);
        u.pm = pm; u.pn = pn; u.aux = e; u.A = HM + (size_t)pm * 256 * EFF * 2; u.B = W + (size_t)e * 1024 * EFF * 2 + (size_t)pn * 256 * EFF * 2; return true;
    } };
__device__ __forceinline__ void fg8(const Ctx& C) {
    SchedG8 S; int cnt[8]; moe_starts(C, cnt, S.ps);
    S.HM = (const char*)(C.P.ws + WS_HM); S.W = (const char*)(C.P.ws + WS_W2_T); S.nM = S.ps[8] / 256; S.G = C.nblk; S.c = C.blk;
    const EpiPlain E{(bf16_t*)(C.P.ws + WS_YM), 1024};
    gemm_phase<true, false>((LAS unsigned char*)C.lds_f, EFF, EFF, S, E);
}

#ifndef FAST_G1
#define FAST_G1 1
#endif
#ifndef FAST_G2
#define FAST_G2 1
#endif
#ifndef FAST_G3
#define FAST_G3 1
#endif
#ifndef FAST_G4
#define FAST_G4 1
#endif
#ifndef FAST_G5
#define FAST_G5 1
#endif
#ifndef FAST_G6
#define FAST_G6 1
#endif
#ifndef FAST_G7
#define FAST_G7 1
#endif
#ifndef FAST_G8
#define FAST_G8 1
#endif
#define FAST_ANY_SMALL (FAST_G1 || FAST_G2 || FAST_G3 || FAST_G4 || FAST_G5 || FAST_G6)
#define FAST_ANY_MOE (FAST_G7 || FAST_G8)

typedef float f32x16 __attribute__((ext_vector_type(16)));
typedef short s16x4 __attribute__((ext_vector_type(4)));
constexpr int FA_STG = 28672, FA_VOFF = 12288, FA_WSF = 4 * FA_STG, FA_IDX = FA_WSF + 2048;
__device__ __forceinline__ int crow(int r, int hi) { return (r & 3) + 8 * (r >> 2) + 4 * hi; }
struct FAttn {
    const bf16_t* q; int qpitch; const bf16_t* k1; int k1pitch; const bf16_t* k2; int k2pitch; const bf16_t* v; int vpitch;
    int qrow0, qpos0, krow_lat, t0, nlat, krow_ctx; bool masked, has_sink; float sink2;
    const float* qgain; const float* qgain2; const float* rq; bool lat;
};
__device__ __forceinline__ s16x4 ds_tr(const LAS unsigned char* p) { return __builtin_bit_cast(s16x4, __builtin_amdgcn_ds_read_tr16_b64_v4i16((LAS s16x4*)p)); }
__device__ __forceinline__ float xhalf(float v) { return __shfl_xor(v, 32); }
__device__ __forceinline__ unsigned cvtpk(float lo, float hi) { f32x2_t v = {lo, hi}; bf16x2_t b = __builtin_convertvector(v, bf16x2_t); return __builtin_bit_cast(unsigned, b); }
#define FA_WAITV(n) asm volatile("s_waitcnt vmcnt(" #n ")" ::: "memory")
__device__ __forceinline__ void glds16(const void* gsrc, unsigned lds_dst) { unsigned keep;
    asm volatile("s_mov_b32 %0, m0\n\ts_mov_b32 m0, %2\n\ts_nop 0\n\tglobal_load_lds_dwordx4 %1, off\n\ts_mov_b32 m0, %0" : "=&s"(keep) : "v"(gsrc), "s"(lds_dst) : "memory"); }
__device__ __forceinline__ float max3f(float a, float b, float c) { float r; asm("v_max3_f32 %0, %1, %2, %3" : "=v"(r) : "v"(a), "v"(b), "v"(c)); return r; }
__device__ __forceinline__ float xhalf_max(float v) { auto rr = __builtin_amdgcn_permlane32_swap(__float_as_uint(v), __float_as_uint(v), false, false); return fmaxf(__uint_as_float(rr[0]), __uint_as_float(rr[1])); }
__device__ __forceinline__ float xhalf_sum(float v) { auto rr = __builtin_amdgcn_permlane32_swap(__float_as_uint(v), __float_as_uint(v), false, false); return __uint_as_float(rr[0]) + __uint_as_float(rr[1]); }
template <int DQK, int DV>
__device__ __forceinline__ void fattn_core(LAS unsigned char* lds, const FAttn& a, f32x16 (&o)[DV / 32]) {
    constexpr bool NEGM = (DV == 64 && DQK == 64);
    constexpr bool PIPE = (DV == 64);
    const int tid = threadIdx.x, lane = tid & 63, r32 = lane & 31, hi = lane >> 5; const int wid = __builtin_amdgcn_readfirstlane(tid >> 6);
    LAS float* wsf = (LAS float*)(lds + FA_WSF) + wid * 64;
    const int ntiles = a.nlat + 4;
    auto tile_row = [&](int tt) { return tt < a.nlat ? a.krow_lat + 64 * (a.t0 + tt) : a.krow_ctx + 64 * (tt - a.nlat); };
    const unsigned lds0 = (unsigned)(size_t)lds;
    auto issue = [&](int tt) {
        const size_t krow = (size_t)tile_row(tt); const unsigned sb = lds0 + (unsigned)((tt & 3) * FA_STG);
        glds16(a.k1 + (krow + lane) * a.k1pitch + wid * 8, (unsigned)__builtin_amdgcn_readfirstlane(sb + wid * 1024));
        if constexpr (DQK == 96) { if (wid < 4) glds16(a.k2 + (krow + lane) * a.k2pitch + wid * 8, (unsigned)__builtin_amdgcn_readfirstlane(sb + (8 + wid) * 1024)); }
#pragma unroll
        for (int j = 0; j < DV / 64; ++j) { const int cw = j * 8 + wid;
            glds16(a.v + (krow + 16 * (cw & 3) + (lane >> 2)) * a.vpitch + (cw >> 2) * 32 + (lane & 3) * 8, (unsigned)__builtin_amdgcn_readfirstlane(sb + FA_VOFF + cw * 1024)); }
    };
    auto wait_tiles = [&](int tiles_left) {
        if (tiles_left <= 0) FA_WAITV(0);
        else if constexpr (DQK == 96) { if (tiles_left == 1) { if (wid < 4) FA_WAITV(3); else FA_WAITV(2); } else { if (wid < 4) FA_WAITV(6); else FA_WAITV(4); } }
        else if constexpr (DV == 128) { if (tiles_left == 1) FA_WAITV(3); else FA_WAITV(6); }
        else { if (tiles_left == 1) FA_WAITV(2); else FA_WAITV(4); }
    };
    bf16x8 qr[DQK / 16];
    {
        const int row = a.qrow0 + wid * 32 + r32;
        const bf16_t* qp = a.q + (size_t)row * a.qpitch + hi * 8;
        float v[DQK / 16][8];
#pragma unroll
        for (int d0 = 0; d0 < DQK / 16; ++d0) unpack8(*(const u32x4*)(qp + d0 * 16), v[d0]);
        const int tq = a.qpos0 + wid * 32 + r32; const float prow = (float)(tq >> 6), pcol = (float)(tq & 63);
        if constexpr (DQK == 64) {
            float ss = 0.f;
#pragma unroll
            for (int d0 = 0; d0 < 4; ++d0)
#pragma unroll
                for (int j = 0; j < 8; ++j) ss += v[d0][j] * v[d0][j];
            const float rinv = __builtin_amdgcn_rsqf(xhalf_sum(ss) * (1.f / 64.f) + EPS) * QSCALE64;
#pragma unroll
            for (int d0 = 0; d0 < 4; ++d0) { const f32x4 g0 = *(const f32x4*)(a.qgain + 16 * d0 + 8 * hi), g1 = *(const f32x4*)(a.qgain + 16 * d0 + 8 * hi + 4);
#pragma unroll
                for (int j = 0; j < 4; ++j) { v[d0][j] *= rinv * g0[j]; v[d0][4 + j] *= rinv * g1[j]; } }
            if (a.lat) {
#pragma unroll
                for (int j = 0; j < 8; ++j) { const float f = inv_freq(8 * hi + j, 16); float s0, c0, s1, c1; __sincosf(prow * f, &s0, &c0); __sincosf(pcol * f, &s1, &c1);
                    const float x1 = v[0][j], x2 = v[2][j], y1 = v[1][j], y2 = v[3][j];
                    v[0][j] = x1 * c0 - x2 * s0; v[2][j] = x1 * s0 + x2 * c0; v[1][j] = y1 * c1 - y2 * s1; v[3][j] = y1 * s1 + y2 * c1; }
            }
        } else {
            const float rq = a.rq[row];
            float ssn = 0.f, ssr = 0.f;
#pragma unroll
            for (int d0 = 0; d0 < 6; ++d0)
#pragma unroll
                for (int j = 0; j < 8; ++j) { v[d0][j] *= rq; if (d0 < 4) ssn += v[d0][j] * v[d0][j]; else ssr += v[d0][j] * v[d0][j]; }
            const float rn = __builtin_amdgcn_rsqf(xhalf_sum(ssn) * (1.f / 64.f) + EPS) * QSCALE96, rr = __builtin_amdgcn_rsqf(xhalf_sum(ssr) * (1.f / 32.f) + EPS) * QSCALE96;
#pragma unroll
            for (int d0 = 0; d0 < 6; ++d0) { const float* gp = d0 < 4 ? a.qgain + 16 * d0 + 8 * hi : a.qgain2 + 16 * (d0 - 4) + 8 * hi; const float rs = d0 < 4 ? rn : rr;
                const f32x4 g0 = *(const f32x4*)gp, g1 = *(const f32x4*)(gp + 4);
#pragma unroll
                for (int j = 0; j < 4; ++j) { v[d0][j] *= rs * g0[j]; v[d0][4 + j] *= rs * g1[j]; } }
            if (a.lat) {
#pragma unroll
                for (int j = 0; j < 8; ++j) { const float f = inv_freq(j, 8); float s0, c0; __sincosf((hi == 0 ? prow : pcol) * f, &s0, &c0);
                    const float x1 = v[4][j], x2 = v[5][j]; v[4][j] = x1 * c0 - x2 * s0; v[5][j] = x1 * s0 + x2 * c0; }
            }
        }
#pragma unroll
        for (int d0 = 0; d0 < DQK / 16; ++d0) { u32x4 w; w.x = cvtpk(v[d0][0], v[d0][1]); w.y = cvtpk(v[d0][2], v[d0][3]); w.z = cvtpk(v[d0][4], v[d0][5]); w.w = cvtpk(v[d0][6], v[d0][7]); qr[d0] = __builtin_bit_cast(bf16x8, w); }
    }
    asm volatile("s_waitcnt vmcnt(0)" ::: "memory");
    issue(0); issue(1); issue(2);
    float m = a.has_sink ? a.sink2 : 0.f, l = a.has_sink ? (hi == 0 ? 1.f : 0.f) : 0.f;
    f32x16 negm;
#pragma unroll
    for (int r = 0; r < 16; ++r) negm[r] = NEGM ? -m : 0.f;
#pragma unroll
    for (int d0 = 0; d0 < DV / 32; ++d0)
#pragma unroll
        for (int r = 0; r < 16; ++r) o[d0][r] = 0.f;
    const int qpos = a.qpos0 + wid * 32 + r32;
    auto qk = [&](int tt, f32x16& p0, f32x16& p1) {
        const LAS unsigned char* kb = lds + (tt & 3) * FA_STG + hi * 1024 + r32 * 16;
#pragma unroll
        for (int dd = 0; dd < DQK / 32; ++dd) {
            bf16x8 kf[4];
#pragma unroll
            for (int e = 0; e < 2; ++e) { kf[2 * e] = *(const LAS bf16x8*)(kb + (2 * dd + e) * 2048); kf[2 * e + 1] = *(const LAS bf16x8*)(kb + (2 * dd + e) * 2048 + 512); }
#pragma unroll
            for (int e = 0; e < 2; ++e) { const int d0 = 2 * dd + e;
                p0 = __builtin_amdgcn_mfma_f32_32x32x16_bf16(kf[2 * e], qr[d0], d0 == 0 ? negm : p0, 0, 0, 0); p1 = __builtin_amdgcn_mfma_f32_32x32x16_bf16(kf[2 * e + 1], qr[d0], d0 == 0 ? negm : p1, 0, 0, 0); }
        }
    };
    auto step = [&](int t, f32x16& pc0, f32x16& pc1, f32x16& pn0, f32x16& pn1) {
        wait_tiles(t + 2 < ntiles ? 1 : 0);
        __builtin_amdgcn_s_barrier();
        asm volatile("" ::: "memory");
        if (t + 3 < ntiles) issue(t + 3);
        if constexpr (!PIPE) qk(t, pc0, pc1);
        const LAS unsigned char* vp = lds + (t & 3) * FA_STG + FA_VOFF + ((lane >> 4) & 1) * 32 + (lane & 3) * 8 + (4 * hi + ((lane & 15) >> 2)) * 64;
        s16x4 vlo[4], vhh[4];
#pragma unroll
        for (int ks = 0; ks < 4; ++ks) { vlo[ks] = ds_tr(vp + ks * 1024); vhh[ks] = ds_tr(vp + ks * 1024 + 512); }
        if constexpr (!NEGM) {
#pragma unroll
            for (int r = 0; r < 16; ++r) { pc0[r] -= m; pc1[r] -= m; }
        }
        if (a.masked && t < a.nlat) {
            const int kbase = 64 * (a.t0 + t) + 4 * hi - qpos;
#pragma unroll
            for (int r = 0; r < 16; ++r) { const int d = kbase + (r & 3) + 8 * (r >> 2); if (d > 128 || d < -128) pc0[r] = -1e30f; if (d + 32 > 128 || d + 32 < -128) pc1[r] = -1e30f; }
        }
        float mt = max3f(pc0[0], pc0[1], pc1[0]), mu = max3f(pc0[2], pc0[3], pc1[1]); mt = max3f(mt, pc1[2], pc1[3]);
#pragma unroll
        for (int r = 4; r < 16; r += 4) { mt = max3f(mt, pc0[r], pc0[r + 1]); mu = max3f(mu, pc0[r + 2], pc0[r + 3]); mt = max3f(mt, pc1[r], pc1[r + 1]); mu = max3f(mu, pc1[r + 2], pc1[r + 3]); }
        mt = xhalf_max(fmaxf(mt, mu));
        if (__any(mt > 6.0f)) {
            const float dl = fmaxf(mt, 0.f), alpha = __builtin_amdgcn_exp2f(-dl);
            m += dl; l *= alpha;
#pragma unroll
            for (int r = 0; r < 16; ++r) { pc0[r] -= dl; pc1[r] -= dl; }
            if constexpr (NEGM) {
#pragma unroll
                for (int r = 0; r < 16; ++r) negm[r] = -m;
            }
            if (hi == 0) wsf[r32] = alpha;
#pragma unroll
            for (int r4 = 0; r4 < 4; ++r4) { const f32x4 al = *(const LAS f32x4*)(wsf + 8 * r4 + 4 * hi);
#pragma unroll
                for (int d0 = 0; d0 < DV / 32; ++d0) { o[d0][4 * r4] *= al[0]; o[d0][4 * r4 + 1] *= al[1]; o[d0][4 * r4 + 2] *= al[2]; o[d0][4 * r4 + 3] *= al[3]; } }
        }
        __builtin_amdgcn_s_setprio(1);
        if constexpr (PIPE) qk(t + 1, pn0, pn1);
        float ls = 0.f;
#pragma unroll
        for (int r = 0; r < 16; ++r) { pc0[r] = __builtin_amdgcn_exp2f(pc0[r]); pc1[r] = __builtin_amdgcn_exp2f(pc1[r]); ls += pc0[r] + pc1[r]; }
        l += ls;
        bf16x8 pa[4];
#pragma unroll
        for (int s = 0; s < 2; ++s) {
            u32x4 w0, w1;
            w0.x = cvtpk(pc0[8 * s], pc0[8 * s + 1]); w0.y = cvtpk(pc0[8 * s + 2], pc0[8 * s + 3]); w0.z = cvtpk(pc0[8 * s + 4], pc0[8 * s + 5]); w0.w = cvtpk(pc0[8 * s + 6], pc0[8 * s + 7]);
            w1.x = cvtpk(pc1[8 * s], pc1[8 * s + 1]); w1.y = cvtpk(pc1[8 * s + 2], pc1[8 * s + 3]); w1.z = cvtpk(pc1[8 * s + 4], pc1[8 * s + 5]); w1.w = cvtpk(pc1[8 * s + 6], pc1[8 * s + 7]);
            pa[s] = __builtin_bit_cast(bf16x8, w0); pa[2 + s] = __builtin_bit_cast(bf16x8, w1);
        }
#pragma unroll
        for (int d0 = 0; d0 < DV / 32; ++d0) {
#pragma unroll
            for (int ks = 0; ks < 4; ++ks) { const bf16x8 vf = (bf16x8){vlo[ks][0], vlo[ks][1], vlo[ks][2], vlo[ks][3], vhh[ks][0], vhh[ks][1], vhh[ks][2], vhh[ks][3]};
                o[d0] = __builtin_amdgcn_mfma_f32_32x32x16_bf16(pa[ks], vf, o[d0], 0, 0, 0); }
            if (d0 + 1 < DV / 32) {
#pragma unroll
                for (int ks = 0; ks < 4; ++ks) { vlo[ks] = ds_tr(vp + (d0 + 1) * 4096 + ks * 1024); vhh[ks] = ds_tr(vp + (d0 + 1) * 4096 + ks * 1024 + 512); }
            }
        }
        __builtin_amdgcn_s_setprio(0);
        if constexpr (PIPE) {
#pragma unroll
            for (int i = 0; i < DQK / 8; ++i) { __builtin_amdgcn_sched_group_barrier(0x008, 1, 0); __builtin_amdgcn_sched_group_barrier(0x002, 80 / (DQK / 8), 0); }
        }
    };
    f32x16 pA0, pA1, pB0, pB1;
    wait_tiles(2); __builtin_amdgcn_s_barrier(); asm volatile("" ::: "memory");
    if constexpr (PIPE) { qk(0, pA0, pA1); for (int t = 0; t < ntiles; t += 2) { step(t, pA0, pA1, pB0, pB1); step(t + 1, pB0, pB1, pA0, pA1); } }
    else { for (int t = 0; t < ntiles; ++t) step(t, pA0, pA1, pA0, pA1); }
    l = xhalf_sum(l);
    if (hi == 0) wsf[r32] = l > 0.f ? 1.f / l : 0.f;
#pragma unroll
    for (int r4 = 0; r4 < 4; ++r4) { const f32x4 il = *(const LAS f32x4*)(wsf + 8 * r4 + 4 * hi);
#pragma unroll
        for (int d0 = 0; d0 < DV / 32; ++d0) { o[d0][4 * r4] *= il[0]; o[d0][4 * r4 + 1] *= il[1]; o[d0][4 * r4 + 2] *= il[2]; o[d0][4 * r4 + 3] *= il[3]; } }
    __syncthreads();
}
template <int NB>
__device__ __forceinline__ void fattn_store(bf16_t* dst  , int row0, const f32x16 (&o)[NB], int lane) {
    const int r32 = lane & 31, hi = lane >> 5;
#pragma unroll
    for (int d0 = 0; d0 < NB; ++d0)
#pragma unroll
        for (int r = 0; r < 16; ++r) dst[(size_t)(row0 + crow(r, hi)) * BRW + 32 * d0 + r32] = (bf16_t)f2bf(o[d0][r]);
}
__device__ __forceinline__ void fattn_phase(const Ctx& C, int l, int rep = 0) {
    LAS unsigned char* lds = (LAS unsigned char*)C.lds_f;
    const int n_lat = 1792, total = n_lat + (l == 0 ? NBATCH * 28 : 0);
    int* counter = (int*)(C.P.ws + WS_CNT) + 24 + l + 2 * rep;
    const float lam = __hip_atomic_load(&((float*)(C.P.ws + WS_CNT + 128))[l], __ATOMIC_RELAXED, __HIP_MEMORY_SCOPE_AGENT);
    const float lam_init = 0.8f - 0.6f * expf(-0.3f * (float)l);
    const int wid = __builtin_amdgcn_readfirstlane(C.tid >> 6);
    for (;;) {
        unsigned char* wsb = C.P.ws; asm volatile("" : "+s"(wsb));
        bf16_t* PQKV = (bf16_t*)(wsb + WS_PQKV); bf16_t* BR = (bf16_t*)(wsb + WS_BR); bf16_t* QD = (bf16_t*)(wsb + WS_QD); bf16_t* KVD = (bf16_t*)(wsb + WS_KVD);
        if (C.tid == 0) *(LAS int*)(lds + FA_IDX) = atomicAdd(counter, 1);
        __syncthreads();
        const int idx = __builtin_amdgcn_readfirstlane(*(LAS int*)(lds + FA_IDX));
        __syncthreads();
        if (idx >= total) break;
        int mixer, b, h, qb; bool isctx = false;
        if (idx < 256) { mixer = 2; b = idx >> 5; h = (idx >> 3) & 3; qb = idx & 7; }
        else if (idx < n_lat) { const int j = (idx - 256) & 511; mixer = idx < 768 ? 3 : (idx < 1280 ? 1 : 0); b = j >> 6; h = (j >> 3) & 7; qb = j & 7; }
        else { const int j = idx - n_lat, hitem = j % 28; b = j / 28; qb = 0; isctx = true; mixer = hitem < 8 ? 0 : (hitem < 16 ? 1 : (hitem < 20 ? 2 : 3)); h = hitem < 16 ? (hitem & 7) : (hitem < 20 ? hitem - 16 : hitem - 20); }
        FAttn a;
        a.qrow0 = isctx ? NL + b * CTXL : b * SEQ + qb * 256; a.qpos0 = qb * 256;
        a.krow_lat = b * SEQ; a.t0 = 0; a.nlat = isctx ? 0 : 32; a.krow_ctx = NL + b * CTXL; a.masked = false; a.has_sink = false; a.sink2 = 0.f;
        a.k2 = nullptr; a.k2pitch = 0; a.qgain2 = nullptr; a.rq = nullptr; a.lat = !isctx;
        a.qgain = (mixer == 0 ? C.P.in[9] : (mixer == 1 ? C.P.in[12] : (mixer == 2 ? C.P.in[14] : C.P.in[25]))) + l * 64;
        const int row0 = a.qrow0 + wid * 32;
        if (mixer <= 1) {
            const bool isA = mixer == 0; const int kvh = h >> 2;
            a.q = PQKV + (isA ? C_QA : C_QB) + h * 64; a.qpitch = PQW; a.k1 = PQKV + (isA ? C_KA : C_KB) + kvh * 64; a.k1pitch = PQW; a.v = PQKV + (isA ? C_VA : C_VB) + kvh * 64; a.vpitch = PQW;
            if (isA) { a.has_sink = true; a.sink2 = (C.P.in[11])[l * 8 + h] * LOG2E;
                if (!isctx) { a.masked = true; const int ta = 4 * qb - 2, tb = 4 * qb + 6; a.t0 = ta < 0 ? 0 : ta; a.nlat = (tb > 32 ? 32 : tb) - a.t0; } }
            f32x16 o[2]; fattn_core<64, 64>(lds, a, o);
            fattn_store<2>(BR + (isA ? 0 : 512) + h * 64, row0, o, C.lane);
        } else if (mixer == 2) {
            const int hc = h; float* OC1 = (float*)(wsb + WS_OC1);
            a.v = PQKV + C_VC + hc * 128; a.vpitch = PQW; a.qpitch = PQW; a.k1pitch = PQW;
            const int r32 = C.lane & 31, hi = C.lane >> 5;
            f32x16 o[4];
            a.q = PQKV + C_QC + (2 * hc) * 64; a.k1 = PQKV + C_KC + (2 * hc) * 64;
            fattn_core<64, 128>(lds, a, o);
#pragma unroll
            for (int d0 = 0; d0 < 4; ++d0)
#pragma unroll
                for (int r = 0; r < 16; ++r) OC1[((size_t)(row0 + crow(r, hi)) * 4 + hc) * 128 + 32 * d0 + r32] = o[d0][r];
            a.q = PQKV + C_QC + (2 * hc + 1) * 64; a.k1 = PQKV + C_KC + (2 * hc + 1) * 64;
            fattn_core<64, 128>(lds, a, o);
            float ss[16];
#pragma unroll
            for (int r = 0; r < 16; ++r) ss[r] = 0.f;
#pragma unroll
            for (int d0 = 0; d0 < 4; ++d0)
#pragma unroll
                for (int r = 0; r < 16; ++r) { const float o1 = OC1[((size_t)(row0 + crow(r, hi)) * 4 + hc) * 128 + 32 * d0 + r32]; const float dl = o1 - lam * o[d0][r]; o[d0][r] = dl; ss[r] += dl * dl; }
#pragma unroll
            for (int r = 0; r < 16; ++r) {
#pragma unroll
                for (int sft = 1; sft < 32; sft <<= 1) ss[r] += __shfl_xor(ss[r], sft);
                ss[r] = (1.0f / sqrtf(ss[r] * (1.f / 128.f) + EPS)) * (1.f - lam_init);
            }
            const float* gn = (C.P.in[20]) + l * 128;
#pragma unroll
            for (int d0 = 0; d0 < 4; ++d0) { const float g = gn[32 * d0 + r32];
#pragma unroll
                for (int r = 0; r < 16; ++r) o[d0][r] *= ss[r] * g; }
            fattn_store<4>(BR + 1024 + hc * 128, row0, o, C.lane);
        } else {
            a.qgain2 = C.P.in[27] + l * 32; a.rq = (const float*)(wsb + WS_RQ);
            a.q = QD + h * 96; a.qpitch = 768; a.k1 = KVD + h * 128; a.k1pitch = 1024; a.k2 = PQKV + C_KR; a.k2pitch = PQW; a.v = KVD + h * 128 + 64; a.vpitch = 1024;
            f32x16 o[2]; fattn_core<96, 64>(lds, a, o);
            fattn_store<2>(BR + 1536 + h * 64, row0, o, C.lane);
        }
    }
}
#ifndef FAST_ATTN
#define FAST_ATTN 1
#endif

#define XB_TMO      128
#define XB_XCNT(j)  (256  + 64 * (j))
#define XB_XSUB(j)  (1280 + 64 * (j))
#define XB_XGEN(j)  (2304 + 64 * (j))
#define XB_TOP      3328
#define XB_TOPGEN   3392
#define XCD_BAR_WORDS 3456
#define XB_SPIN_CAP (1u << 22)
constexpr size_t WS_BAR = 2 * MiB;
constexpr int LDS_ST_OFF = LDS_BYTES - 64;
__device__ __forceinline__ unsigned xb_ld(unsigned* p)              { return __hip_atomic_load(p, __ATOMIC_RELAXED, __HIP_MEMORY_SCOPE_AGENT); }
__device__ __forceinline__ unsigned xb_add(unsigned* p, unsigned v) { return __hip_atomic_fetch_add(p, v, __ATOMIC_RELAXED, __HIP_MEMORY_SCOPE_AGENT); }
__device__ __forceinline__ unsigned xb_xcc_id() { return (unsigned)__builtin_amdgcn_s_getreg((3 << 11) | 20) & 0xFu; }
#define XB_SPIN(cond, bar) do { unsigned _sp = 0; while (cond) { __builtin_amdgcn_s_sleep(1); \
    if ((++_sp & 255u) == 0u) { if (xb_ld(&(bar)[XB_TMO])) break; if (_sp > XB_SPIN_CAP) { atomicAdd(&(bar)[XB_TMO], 1u); break; } } } } while (0)
struct XcdBarrier { unsigned* bar; unsigned x; volatile LAS unsigned* st; };
__device__ __forceinline__ XcdBarrier xcd_barrier_post(unsigned* bar, volatile LAS unsigned* st) {
    XcdBarrier b; b.bar = bar; b.x = xb_xcc_id(); b.st = st;
    if (threadIdx.x == 0) (void)xb_add(&bar[XB_XCNT(b.x)], 1u);
    return b;
}
__device__ __forceinline__ void xcd_barrier_complete(unsigned* bar, unsigned x, unsigned& nloc, unsigned& nx) {
    const unsigned G = gridDim.x * gridDim.y * gridDim.z;
    unsigned sum, cnt, mine, sp = 0u;
    for (;;) {
        sum = 0u; cnt = 0u; mine = 0u;
#pragma unroll
        for (unsigned j = 0; j < 16; ++j) { const unsigned c = xb_ld(&bar[XB_XCNT(j)]); sum += c; cnt += (c > 0u) ? 1u : 0u; mine = (j == x) ? c : mine; }
        if (sum == G) break;
        __builtin_amdgcn_s_sleep(1);
        if ((++sp & 255u) == 0u) { if (xb_ld(&bar[XB_TMO])) break; if (sp > XB_SPIN_CAP) { atomicAdd(&bar[XB_TMO], 1u); break; } }
    }
    nloc = mine > 0u ? mine : 1u; nx = cnt > 0u ? cnt : 1u;
}
__device__ __forceinline__ void xcd_barrier(const XcdBarrier& b) {
    asm volatile("s_waitcnt vmcnt(0)" ::: "memory");
    __syncthreads();
    if (threadIdx.x == 0) {
        unsigned* bar = b.bar;
        __builtin_amdgcn_s_waitcnt(0);
        unsigned nloc = b.st[0], nx = b.st[1];
        if (nloc == 0u) { xcd_barrier_complete(bar, b.x, nloc, nx); b.st[0] = nloc; b.st[1] = nx; }
        const unsigned old = xb_add(&bar[XB_XSUB(b.x)], 1u);
        const unsigned gen = old / nloc;
        if (old + 1u == (gen + 1u) * nloc) {
            __builtin_amdgcn_fence(__ATOMIC_RELEASE, "agent");
            asm volatile("s_waitcnt vmcnt(0)" ::: "memory");
            const unsigned og = xb_add(&bar[XB_TOP], 1u);
            const unsigned tg = og / nx;
            if (og + 1u == (tg + 1u) * nx) xb_add(&bar[XB_TOPGEN], 1u);
            else XB_SPIN(xb_ld(&bar[XB_TOPGEN]) == tg, bar);
            __builtin_amdgcn_fence(__ATOMIC_ACQUIRE, "agent");
            xb_add(&bar[XB_XGEN(b.x)], 1u);
            asm volatile("s_waitcnt vmcnt(0)" ::: "memory");
        } else {
            XB_SPIN(xb_ld(&bar[XB_XGEN(b.x)]) == gen, bar);
            __builtin_amdgcn_fence(__ATOMIC_ACQUIRE, "agent");
            asm volatile("s_waitcnt vmcnt(0)" ::: "memory");
        }
    }
    __syncthreads();
}

constexpr int N_PHASES = 23;
__global__ void __launch_bounds__(NTHREADS) mk_fwd(Params p) {
    extern __shared__ __attribute__((aligned(16))) unsigned char lds[];
    cg::grid_group grid = cg::this_grid();
#define MKCTX int tid_l_ = (int)threadIdx.x; asm volatile("" : "+v"(tid_l_)); const Ctx C{p, (float*)lds, tid_l_, tid_l_ & 63, tid_l_ >> 6, (int)gridDim.x, (int)blockIdx.x}
    const int lo = p.ph_lo, hi = p.ph_hi;
    if (threadIdx.x < 2) ((volatile LAS unsigned*)((LAS unsigned char*)lds + LDS_ST_OFF))[threadIdx.x] = 0u;
    __syncthreads();
    XcdBarrier xbar; xbar.bar = (unsigned*)(p.ws + WS_BAR); xbar.x = 0; xbar.st = (volatile LAS unsigned*)((LAS unsigned char*)lds + LDS_ST_OFF);
#define SEAM(k) do { if ((k) == 0) { grid.sync(); xbar = xcd_barrier_post((unsigned*)(p.ws + WS_BAR), (volatile LAS unsigned*)((LAS unsigned char*)lds + LDS_ST_OFF)); } else xcd_barrier(xbar); } while (0)
#ifndef REPEAT_MASK
#define REPEAT_MASK 0u
#endif
int rep = 0;
#define PHASE(k, call) if (lo <= (k) && (k) < hi) { MKCTX; rep = 0; call; if ((REPEAT_MASK >> (k)) & 1u) { SEAM(k); rep = 1; call; } if ((k) + 1 < hi) SEAM(k); }
#define PHASEAB(k, callA, callB) if (lo <= (k) && (k) < hi) { MKCTX; callA; callB; if ((REPEAT_MASK >> (k)) & 1u) { SEAM(k); callB; } if ((k) + 1 < hi) SEAM(k); }
    PHASEAB(0, ph_prologue(C), (FAST_ANY_SMALL ? conv_weights<false>(C) : (void)0))
    PHASE(1, ph_adaln(C, 0, 0))
    PHASE(2, (FAST_G1 ? fg1(C, 0) : ph_g1(C, 0)))
    PHASE(3, (FAST_G2 ? fg2(C, 0) : ph_g2(C, 0)))
    PHASE(4, ph_post(C, 0, rep))
    PHASE(5, (FAST_ATTN ? fattn_phase(C, 0, rep) : ph_attn(C, 0)))
    PHASE(6, (FAST_G3 ? fg3(C, 0) : ph_g3(C, 0)))
    PHASE(7, (FAST_G4 ? fg4(C, 0) : ph_g4(C, 0)))
    PHASE(8, ph_adaln(C, 0, 1))
    PHASE(9, (FAST_G5 ? fg5(C) : ph_g5(C)))
    PHASE(10, (FAST_G6 ? fg6(C) : ph_g6(C)))
    PHASE(11, ph_adaln(C, 1, 0))
    PHASE(12, (FAST_G1 ? fg1(C, 1) : ph_g1(C, 1)))
    PHASE(13, (FAST_G2 ? fg2(C, 1) : ph_g2(C, 1)))
    PHASE(14, ph_post(C, 1, rep))
    PHASE(15, (FAST_ATTN ? fattn_phase(C, 1, rep) : ph_attn(C, 1)))
    PHASE(16, (FAST_G3 ? fg3(C, 1) : ph_g3(C, 1)))
    PHASE(17, (FAST_G4 ? fg4(C, 1) : ph_g4(C, 1)))
    PHASEAB(18, ph_adaln(C, 1, 1), (FAST_ANY_MOE ? conv_weights<true>(C) : (void)0))
    PHASE(19, ph_assign(C))
    PHASE(20, (FAST_G7 ? fg7(C) : ph_g7(C)))
    PHASE(21, (FAST_G8 ? fg8(C) : ph_g8(C)))
    PHASE(22, ph_combine(C))
#ifdef EXTRA_SYNCS
    for (int i = 0; i < EXTRA_SYNCS; ++i) xcd_barrier(xbar);
#endif
#ifdef REPEAT_PRO
    grid.sync(); if (blockIdx.x < 0) ph_prologue(C);
#endif
#undef PHASE
#undef PHASEAB
#undef SEAM
}

extern "C" void kernel_launch(void* const* d_in, const int* in_sizes, int n_in, void* d_out, int out_size, void* d_ws, size_t ws_size, hipStream_t stream) {
    static int grid_blocks = 0;
    if (grid_blocks == 0) {
        if (n_in != 38 || ws_size < WS_NEED) { fprintf(stderr, "kernel_launch: unexpected n_in %d / ws_size %zu\n", n_in, ws_size); grid_blocks = -1; return; }
        int dev = 0, cus = 0, per_cu = 0;
        hipGetDevice(&dev);
        hipDeviceGetAttribute(&cus, hipDeviceAttributeMultiprocessorCount, dev);
        hipFuncSetAttribute((const void*)mk_fwd, hipFuncAttributeMaxDynamicSharedMemorySize, LDS_BYTES);
        hipOccupancyMaxActiveBlocksPerMultiprocessor(&per_cu, (const void*)mk_fwd, NTHREADS, LDS_BYTES);
        if (per_cu < 1) per_cu = 1;
        grid_blocks = cus * per_cu;
        (void)hipGetLastError();
    }
    if (grid_blocks < 0) return;
    Params p{};
    for (int i = 0; i < 38; ++i) p.in[i] = (const float*)d_in[i];
    p.out = (float*)d_out; p.ws = (unsigned char*)d_ws; p.ph_lo = 0; p.ph_hi = N_PHASES;
    void* args[] = {&p};
    hipError_t e = hipLaunchCooperativeKernel((const void*)mk_fwd, dim3(grid_blocks), dim3(NTHREADS), args, LDS_BYTES, stream);
    if (e != hipSuccess) fprintf(stderr, "cooperative launch failed: %s (grid %d)\n", hipGetErrorString(e), grid_blocks);
}
```

```cpp
#include <hip/hip_runtime.h>
#include <hip/hip_cooperative_groups.h>
#include <cstdio>
#include <cstdint>
namespace cg = cooperative_groups;

typedef unsigned short bf16_t;
typedef float f32x4 __attribute__((ext_vector_type(4)));
typedef unsigned u32x4 __attribute__((ext_vector_type(4)));
typedef unsigned u32x2 __attribute__((ext_vector_type(2)));

constexpr int DM = 1024, NBATCH = 8, SEQ = 2048, CTXL = 256;
constexpr int NL = NBATCH * SEQ, NC = NBATCH * CTXL, NT = NL + NC;
constexpr int IN_COLS = 7968;
constexpr int C_QA = 0, C_QB = 512, C_QC = 1024, C_CQ = 1536, C_KA = 2048, C_VA = 2176, C_KB = 2304, C_VB = 2432, C_KC = 2560, C_VC = 3072, C_CKV = 3584, C_KR = 3840;
constexpr int PQW = 4096, PGW = 4096, BRW = 2048;
constexpr int DFF = 2816, EFF = 3584, NEXP = 8;
constexpr int MOE_ROWS = 34816;
constexpr float EPS = 1e-6f;
constexpr float LOG2E = 1.4426950408889634f;
constexpr float QSCALE64 = 0.125f * LOG2E, QSCALE96 = 0.10206207261596577f * LOG2E;
constexpr int NTHREADS = 512;
constexpr int LDS_BYTES = 147456;

constexpr size_t MiB = 1u << 20;
constexpr size_t WS_MOD = 0;
constexpr size_t WS_CNT = 512 * 1024;
constexpr size_t WS_ROUTE_E = 1 * MiB;
constexpr size_t WS_ROUTE_W = WS_ROUTE_E + 64 * 1024;
constexpr size_t WS_POS = WS_ROUTE_W + 128 * 1024;
constexpr size_t WS_ROWMAP = WS_POS + 128 * 1024;
constexpr size_t WS_RQ = 1536 * 1024;
constexpr size_t WS_XN = 4 * MiB;
constexpr size_t WS_BR = 4 * MiB;
constexpr size_t WS_WSMALL = 76 * MiB;
constexpr size_t WS_CX = 140 * MiB;
constexpr size_t WS_PQKV = 148 * MiB;
constexpr size_t WS_MERGED = 148 * MiB;
constexpr size_t WS_PG = 292 * MiB;
constexpr size_t WS_H = 292 * MiB;
constexpr size_t WS_QD = 436 * MiB;
constexpr size_t WS_KVD = 463 * MiB;
constexpr size_t WS_OC1 = 499 * MiB;
constexpr size_t WS_HM = 208 * MiB;
constexpr size_t WS_YM = 446 * MiB;
constexpr size_t WS_NEED = 535 * MiB;

__device__ __forceinline__ float bf2f(unsigned h) { return __uint_as_float(h << 16); }
__device__ __forceinline__ unsigned f2bf(float f) { unsigned u = __float_as_uint(f); return (u + 0x7fffu + ((u >> 16) & 1u)) >> 16; }
typedef float f32x2_t __attribute__((ext_vector_type(2))); typedef __bf16 bf16x2_t __attribute__((ext_vector_type(2)));
__device__ __forceinline__ unsigned pk2(float lo, float hi) { f32x2_t v = {lo, hi}; bf16x2_t b = __builtin_convertvector(v, bf16x2_t); return __builtin_bit_cast(unsigned, b); }
__device__ __forceinline__ float wave_sum(float v) {
#pragma unroll
    for (int o = 1; o < 64; o <<= 1) v += __shfl_xor(v, o);
    return v;
}
__device__ __forceinline__ float sigmoidf_(float x) { return 1.f / (1.f + __expf(-x)); }
__device__ __forceinline__ float siluf_(float x) { return x / (1.f + __expf(-x)); }
__device__ __forceinline__ void unpack8(u32x4 raw, float* dst) {
    dst[0] = bf2f(raw.x & 0xffffu); dst[1] = bf2f(raw.x >> 16); dst[2] = bf2f(raw.y & 0xffffu); dst[3] = bf2f(raw.y >> 16);
    dst[4] = bf2f(raw.z & 0xffffu); dst[5] = bf2f(raw.z >> 16); dst[6] = bf2f(raw.w & 0xffffu); dst[7] = bf2f(raw.w >> 16);
}

struct Params { const float* in[38]; float* out; unsigned char* ws; int ph_lo, ph_hi; };

struct Ctx { const Params& P; float* lds_f; int tid, lane, wave, nblk, blk; };

__device__ __forceinline__ void ph_prologue(const Ctx& C) {
    if (C.blk == 0 && C.tid < 32) ((int*)(C.P.ws + WS_CNT))[C.tid] = 0;
    if (C.blk == 0) for (int i = C.tid; i < 3456; i += NTHREADS) ((unsigned*)(C.P.ws + (2u << 20)))[i] = 0u;
    if (C.blk == 0 && C.wave == 1) {
        for (int l = 0; l < 2; ++l) {
            const float a = wave_sum((C.P.in[16])[l * 64 + C.lane] * (C.P.in[17])[l * 64 + C.lane]);
            const float b = wave_sum((C.P.in[18])[l * 64 + C.lane] * (C.P.in[19])[l * 64 + C.lane]);
            const float lam_init = 0.8f - 0.6f * expf(-0.3f * (float)l);
            if (C.lane == 0) ((float*)(C.P.ws + WS_CNT + 128))[l] = expf(a) - expf(b) + lam_init;
        }
    }
    float* sc = C.lds_f;
    float* red = C.lds_f + 9 * 1024;
    for (int i = C.tid; i < 9 * 1024; i += NTHREADS) { const int row = i >> 10, k = i & 1023; const float v = row < 8 ? (C.P.in[1])[row * 1024 + k] : (C.P.in[3])[k]; sc[i] = v / (1.f + expf(-v)); }
    __syncthreads();
    for (int item = C.blk; item < 384; item += C.nblk) {
        const int l = item / 192, cgp = item % 192, cl32 = C.lane & 31, kpar = C.lane >> 5;
        const float* w = (C.P.in[4]) + (size_t)l * 1024 * 6144 + cgp * 32 + cl32;
        float acc[9];
#pragma unroll
        for (int r = 0; r < 9; ++r) acc[r] = 0.f;
#pragma unroll 16
        for (int i = 0; i < 64; ++i) {
            const int k = C.wave * 128 + 2 * i + kpar; const float wv = w[(size_t)k * 6144];
#pragma unroll
            for (int r = 0; r < 9; ++r) acc[r] += sc[r * 1024 + k] * wv;
        }
#pragma unroll
        for (int r = 0; r < 9; ++r) { acc[r] += __shfl_xor(acc[r], 32); if (kpar == 0) red[(C.wave * 9 + r) * 32 + cl32] = acc[r]; }
        __syncthreads();
        for (int i = C.tid; i < 9 * 32; i += NTHREADS) {
            const int r = i >> 5, cl = i & 31; float sm = 0.f;
#pragma unroll
            for (int w8 = 0; w8 < 8; ++w8) sm += red[(w8 * 9 + r) * 32 + cl];
            ((float*)(C.P.ws + WS_MOD))[(size_t)(l * 9 + r) * 6144 + cgp * 32 + cl] = sm + (C.P.in[5])[l * 6144 + cgp * 32 + cl];
        }
        __syncthreads();
    }
}

__device__ __forceinline__ void ph_adaln(const Ctx& C, int l, int which) {
    const float* g = (which == 0 ? (C.P.in[6]) : (C.P.in[7])) + l * 1024;
    const bool router = (l == 1 && which == 1);
    const int nrows = router ? NL : NT;
    const int gw = C.blk * 8 + C.wave, NGW = C.nblk * 8;
    auto load_row = [&](int r, f32x4 (&v)[4]) {
        const float* src;
        if (l == 0 && which == 0) src = r < NL ? (C.P.in[0]) + (size_t)r * 1024 : (C.P.in[2]) + (size_t)(r - NL) * 1024;
        else src = r < NL ? (C.P.out) + (size_t)r * 1024 : ((float*)(C.P.ws + WS_CX)) + (size_t)(r - NL) * 1024;
#pragma unroll
        for (int j = 0; j < 4; ++j) v[j] = ((const f32x4*)src)[C.lane + 64 * j];
    };
    auto finish_row = [&](int r, const f32x4 (&v)[4]) {
        const int mrow = r < NL ? (r >> 11) : 8;
        const float* mod = ((float*)(C.P.ws + WS_MOD)) + (size_t)(l * 9 + mrow) * 6144;
        const float* shift = mod + (which ? 3 : 0) * 1024; const float* scale = mod + (which ? 4 : 1) * 1024;
        float ss = 0.f;
#pragma unroll
        for (int j = 0; j < 4; ++j) ss += (v[j].x * v[j].x + v[j].y * v[j].y) + (v[j].z * v[j].z + v[j].w * v[j].w);
        ss = wave_sum(ss);
        const float rinv = __builtin_amdgcn_rsqf(ss * (1.f / 1024.f) + EPS);
        float y[16];
#pragma unroll
        for (int j = 0; j < 4; ++j) {
            const f32x4 gg = ((const f32x4*)g)[C.lane + 64 * j], sh = ((const f32x4*)shift)[C.lane + 64 * j], sl = ((const f32x4*)scale)[C.lane + 64 * j];
            y[4 * j + 0] = v[j].x * rinv * gg.x * (1.f + sl.x) + sh.x; y[4 * j + 1] = v[j].y * rinv * gg.y * (1.f + sl.y) + sh.y;
            y[4 * j + 2] = v[j].z * rinv * gg.z * (1.f + sl.z) + sh.z; y[4 * j + 3] = v[j].w * rinv * gg.w * (1.f + sl.w) + sh.w;
            u32x2 o; o.x = pk2(y[4 * j + 0], y[4 * j + 1]); o.y = pk2(y[4 * j + 2], y[4 * j + 3]);
            ((u32x2*)(((bf16_t*)(C.P.ws + WS_XN)) + (size_t)r * 1024))[C.lane + 64 * j] = o;
        }
        if (router) {
            float lg[8];
#pragma unroll
            for (int e = 0; e < 8; ++e) lg[e] = 0.f;
#pragma unroll
            for (int j = 0; j < 4; ++j)
#pragma unroll
                for (int q = 0; q < 4; ++q) {
                    const int k = 4 * C.lane + 256 * j + q;
                    const f32x4 w0 = ((const f32x4*)((C.P.in[34]) + (size_t)k * 8))[0], w1 = ((const f32x4*)((C.P.in[34]) + (size_t)k * 8))[1];
                    const float yy = y[4 * j + q];
                    lg[0] += yy * w0.x; lg[1] += yy * w0.y; lg[2] += yy * w0.z; lg[3] += yy * w0.w; lg[4] += yy * w1.x; lg[5] += yy * w1.y; lg[6] += yy * w1.z; lg[7] += yy * w1.w;
                }
#pragma unroll
            for (int e = 0; e < 8; ++e) lg[e] = wave_sum(lg[e]);
            float b0 = lg[0]; int i0 = 0;
#pragma unroll
            for (int e = 1; e < 8; ++e) if (lg[e] > b0) { b0 = lg[e]; i0 = e; }
            float b1 = -3.0e38f; int i1 = 0;
#pragma unroll
            for (int e = 0; e < 8; ++e) if (e != i0 && lg[e] > b1) { b1 = lg[e]; i1 = e; }
            if (C.lane == 0) {
                const float w0 = 1.f / (1.f + expf(b1 - b0));
                ((int*)(C.P.ws + WS_ROUTE_E))[r] = i0 | (i1 << 8); ((float*)(C.P.ws + WS_ROUTE_W))[2 * r] = w0; ((float*)(C.P.ws + WS_ROUTE_W))[2 * r + 1] = 1.f - w0;
                atomicAdd(&((int*)(C.P.ws + WS_CNT))[i0], 1); atomicAdd(&((int*)(C.P.ws + WS_CNT))[i1], 1);
            }
        }
    };
    if (router) {
        for (int r = gw; r < nrows; r += 2 * NGW) {
            const int r2 = r + NGW; const bool h2 = r2 < nrows;
            f32x4 va[4], vb[4];
            load_row(r, va);
            if (h2) load_row(r2, vb);
            finish_row(r, va);
            if (h2) finish_row(r2, vb);
        }
    } else
    for (int r = gw; r < nrows; r += 4 * NGW) {
        const int r2 = r + NGW, r3 = r + 2 * NGW, r4 = r + 3 * NGW; const bool h2 = r2 < nrows, h3 = r3 < nrows, h4 = r4 < nrows;
        f32x4 va[4], vb[4], vc[4], vd[4];
        load_row(r, va);
        if (h2) load_row(r2, vb);
        if (h3) load_row(r3, vc);
        if (h4) load_row(r4, vd);
        finish_row(r, va);
        if (h2) finish_row(r2, vb);
        if (h3) finish_row(r3, vc);
        if (h4) finish_row(r4, vd);
    }
}

template <class AF, class BF>
__device__ __forceinline__ void ngemm_tile(float* lds_f, int tid, int K, AF af, BF bf, float (&acc)[4][4]) {
    float* As = lds_f;
    float* Bs = lds_f + 128 * 33;
    const int ty = tid >> 4, tx = tid & 15;
#pragma unroll
    for (int i = 0; i < 4; ++i)
#pragma unroll
        for (int j = 0; j < 4; ++j) acc[i][j] = 0.f;
    for (int k0 = 0; k0 < K; k0 += 32) {
        {
            const int i = tid >> 2, kq = (tid & 3) * 8; const bf16_t* ap = af(i, k0 + kq); float t[8];
            if (ap) unpack8(*(const u32x4*)ap, t); else {
#pragma unroll
                for (int q = 0; q < 8; ++q) t[q] = 0.f; }
#pragma unroll
            for (int q = 0; q < 8; ++q) As[i * 33 + kq + q] = t[q];
        }
        {
            const int k = tid >> 4, j = (tid & 15) * 4;
#pragma unroll
            for (int q = 0; q < 4; ++q) Bs[k * 64 + j + q] = bf(k0 + k, j + q);
        }
        __syncthreads();
#pragma unroll 8
        for (int kk = 0; kk < 32; ++kk) {
            float a[4];
#pragma unroll
            for (int i = 0; i < 4; ++i) a[i] = As[(ty * 4 + i) * 33 + kk];
            const f32x4 b = *(const f32x4*)&Bs[kk * 64 + tx * 4];
#pragma unroll
            for (int i = 0; i < 4; ++i) { acc[i][0] += a[i] * b.x; acc[i][1] += a[i] * b.y; acc[i][2] += a[i] * b.z; acc[i][3] += a[i] * b.w; }
        }
        __syncthreads();
    }
}
#define NG_EPI(acc, ...) do { const int ty_ = C.tid >> 4, tx_ = C.tid & 15; auto ef_ = __VA_ARGS__; _Pragma("unroll") for (int i_ = 0; i_ < 4; ++i_) ef_(ty_ * 4 + i_, tx_ * 4, acc[i_]); } while (0)

__device__ __forceinline__ void ph_g1(const Ctx& C, int l) {
    const float* W = (C.P.in[8]) + (size_t)l * 1024 * IN_COLS;
    const int n_lat = (NL / 128) * 128, n_ctx = (NC / 128) * (l == 0 ? 128 : 32);
    for (int it = C.blk; it < n_lat + n_ctx; it += C.nblk) {
        int rt, ct;
        if (it < n_lat) { rt = it >> 7; ct = it & 127; }
        else { const int j = it - n_lat; if (l == 0) { rt = NL / 128 + (j >> 7); ct = j & 127; } else { rt = NL / 128 + (j >> 5); ct = 32 + (j & 31); } }
        const int row0 = rt * 128, col0 = ct * 64;
        float acc[4][4];
        ngemm_tile(C.lds_f, C.tid, 1024,
            [&](int i, int k) { return ((bf16_t*)(C.P.ws + WS_XN)) + (size_t)(row0 + i) * 1024 + k; },
            [&](int k, int j) { const int n = col0 + j; return n < 3872 ? W[(size_t)k * IN_COLS + n] : (n < 4096 ? 0.f : W[(size_t)k * IN_COLS + n - 224]); }, acc);
        NG_EPI(acc, [&](int i, int j0, const float* a) {
                const int n = col0 + j0; u32x2 o;
                if (n < 4096) { o.x = pk2(a[0], a[1]); o.y = pk2(a[2], a[3]); *(u32x2*)(((bf16_t*)(C.P.ws + WS_PQKV)) + (size_t)(row0 + i) * PQW + n) = o; }
                else { o.x = pk2(sigmoidf_(a[0]), sigmoidf_(a[1])); o.y = pk2(sigmoidf_(a[2]), sigmoidf_(a[3])); *(u32x2*)(((bf16_t*)(C.P.ws + WS_PG)) + (size_t)(row0 + i) * PGW + n - 4096) = o; }
            });
    }
}
__device__ __forceinline__ void ph_g2(const Ctx& C, int l) {
    const float* Wq = (C.P.in[23]) + (size_t)l * 512 * 768; const float* gq = (C.P.in[21]) + l * 512;
    const float* Wk = (C.P.in[24]) + (size_t)l * 256 * 1024; const float* gk = (C.P.in[22]) + l * 256;
    const int nq = (NT / 128) * 12, nk = (NT / 128) * 16;
    for (int it = C.blk; it < nq + nk; it += C.nblk) {
        float acc[4][4];
        if (it < nq) {
            const int row0 = (it / 12) * 128, col0 = (it % 12) * 64;
            ngemm_tile(C.lds_f, C.tid, 512,
                [&](int i, int k) { return ((bf16_t*)(C.P.ws + WS_PQKV)) + (size_t)(row0 + i) * PQW + C_CQ + k; },
                [&](int k, int j) { return gq[k] * Wq[(size_t)k * 768 + col0 + j]; }, acc);
            NG_EPI(acc, [&](int i, int j0, const float* a) { u32x2 o; o.x = pk2(a[0], a[1]); o.y = pk2(a[2], a[3]); *(u32x2*)(((bf16_t*)(C.P.ws + WS_QD)) + (size_t)(row0 + i) * 768 + col0 + j0) = o; });
        } else {
            const int j2 = it - nq; const int row0 = (j2 / 16) * 128, col0 = (j2 % 16) * 64;
            ngemm_tile(C.lds_f, C.tid, 256,
                [&](int i, int k) { return ((bf16_t*)(C.P.ws + WS_PQKV)) + (size_t)(row0 + i) * PQW + C_CKV + k; },
                [&](int k, int j) { return gk[k] * Wk[(size_t)k * 1024 + col0 + j]; }, acc);
            NG_EPI(acc, [&](int i, int j0, const float* a) { u32x2 o; o.x = pk2(a[0], a[1]); o.y = pk2(a[2], a[3]); *(u32x2*)(((bf16_t*)(C.P.ws + WS_KVD)) + (size_t)(row0 + i) * 1024 + col0 + j0) = o; });
        }
    }
}

__device__ __forceinline__ float inv_freq(int i, int n) { return exp2f(-(float)i / (float)n * 13.287712379549449f); }
__device__ __forceinline__ float grp16_sum(float v) { v += __shfl_xor(v, 1); v += __shfl_xor(v, 2); v += __shfl_xor(v, 4); v += __shfl_xor(v, 8); return v; }
__device__ __forceinline__ float grp8_sum(float v) { v += __shfl_xor(v, 1); v += __shfl_xor(v, 2); v += __shfl_xor(v, 4); return v; }
__device__ __forceinline__ float rms_inv(float ss, float inv_n) { return __builtin_amdgcn_rsqf(ss * inv_n + EPS); }
__device__ __forceinline__ void ph_post(const Ctx& C, int l, int rep = 0) {
    (void)rep;
    const int gw = C.blk * 8 + C.wave, NGW = C.nblk * 8, lane = C.lane, g = lane >> 4, j = lane & 15, jj = lane & 7, g8 = lane >> 3;
    float fh[2], fr[2];
#pragma unroll
    for (int e = 0; e < 2; ++e) { fh[e] = inv_freq((2 * j + e) & 15, 16); fr[e] = inv_freq((2 * jj + e) & 7, 8); }
    float ga[6][4];
    {
        const float* gp[6] = {C.P.in[9], C.P.in[12], C.P.in[14], C.P.in[10], C.P.in[13], C.P.in[15]};
#pragma unroll
        for (int f = 0; f < 6; ++f) { ga[f][0] = gp[f][l * 64 + 2 * j]; ga[f][1] = gp[f][l * 64 + 2 * j + 1]; ga[f][2] = gp[f][l * 64 + 32 + 2 * j]; ga[f][3] = gp[f][l * 64 + 33 + 2 * j]; }
    }
    const f32x4 g_qn = *(const f32x4*)(C.P.in[25] + l * 64 + 4 * j), g_kn = *(const f32x4*)(C.P.in[26] + l * 64 + 4 * j);
    float g_qr[4], g_kr[4];
    g_qr[0] = (C.P.in[27])[l * 32 + 2 * jj]; g_qr[1] = (C.P.in[27])[l * 32 + 2 * jj + 1]; g_qr[2] = (C.P.in[27])[l * 32 + 16 + 2 * jj]; g_qr[3] = (C.P.in[27])[l * 32 + 17 + 2 * jj];
    g_kr[0] = (C.P.in[28])[l * 32 + 2 * jj]; g_kr[1] = (C.P.in[28])[l * 32 + 2 * jj + 1]; g_kr[2] = (C.P.in[28])[l * 32 + 16 + 2 * jj]; g_kr[3] = (C.P.in[28])[l * 32 + 17 + 2 * jj];
    for (int r = gw; r < NT; r += NGW) {
        const bool lat = r < NL; const int t = r & 2047; const float prow = (float)(t >> 6), pcol = (float)(t & 63);
        float ch[2] = {1.f, 1.f}, sh[2] = {0.f, 0.f}, cr[2] = {1.f, 1.f}, sr[2] = {0.f, 0.f};
        if (lat) {
#pragma unroll
            for (int e = 0; e < 2; ++e) { __sincosf((j < 8 ? prow : pcol) * fh[e], &sh[e], &ch[e]); __sincosf((jj < 4 ? prow : pcol) * fr[e], &sr[e], &cr[e]); }
        }
        bf16_t* pq = ((bf16_t*)(C.P.ws + WS_PQKV)) + (size_t)r * PQW;
        bf16_t* kv = ((bf16_t*)(C.P.ws + WS_KVD)) + (size_t)r * 1024;
        bf16_t* qd = ((bf16_t*)(C.P.ws + WS_QD)) + (size_t)r * 768;
        const bool do_q = lat || l == 0;
        const u32x2 ckv_raw = *(const u32x2*)(pq + C_CKV + lane * 4);
        const u32x4 cq_raw = *(const u32x4*)(pq + C_CQ + lane * 8);
#pragma unroll
        for (int it = 6; it < 9; ++it) {
            const int hh = 4 * it + g;
            const int col = it < 6 ? hh * 64 : (it == 6 ? (g < 2 ? C_KA + g * 64 : C_KB + (g - 2) * 64) : C_KC + (hh - 28) * 64);
            const unsigned w0 = *(const unsigned*)(pq + col + 2 * j), w1 = *(const unsigned*)(pq + col + 32 + 2 * j);
            const float x0 = bf2f(w0 & 0xffffu), x1 = bf2f(w0 >> 16), x2 = bf2f(w1 & 0xffffu), x3 = bf2f(w1 >> 16);
            const float rinv = rms_inv(grp16_sum((x0 * x0 + x1 * x1) + (x2 * x2 + x3 * x3)), 1.f / 64.f);
            float ga0, ga1, ga2, ga3;
            if (it < 6) { ga0 = ga[it >> 1][0]; ga1 = ga[it >> 1][1]; ga2 = ga[it >> 1][2]; ga3 = ga[it >> 1][3]; }
            else if (it == 6) { ga0 = g < 2 ? ga[3][0] : ga[4][0]; ga1 = g < 2 ? ga[3][1] : ga[4][1]; ga2 = g < 2 ? ga[3][2] : ga[4][2]; ga3 = g < 2 ? ga[3][3] : ga[4][3]; }
            else { ga0 = ga[5][0]; ga1 = ga[5][1]; ga2 = ga[5][2]; ga3 = ga[5][3]; }
            const float sc = it < 6 ? QSCALE64 : 1.f;
            const float y0 = x0 * rinv * ga0 * sc, y1 = x1 * rinv * ga1 * sc, y2 = x2 * rinv * ga2 * sc, y3 = x3 * rinv * ga3 * sc;
            *(unsigned*)(pq + col + 2 * j) = pk2(y0 * ch[0] - y2 * sh[0], y1 * ch[1] - y3 * sh[1]);
            *(unsigned*)(pq + col + 32 + 2 * j) = pk2(y0 * sh[0] + y2 * ch[0], y1 * sh[1] + y3 * ch[1]);
        }
        {
            const unsigned w0 = lane < 8 ? *(const unsigned*)(pq + C_KR + 2 * jj) : 0u, w1 = lane < 8 ? *(const unsigned*)(pq + C_KR + 16 + 2 * jj) : 0u;
            const float x0 = bf2f(w0 & 0xffffu), x1 = bf2f(w0 >> 16), x2 = bf2f(w1 & 0xffffu), x3 = bf2f(w1 >> 16);
            const float rinv = rms_inv(grp8_sum((x0 * x0 + x1 * x1) + (x2 * x2 + x3 * x3)), 1.f / 32.f);
            const float y0 = x0 * rinv * g_kr[0], y1 = x1 * rinv * g_kr[1], y2 = x2 * rinv * g_kr[2], y3 = x3 * rinv * g_kr[3];
            if (lane < 8) { *(unsigned*)(pq + C_KR + 2 * jj) = pk2(y0 * cr[0] - y2 * sr[0], y1 * cr[1] - y3 * sr[1]); *(unsigned*)(pq + C_KR + 16 + 2 * jj) = pk2(y0 * sr[0] + y2 * cr[0], y1 * sr[1] + y3 * cr[1]); }
        }
        {
            float t4[4] = {bf2f(ckv_raw.x & 0xffffu), bf2f(ckv_raw.x >> 16), bf2f(ckv_raw.y & 0xffffu), bf2f(ckv_raw.y >> 16)};
            const float rkv = rms_inv(wave_sum((t4[0] * t4[0] + t4[1] * t4[1]) + (t4[2] * t4[2] + t4[3] * t4[3])), 1.f / 256.f);
#pragma unroll
            for (int it = 0; it < 2; ++it) {
                bf16_t* p = kv + (4 * it + g) * 128 + 4 * j;
                const u32x2 w = *(const u32x2*)p;
                const float x0 = rkv * bf2f(w.x & 0xffffu), x1 = rkv * bf2f(w.x >> 16), x2 = rkv * bf2f(w.y & 0xffffu), x3 = rkv * bf2f(w.y >> 16);
                const float rinv = rms_inv(grp16_sum((x0 * x0 + x1 * x1) + (x2 * x2 + x3 * x3)), 1.f / 64.f);
                u32x2 o; o.x = pk2(x0 * rinv * g_kn[0], x1 * rinv * g_kn[1]); o.y = pk2(x2 * rinv * g_kn[2], x3 * rinv * g_kn[3]); *(u32x2*)p = o;
            }
            {
                bf16_t* p = kv + g8 * 128 + 64 + jj * 8;
                float v8[8]; unpack8(*(const u32x4*)p, v8);
                u32x4 o; o.x = pk2(rkv * v8[0], rkv * v8[1]); o.y = pk2(rkv * v8[2], rkv * v8[3]); o.z = pk2(rkv * v8[4], rkv * v8[5]); o.w = pk2(rkv * v8[6], rkv * v8[7]); *(u32x4*)p = o;
            }
        }
        if (do_q) {
            float t8[8]; unpack8(cq_raw, t8);
            float ss = 0.f;
#pragma unroll
            for (int q = 0; q < 8; ++q) ss += t8[q] * t8[q];
            const float rq = rms_inv(wave_sum(ss), 1.f / 512.f);
            if (lane == 0) ((float*)(C.P.ws + WS_RQ))[r] = rq;
        }
    }
}

struct AttnArgs {
    const bf16_t* q; int qpitch; const bf16_t* k1; int k1pitch; const bf16_t* k2; int k2pitch; const bf16_t* v; int vpitch;
    float scale, sink; bool has_sink, windowed, qctx, lat_keys; int b, q0, nq;
};
template <int DQK, int DV>
__device__ __forceinline__ void nattn_core(float* lds_f, int tid, const AttnArgs& a, float (&o)[DV]) {
    float* Ks = lds_f; float* Vs = lds_f + 32 * DQK;
    const int qpos = a.q0 + tid; const bool valid = tid < a.nq;
    const size_t qrow = valid ? (a.qctx ? (size_t)(NL + a.b * CTXL + qpos) : (size_t)(a.b * SEQ + qpos)) : (size_t)0;
    float q[DQK];
    {
        const bf16_t* qp = a.q + qrow * a.qpitch;
#pragma unroll
        for (int d8 = 0; d8 < DQK / 8; ++d8) { float t[8]; unpack8(*(const u32x4*)(qp + d8 * 8), t);
#pragma unroll
            for (int i = 0; i < 8; ++i) q[d8 * 8 + i] = t[i] * a.scale; }
    }
    float m = a.has_sink ? a.sink : -1e30f, ls = a.has_sink ? 1.f : 0.f;
#pragma unroll
    for (int d = 0; d < DV; ++d) o[d] = 0.f;
    auto tile = [&](size_t krow0, int kpos0, bool masked) {
        __syncthreads();
        for (int c = tid; c < 32 * DQK / 8; c += NTHREADS) {
            const int key = c / (DQK / 8), d8 = (c % (DQK / 8)) * 8;
            const bf16_t* src = d8 < 64 ? a.k1 + (krow0 + key) * a.k1pitch + d8 : a.k2 + (krow0 + key) * a.k2pitch + (d8 - 64);
            float t[8]; unpack8(*(const u32x4*)src, t);
#pragma unroll
            for (int i = 0; i < 8; ++i) Ks[key * DQK + d8 + i] = t[i];
        }
        for (int c = tid; c < 32 * DV / 8; c += NTHREADS) {
            const int key = c / (DV / 8), d8 = (c % (DV / 8)) * 8;
            float t[8]; unpack8(*(const u32x4*)(a.v + (krow0 + key) * a.vpitch + d8), t);
#pragma unroll
            for (int i = 0; i < 8; ++i) Vs[key * DV + d8 + i] = t[i];
        }
        __syncthreads();
        for (int j = 0; j < 32; ++j) {
            int dist = qpos - (kpos0 + j); dist = dist < 0 ? -dist : dist;
            const bool ok = valid && (!masked || dist <= 128);
            if (ok) {
                float s = 0.f; const f32x4* kp = (const f32x4*)(Ks + j * DQK);
#pragma unroll
                for (int d4 = 0; d4 < DQK / 4; ++d4) { const f32x4 kv = kp[d4]; s += q[4 * d4] * kv.x + q[4 * d4 + 1] * kv.y + q[4 * d4 + 2] * kv.z + q[4 * d4 + 3] * kv.w; }
                if (s > m) { const float corr = exp2f(m - s); ls *= corr;
#pragma unroll
                    for (int d = 0; d < DV; ++d) o[d] *= corr;
                    m = s; }
                const float p = exp2f(s - m); ls += p; const f32x4* vp = (const f32x4*)(Vs + j * DV);
#pragma unroll
                for (int d4 = 0; d4 < DV / 4; ++d4) { const f32x4 vv = vp[d4]; o[4 * d4] += p * vv.x; o[4 * d4 + 1] += p * vv.y; o[4 * d4 + 2] += p * vv.z; o[4 * d4 + 3] += p * vv.w; }
            }
        }
    };
    if (a.lat_keys) {
        int lo = 0, hi = SEQ;
        if (a.windowed) { lo = a.q0 - 128; lo = lo < 0 ? 0 : lo; lo &= ~31; hi = a.q0 + a.nq + 128; hi = hi > SEQ ? SEQ : hi; }
        for (int kp = lo; kp < hi; kp += 32) tile((size_t)(a.b * SEQ + kp), kp, a.windowed);
    }
    for (int kp = 0; kp < CTXL; kp += 32) tile((size_t)(NL + a.b * CTXL + kp), 0, false);
    const float inv = ls > 0.f ? 1.f / ls : 0.f;
#pragma unroll
    for (int d = 0; d < DV; ++d) o[d] *= inv;
    __syncthreads();
}
__device__ __forceinline__ void store_o64(bf16_t* dst, const float (&o)[64]) {
#pragma unroll
    for (int d8 = 0; d8 < 8; ++d8) { u32x4 w; w.x = pk2(o[d8 * 8], o[d8 * 8 + 1]); w.y = pk2(o[d8 * 8 + 2], o[d8 * 8 + 3]); w.z = pk2(o[d8 * 8 + 4], o[d8 * 8 + 5]); w.w = pk2(o[d8 * 8 + 6], o[d8 * 8 + 7]); *(u32x4*)(dst + d8 * 8) = w; }
}
__device__ __forceinline__ void ph_attn(const Ctx& C, int l) {
    const int n_lat = NBATCH * 4 * 28, n_ctx = (l == 0) ? NBATCH * 28 : 0;
    const float lam = __hip_atomic_load(&((float*)(C.P.ws + WS_CNT + 128))[l], __ATOMIC_RELAXED, __HIP_MEMORY_SCOPE_AGENT);
    const float lam_init = 0.8f - 0.6f * expf(-0.3f * (float)l);
    bf16_t* PQKV = (bf16_t*)(C.P.ws + WS_PQKV); bf16_t* BR = (bf16_t*)(C.P.ws + WS_BR);
    for (int it = C.blk; it < n_lat + n_ctx; it += C.nblk) {
        AttnArgs a; int hitem;
        if (it < n_lat) { hitem = it % 28; const int rest = it / 28; a.b = rest >> 2; a.q0 = (rest & 3) * 512; a.nq = 512; a.qctx = false; a.lat_keys = true; }
        else { const int j = it - n_lat; hitem = j % 28; a.b = j / 28; a.q0 = 0; a.nq = CTXL; a.qctx = true; a.lat_keys = false; }
        a.k2 = nullptr; a.k2pitch = 0; a.has_sink = false; a.sink = 0.f; a.windowed = false; a.scale = 1.0f;
        const bool valid = C.tid < a.nq;
        const size_t orow = valid ? (a.qctx ? (size_t)(NL + a.b * CTXL + a.q0 + C.tid) : (size_t)(a.b * SEQ + a.q0 + C.tid)) : (size_t)0;
        float o[64];
        if (hitem < 16) {
            const bool isA = hitem < 8; const int h = hitem & 7, kvh = h >> 2;
            a.q = PQKV + (isA ? C_QA : C_QB) + h * 64; a.qpitch = PQW;
            a.k1 = PQKV + (isA ? C_KA : C_KB) + kvh * 64; a.k1pitch = PQW;
            a.v = PQKV + (isA ? C_VA : C_VB) + kvh * 64; a.vpitch = PQW;
            if (isA) { a.has_sink = true; a.sink = (C.P.in[11])[l * 8 + h] * LOG2E; a.windowed = !a.qctx; }
            nattn_core<64, 64>(C.lds_f, C.tid, a, o);
            if (valid) store_o64(BR + orow * BRW + (isA ? 0 : 512) + h * 64, o);
        } else if (hitem < 20) {
            const int hc = hitem - 16;
            float* sc1 = (float*)(C.P.ws + WS_OC1) + (orow * 4 + hc) * 128;
            float ss = 0.f;
            for (int part = 0; part < 2; ++part)
                for (int ch = 0; ch < 2; ++ch) {
                    a.q = PQKV + C_QC + (2 * hc + part) * 64; a.qpitch = PQW; a.k1 = PQKV + C_KC + (2 * hc + part) * 64; a.k1pitch = PQW;
                    a.v = PQKV + C_VC + hc * 128 + ch * 64; a.vpitch = PQW;
                    nattn_core<64, 64>(C.lds_f, C.tid, a, o);
                    if (valid) {
                        f32x4* s4 = (f32x4*)(sc1 + ch * 64);
                        if (part == 0) {
#pragma unroll
                            for (int d4 = 0; d4 < 16; ++d4) s4[d4] = (f32x4){o[4 * d4], o[4 * d4 + 1], o[4 * d4 + 2], o[4 * d4 + 3]};
                        } else {
#pragma unroll
                            for (int d4 = 0; d4 < 16; ++d4) { const f32x4 o1 = s4[d4];
                                const f32x4 dl = (f32x4){o1.x - lam * o[4 * d4], o1.y - lam * o[4 * d4 + 1], o1.z - lam * o[4 * d4 + 2], o1.w - lam * o[4 * d4 + 3]};
                                ss += (dl.x * dl.x + dl.y * dl.y) + (dl.z * dl.z + dl.w * dl.w); s4[d4] = dl; }
                        }
                    }
                }
            if (valid) {
                const float rs = (1.0f / sqrtf(ss * (1.f / 128.f) + EPS)) * (1.f - lam_init);
                const float* gn = (C.P.in[20]) + l * 128;
                for (int ch = 0; ch < 2; ++ch) {
#pragma unroll
                    for (int d4 = 0; d4 < 16; ++d4) { const f32x4 dl = ((const f32x4*)(sc1 + ch * 64))[d4]; const f32x4 g4 = ((const f32x4*)(gn + ch * 64))[d4];
                        o[4 * d4] = dl.x * rs * g4.x; o[4 * d4 + 1] = dl.y * rs * g4.y; o[4 * d4 + 2] = dl.z * rs * g4.z; o[4 * d4 + 3] = dl.w * rs * g4.w; }
                    store_o64(BR + orow * BRW + 1024 + hc * 128 + ch * 64, o);
                }
            }
        } else {
            const int h = hitem - 20;
            bf16_t* QD = (bf16_t*)(C.P.ws + WS_QD); bf16_t* KVD = (bf16_t*)(C.P.ws + WS_KVD);
            a.q = QD + h * 96; a.qpitch = 768; a.k1 = KVD + h * 128; a.k1pitch = 1024; a.k2 = PQKV + C_KR; a.k2pitch = PQW; a.v = KVD + h * 128 + 64; a.vpitch = 1024;
            nattn_core<96, 64>(C.lds_f, C.tid, a, o);
            if (valid) store_o64(BR + orow * BRW + 1536 + h * 64, o);
        }
    }
}

__device__ __forceinline__ void ph_g3(const Ctx& C, int l) {
    const int nrt = (l == 0 ? NT : NL) / 128;
    for (int it = C.blk; it < nrt * 16; it += C.nblk) {
        const int row0 = (it >> 4) * 128, col0 = (it & 15) * 64;
        const int ty = C.tid >> 4, tx = C.tid & 15;
        float tot[4][4];
#pragma unroll
        for (int i = 0; i < 4; ++i)
#pragma unroll
            for (int j = 0; j < 4; ++j) tot[i][j] = 0.f;
        for (int n = 0; n < 4; ++n) {
            const float* W = (C.P.in[29]) + (size_t)(l * 4 + n) * 512 * 1024;
            float part[4][4];
            ngemm_tile(C.lds_f, C.tid, 512,
                [&](int i, int k) { return ((bf16_t*)(C.P.ws + WS_BR)) + (size_t)(row0 + i) * BRW + n * 512 + k; },
                [&](int k, int j) { return W[(size_t)k * 1024 + col0 + j]; }, part);
#pragma unroll
            for (int i = 0; i < 4; ++i) {
                const u32x2 g = *(const u32x2*)(((bf16_t*)(C.P.ws + WS_PG)) + (size_t)(row0 + ty * 4 + i) * PGW + n * 1024 + col0 + tx * 4);
                tot[i][0] += bf2f(g.x & 0xffffu) * part[i][0]; tot[i][1] += bf2f(g.x >> 16) * part[i][1]; tot[i][2] += bf2f(g.y & 0xffffu) * part[i][2]; tot[i][3] += bf2f(g.y >> 16) * part[i][3];
            }
        }
#pragma unroll
        for (int i = 0; i < 4; ++i) { u32x2 o; o.x = pk2(tot[i][0], tot[i][1]); o.y = pk2(tot[i][2], tot[i][3]); *(u32x2*)(((bf16_t*)(C.P.ws + WS_MERGED)) + (size_t)(row0 + ty * 4 + i) * 1024 + col0 + tx * 4) = o; }
    }
}
__device__ __forceinline__ void resid_store(const Ctx& C, int l, int mi, bool first, int row, int n, const float* a) {
    const int mrow = row < NL ? (row >> 11) : 8;
    const f32x4 mv = *(const f32x4*)(((float*)(C.P.ws + WS_MOD)) + (size_t)(l * 9 + mrow) * 6144 + mi * 1024 + n);
    float* dst = row < NL ? (C.P.out) + (size_t)row * 1024 + n : ((float*)(C.P.ws + WS_CX)) + (size_t)(row - NL) * 1024 + n;
    const float* base = first ? (row < NL ? (C.P.in[0]) + (size_t)row * 1024 + n : (C.P.in[2]) + (size_t)(row - NL) * 1024 + n) : dst;
    const f32x4 b = *(const f32x4*)base;
    *(f32x4*)dst = (f32x4){b.x + mv.x * a[0], b.y + mv.y * a[1], b.z + mv.z * a[2], b.w + mv.w * a[3]};
}
__device__ __forceinline__ void ph_g4(const Ctx& C, int l) {
    const float* W = (C.P.in[30]) + (size_t)l * 1024 * 1024;
    const int nrt = (l == 0 ? NT : NL) / 128;
    for (int it = C.blk; it < nrt * 16; it += C.nblk) {
        const int row0 = (it >> 4) * 128, col0 = (it & 15) * 64;
        float acc[4][4];
        ngemm_tile(C.lds_f, C.tid, 1024,
            [&](int i, int k) { return ((bf16_t*)(C.P.ws + WS_MERGED)) + (size_t)(row0 + i) * 1024 + k; },
            [&](int k, int j) { return W[(size_t)k * 1024 + col0 + j]; }, acc);
        NG_EPI(acc, [&](int i, int j0, const float* a) { resid_store(C, l, 2, l == 0, row0 + i, col0 + j0, a); });
    }
}
__device__ __forceinline__ void ph_g5(const Ctx& C) {
    for (int it = C.blk; it < (NT / 128) * 88; it += C.nblk) {
        const int row0 = (it / 88) * 128, col0 = (it % 88) * 64;
        float acc[4][4];
        ngemm_tile(C.lds_f, C.tid, 1024,
            [&](int i, int k) { return ((bf16_t*)(C.P.ws + WS_XN)) + (size_t)(row0 + i) * 1024 + k; },
            [&](int k, int j) { const int v = col0 + j; return (v & 1) ? (C.P.in[32])[(size_t)k * DFF + (v >> 1)] : (C.P.in[31])[(size_t)k * DFF + (v >> 1)]; }, acc);
        NG_EPI(acc, [&](int i, int j0, const float* a) { const int jj = (col0 + j0) >> 1; *(unsigned*)(((bf16_t*)(C.P.ws + WS_H)) + (size_t)(row0 + i) * DFF + jj) = pk2(siluf_(a[0]) * a[1], siluf_(a[2]) * a[3]); });
    }
}
__device__ __forceinline__ void ph_g6(const Ctx& C) {
    for (int it = C.blk; it < (NT / 128) * 16; it += C.nblk) {
        const int row0 = (it >> 4) * 128, col0 = (it & 15) * 64;
        float acc[4][4];
        ngemm_tile(C.lds_f, C.tid, DFF,
            [&](int i, int k) { return ((bf16_t*)(C.P.ws + WS_H)) + (size_t)(row0 + i) * DFF + k; },
            [&](int k, int j) { return (C.P.in[33])[(size_t)k * 1024 + col0 + j]; }, acc);
        NG_EPI(acc, [&](int i, int j0, const float* a) { resid_store(C, 0, 5, false, row0 + i, col0 + j0, a); });
    }
}

__device__ __forceinline__ void moe_starts(const Ctx& C, int (&cnt)[8], int (&ps)[9]) {
    ps[0] = 0;
#pragma unroll
    for (int e = 0; e < 8; ++e) { cnt[e] = __hip_atomic_load(&((int*)(C.P.ws + WS_CNT))[e], __ATOMIC_RELAXED, __HIP_MEMORY_SCOPE_AGENT); ps[e + 1] = ps[e] + ((cnt[e] + 255) & ~255); }
}
__device__ __forceinline__ void ph_assign(const Ctx& C) {
    int cnt[8], ps[9]; moe_starts(C, cnt, ps);
    const int gw = C.blk * 8 + C.wave, NGW = C.nblk * 8;
    for (int t0 = gw * 64; t0 < NL; t0 += NGW * 64) {
        const int tok = t0 + C.lane; const int ee = ((int*)(C.P.ws + WS_ROUTE_E))[tok];
#pragma unroll
        for (int k = 0; k < 2; ++k) {
            const int my = (ee >> (8 * k)) & 0xff; int pos = 0;
#pragma unroll
            for (int e = 0; e < 8; ++e) {
                const unsigned long long mask = __ballot(my == e);
                if (mask) {
                    int base = 0; const int leader = __ffsll((long long)mask) - 1;
                    if (C.lane == leader) base = atomicAdd(&((int*)(C.P.ws + WS_CNT))[16 + e], (int)__popcll(mask));
                    base = __shfl(base, leader);
                    if (my == e) pos = ps[e] + base + (int)__popcll(mask & ((1ull << C.lane) - 1ull));
                }
            }
            ((int*)(C.P.ws + WS_ROWMAP))[pos] = tok; ((int*)(C.P.ws + WS_POS))[2 * tok + k] = pos;
        }
    }
    if (C.blk == 0) {
#pragma unroll
        for (int e = 0; e < 8; ++e) for (int i = cnt[e] + C.tid; i < ps[e + 1] - ps[e]; i += NTHREADS) ((int*)(C.P.ws + WS_ROWMAP))[ps[e] + i] = -1;
    }
}
__device__ __forceinline__ int moe_expert_of(const int (&ps)[9], int p0) {
    int e = 0;
#pragma unroll
    for (int q = 1; q < 8; ++q) if (p0 >= ps[q]) e = q;
    return e;
}
__device__ __forceinline__ void ph_g7(const Ctx& C) {
    int cnt[8], ps[9]; moe_starts(C, cnt, ps);
    const int nrt = ps[8] / 128;
    for (int it = C.blk; it < nrt * 112; it += C.nblk) {
        const int p0 = (it / 112) * 128, col0 = (it % 112) * 64;
        const int e = moe_expert_of(ps, p0);
        int cnt_e = 0;
#pragma unroll
        for (int q = 0; q < 8; ++q) if (q == e) cnt_e = cnt[q];
        int ps_e = 0;
#pragma unroll
        for (int q = 0; q < 8; ++q) if (q == e) ps_e = ps[q];
        if (p0 >= ps_e + cnt_e) continue;
        const float* W1 = (C.P.in[35]) + (size_t)e * 1024 * EFF; const float* W3 = (C.P.in[36]) + (size_t)e * 1024 * EFF;
        float acc[4][4];
        ngemm_tile(C.lds_f, C.tid, 1024,
            [&](int i, int k) { const int tok = ((int*)(C.P.ws + WS_ROWMAP))[p0 + i]; return tok < 0 ? (const bf16_t*)nullptr : ((bf16_t*)(C.P.ws + WS_XN)) + (size_t)tok * 1024 + k; },
            [&](int k, int j) { const int v = col0 + j; return (v & 1) ? W3[(size_t)k * EFF + (v >> 1)] : W1[(size_t)k * EFF + (v >> 1)]; }, acc);
        NG_EPI(acc, [&](int i, int j0, const float* a) { const int jj = (col0 + j0) >> 1; *(unsigned*)(((bf16_t*)(C.P.ws + WS_HM)) + (size_t)(p0 + i) * EFF + jj) = pk2(siluf_(a[0]) * a[1], siluf_(a[2]) * a[3]); });
    }
}
__device__ __forceinline__ void ph_g8(const Ctx& C) {
    int cnt[8], ps[9]; moe_starts(C, cnt, ps);
    const int nrt = ps[8] / 128;
    for (int it = C.blk; it < nrt * 16; it += C.nblk) {
        const int p0 = (it >> 4) * 128, col0 = (it & 15) * 64;
        const int e = moe_expert_of(ps, p0);
        int cnt_e = 0, ps_e = 0;
#pragma unroll
        for (int q = 0; q < 8; ++q) if (q == e) { cnt_e = cnt[q]; ps_e = ps[q]; }
        if (p0 >= ps_e + cnt_e) continue;
        const float* W2 = (C.P.in[37]) + (size_t)e * EFF * 1024;
        float acc[4][4];
        ngemm_tile(C.lds_f, C.tid, EFF,
            [&](int i, int k) { return ((bf16_t*)(C.P.ws + WS_HM)) + (size_t)(p0 + i) * EFF + k; },
            [&](int k, int j) { return W2[(size_t)k * 1024 + col0 + j]; }, acc);
        NG_EPI(acc, [&](int i, int j0, const float* a) { u32x2 o; o.x = pk2(a[0], a[1]); o.y = pk2(a[2], a[3]); *(u32x2*)(((bf16_t*)(C.P.ws + WS_YM)) + (size_t)(p0 + i) * 1024 + col0 + j0) = o; });
    }
}
__device__ __forceinline__ void ph_combine(const Ctx& C) {
    const int gw = C.blk * 8 + C.wave, NGW = C.nblk * 8;
    for (int r = gw; r < NL; r += NGW) {
        const int p0 = ((int*)(C.P.ws + WS_POS))[2 * r], p1 = ((int*)(C.P.ws + WS_POS))[2 * r + 1]; const float w0 = ((float*)(C.P.ws + WS_ROUTE_W))[2 * r], w1 = ((float*)(C.P.ws + WS_ROUTE_W))[2 * r + 1];
        const float* m5 = ((float*)(C.P.ws + WS_MOD)) + (size_t)(9 + (r >> 11)) * 6144 + 5 * 1024;
#pragma unroll
        for (int j = 0; j < 4; ++j) {
            const int c4 = C.lane + 64 * j;
            const u32x2 a = ((const u32x2*)(((bf16_t*)(C.P.ws + WS_YM)) + (size_t)p0 * 1024))[c4], b = ((const u32x2*)(((bf16_t*)(C.P.ws + WS_YM)) + (size_t)p1 * 1024))[c4];
            const f32x4 mv = ((const f32x4*)m5)[c4]; f32x4 o = ((const f32x4*)((C.P.out) + (size_t)r * 1024))[c4];
            o.x += mv.x * (w0 * bf2f(a.x & 0xffffu) + w1 * bf2f(b.x & 0xffffu)); o.y += mv.y * (w0 * bf2f(a.x >> 16) + w1 * bf2f(b.x >> 16));
            o.z += mv.z * (w0 * bf2f(a.y & 0xffffu) + w1 * bf2f(b.y & 0xffffu)); o.w += mv.w * (w0 * bf2f(a.y >> 16) + w1 * bf2f(b.y >> 16));
            ((f32x4*)((C.P.out) + (size_t)r * 1024))[c4] = o;
        }
    }
}

#define LAS __attribute__((address_space(3)))
typedef short bf16x8 __attribute__((ext_vector_type(8)));
constexpr int BM = 256, BK = 64, HALF = 128, HTB = HALF * BK * 2, NXCD = 8, WGM = 8;
__device__ __forceinline__ int lds_byte(int r, int c) { const int st = (r >> 4) * 2 + (c >> 5), rr = r & 15, cc = c & 31, ob = rr * 64 + cc * 2; return st * 1024 + (ob ^ (((ob >> 9) & 1) << 5)); }
__device__ __forceinline__ void stage_rc(int b, int& R, int& C) { const int st = b / 1024, sb = b % 1024, swz = sb ^ (((sb >> 9) & 1) << 5); R = (st >> 1) * 16 + swz / 64; C = (st & 1) * 32 + (swz % 64) / 2; }
__device__ __forceinline__ int perm32(int rho) { const int n = rho >> 4, i = rho & 15; return 8 * (i >> 2) + 4 * n + (i & 3); }
__device__ __forceinline__ unsigned cvt_pk_bf16(float lo, float hi) { f32x2_t v = {lo, hi}; bf16x2_t b = __builtin_convertvector(v, bf16x2_t); return __builtin_bit_cast(unsigned, b); }

struct GUnit { const char* A; const char* B; int pm, pn, aux; };
__device__ __forceinline__ bool static_order(int nM, int nN, int G, int c, int i, int& pm, int& pn) {
    const int nwg = nM * nN; const long L = (long)i * G + c; if (L >= nwg) return false;
    int wgid = (int)L; { const int q = nwg / NXCD, r = nwg % NXCD, xcd = wgid % NXCD, off = wgid / NXCD; wgid = (xcd < r ? xcd * (q + 1) : r * (q + 1) + (xcd - r) * q) + off; }
    const int nig = WGM * nN, gid = wgid / nig, fm = gid * WGM, gsz = (nM - fm) < WGM ? (nM - fm) : WGM;
    pm = fm + ((wgid % nig) % gsz); pn = (wgid % nig) / gsz; return true;
}

typedef f32x4 Acc[2][2][4][2];
template <bool PERM, bool GATHER, bool HALFN, class Sched, class Epi>
__device__ __forceinline__ void gemm_phase_t(LAS unsigned char* lds, const int K, const int lda, const Sched& S, Epi& E) {
    const int tid = threadIdx.x, wid = __builtin_amdgcn_readfirstlane(tid >> 6), lane = tid & 63, wr = wid >> 2, wc = wid & 3, fr = lane & 15, fq = lane >> 4;
    const int nt = K / BK;
    unsigned voffB[2]; int RA[2], CA[2];
#pragma unroll
    for (int i = 0; i < 2; ++i) { int R, C; stage_rc(tid * 16 + i * 8192, R, C); const int Rb = PERM ? ((R & ~31) + perm32(R & 31)) : R; voffB[i] = (unsigned)(Rb * K + C) * 2u; RA[i] = R; CA[i] = C; }
    const size_t kstep = (size_t)(BK * 2);
    const size_t hstepB = (size_t)HALF * K * 2;
    const unsigned ldsw = (unsigned)wid * 1024u;
    const int aoff = lds_byte(wr * 64 + fr, fq * 8), boff = lds_byte(wc * 32 + fr, fq * 8);
#define PG8_SA(b, h) (((b) * 2 + (h)) * HTB)
#define PG8_SB(b, h) ((4 + (b) * 2 + (h)) * HTB)
#define PG8_STAGE(bufoff, gbase, voff) do { _Pragma("unroll") for (int _i = 0; _i < 2; ++_i) \
        __builtin_amdgcn_global_load_lds((const unsigned*)((const char*)(gbase) + (voff)[_i]), (LAS unsigned*)(lds + (bufoff) + ldsw + _i * 8192), 16, 0, 0); } while (0)
#define PG8_LDA(dst, b, h) do { _Pragma("unroll") for (int m = 0; m < 4; ++m) _Pragma("unroll") for (int k = 0; k < 2; ++k) dst[m][k] = *(const LAS bf16x8*)(lds + PG8_SA(b, h) + aoff + m * 2048 + k * 1024); } while (0)
#define PG8_LDB(dst, b, h) do { _Pragma("unroll") for (int n = 0; n < 2; ++n) _Pragma("unroll") for (int k = 0; k < 2; ++k) dst[n][k] = *(const LAS bf16x8*)(lds + PG8_SB(b, h) + boff + n * 2048 + k * 1024); } while (0)
#define PG8_MMA(ai, bj, At, Bt) do { __builtin_amdgcn_s_setprio(1); _Pragma("unroll") for (int m = 0; m < 4; ++m) _Pragma("unroll") for (int n = 0; n < 2; ++n) _Pragma("unroll") for (int k = 0; k < 2; ++k) \
        acc[ai][bj][m][n] = __builtin_amdgcn_mfma_f32_16x16x32_bf16(Bt[n][k], At[m][k], acc[ai][bj][m][n], 0, 0, 0); __builtin_amdgcn_s_setprio(0); } while (0)
#define PG8_WAIT_V(n) asm volatile("s_waitcnt vmcnt(" #n ")" ::: "memory")
#define PG8_WAIT_L(n) asm volatile("s_waitcnt lgkmcnt(" #n ")" ::: "memory")
#define PG8_BAR __builtin_amdgcn_s_barrier()
#define PG8_SCHED __builtin_amdgcn_sched_barrier(0)
#define PG8_OFFA(u, o) do { _Pragma("unroll") for (int h_ = 0; h_ < 2; ++h_) _Pragma("unroll") for (int i_ = 0; i_ < 2; ++i_) { const int row_ = h_ * HALF + RA[i_]; \
        if constexpr (GATHER) o[h_][i_] = S.row_off(u, row_) + (unsigned)CA[i_] * 2u; else o[h_][i_] = (unsigned)(row_ * lda + CA[i_]) * 2u; } } while (0)
    GUnit cur, nxt; int ui = 0;
    if (!S.next(0, cur)) return;
    Acc acc;
#pragma unroll
    for (int a = 0; a < 2; ++a)
#pragma unroll
        for (int b = 0; b < 2; ++b)
#pragma unroll
            for (int m = 0; m < 4; ++m)
#pragma unroll
                for (int n = 0; n < 2; ++n) acc[a][b][m][n] = (f32x4){0.f, 0.f, 0.f, 0.f};
    bf16x8 At[4][2], B0[2][2], B1[2][2];
    unsigned oc[2][2], on[2][2];
    PG8_OFFA(cur, oc);
#pragma unroll
    for (int h = 0; h < 2; ++h)
#pragma unroll
        for (int i = 0; i < 2; ++i) on[h][i] = oc[h][i];
    const char* cA = cur.A; const char* cB = cur.B;
    if constexpr (HALFN) {
        PG8_STAGE(PG8_SB(0, 0), cB, voffB); PG8_STAGE(PG8_SA(0, 0), cA, oc[0]); PG8_STAGE(PG8_SA(0, 1), cA, oc[1]);
        if (wr == 1) PG8_BAR;
        PG8_WAIT_V(2); PG8_BAR;
        PG8_STAGE(PG8_SB(1, 0), cB + kstep, voffB); PG8_STAGE(PG8_SA(1, 0), cA + kstep, oc[0]);
        PG8_WAIT_V(4); PG8_BAR;
    } else {
    PG8_STAGE(PG8_SB(0, 0), cB, voffB); PG8_STAGE(PG8_SB(0, 1), cB + hstepB, voffB); PG8_STAGE(PG8_SA(0, 0), cA, oc[0]); PG8_STAGE(PG8_SA(0, 1), cA, oc[1]);
    if (wr == 1) PG8_BAR;
    PG8_WAIT_V(2); PG8_BAR;
    PG8_STAGE(PG8_SB(1, 0), cB + kstep, voffB); PG8_STAGE(PG8_SA(1, 0), cA + kstep, oc[0]); PG8_STAGE(PG8_SB(1, 1), cB + hstepB + kstep, voffB);
    PG8_WAIT_V(6); PG8_BAR;
    }
    for (;;) {
        const bool has_next = S.next(ui + 1, nxt);
        const char* nA = has_next ? nxt.A : cA; const char* nB = has_next ? nxt.B : cB;
        if constexpr (GATHER) { if (has_next) PG8_OFFA(nxt, on); }
        for (int t = 0; t < nt; t += 2) {
            const bool last = (t == nt - 2);
            const char* a1 = cA + (size_t)(t + 1) * kstep;
            const char* a2 = last ? nA : cA + (size_t)(t + 2) * kstep; const char* b2 = last ? nB : cB + (size_t)(t + 2) * kstep;
            const char* a3 = a2 + kstep; const char* b3 = b2 + kstep;
            unsigned o2[2][2];
#pragma unroll
            for (int h = 0; h < 2; ++h)
#pragma unroll
                for (int i = 0; i < 2; ++i) { if constexpr (GATHER) o2[h][i] = last ? on[h][i] : oc[h][i]; else o2[h][i] = oc[h][i]; }
            if constexpr (HALFN) {
            PG8_LDB(B0, 0, 0); PG8_SCHED; PG8_LDA(At, 0, 0); PG8_STAGE(PG8_SA(1, 1), a1, oc[1]);
            PG8_WAIT_V(6); PG8_WAIT_L(0); PG8_BAR; PG8_MMA(0, 0, At, B0); PG8_BAR; PG8_SCHED;
            PG8_LDA(At, 0, 1); PG8_STAGE(PG8_SB(0, 0), b2, voffB); PG8_STAGE(PG8_SA(0, 0), a2, o2[0]);
            PG8_WAIT_V(6); PG8_WAIT_L(0); PG8_BAR; PG8_MMA(1, 0, At, B0); PG8_BAR; PG8_SCHED;
            PG8_LDB(B0, 1, 0); PG8_SCHED; PG8_LDA(At, 1, 0); PG8_STAGE(PG8_SA(0, 1), a2, o2[1]);
            PG8_WAIT_V(6); PG8_WAIT_L(0); PG8_BAR; PG8_MMA(0, 0, At, B0); PG8_BAR; PG8_SCHED;
            PG8_LDA(At, 1, 1); PG8_STAGE(PG8_SB(1, 0), b3, voffB); PG8_STAGE(PG8_SA(1, 0), a3, o2[0]);
            PG8_WAIT_V(6); PG8_WAIT_L(0); PG8_BAR; PG8_MMA(1, 0, At, B0); PG8_BAR; PG8_SCHED;
            } else {
            PG8_LDB(B0, 0, 0); PG8_LDB(B1, 0, 1); PG8_SCHED; PG8_LDA(At, 0, 0); PG8_STAGE(PG8_SA(1, 1), a1, oc[1]);
            PG8_WAIT_V(8); PG8_WAIT_L(0); PG8_BAR; PG8_MMA(0, 0, At, B0); PG8_MMA(0, 1, At, B1); PG8_BAR; PG8_SCHED;
            PG8_LDA(At, 0, 1); PG8_STAGE(PG8_SB(0, 0), b2, voffB); PG8_STAGE(PG8_SB(0, 1), b2 + hstepB, voffB); PG8_STAGE(PG8_SA(0, 0), a2, o2[0]);
            PG8_WAIT_V(8); PG8_WAIT_L(0); PG8_BAR; PG8_MMA(1, 0, At, B0); PG8_MMA(1, 1, At, B1); PG8_BAR; PG8_SCHED;
            PG8_LDB(B0, 1, 0); PG8_LDB(B1, 1, 1); PG8_SCHED; PG8_LDA(At, 1, 0); PG8_STAGE(PG8_SA(0, 1), a2, o2[1]);
            PG8_WAIT_V(8); PG8_WAIT_L(0); PG8_BAR; PG8_MMA(0, 0, At, B0); PG8_MMA(0, 1, At, B1); PG8_BAR; PG8_SCHED;
            PG8_LDA(At, 1, 1); PG8_STAGE(PG8_SB(1, 0), b3, voffB); PG8_STAGE(PG8_SB(1, 1), b3 + hstepB, voffB); PG8_STAGE(PG8_SA(1, 0), a3, o2[0]);
            PG8_WAIT_V(8); PG8_WAIT_L(0); PG8_BAR; PG8_MMA(1, 0, At, B0); PG8_MMA(1, 1, At, B1); PG8_BAR; PG8_SCHED;
            }
        }
        if (wr == 0) PG8_BAR;
        E(acc, cur, wr, wc, fr, fq);
        if (!has_next) break;
#pragma unroll
        for (int a = 0; a < 2; ++a)
#pragma unroll
            for (int b = 0; b < 2; ++b)
#pragma unroll
                for (int m = 0; m < 4; ++m)
#pragma unroll
                    for (int n = 0; n < 2; ++n) acc[a][b][m][n] = (f32x4){0.f, 0.f, 0.f, 0.f};
        cur = nxt; cA = nA; cB = nB; ++ui;
        if constexpr (GATHER) {
#pragma unroll
            for (int h = 0; h < 2; ++h)
#pragma unroll
                for (int i = 0; i < 2; ++i) oc[h][i] = on[h][i];
        }
        if (wr == 1) PG8_BAR;
    }
    PG8_WAIT_V(0);
    PG8_BAR;
#undef PG8_SA
#undef PG8_SB
#undef PG8_STAGE
#undef PG8_LDA
#undef PG8_LDB
#undef PG8_MMA
#undef PG8_WAIT_V
#undef PG8_WAIT_L
#undef PG8_BAR
#undef PG8_SCHED
#undef PG8_OFFA
}

template <bool PERM, bool GATHER, class Sched, class Epi>
__device__ __forceinline__ void gemm_phase(LAS unsigned char* lds, const int K, const int lda, const Sched& S, const Epi& E) { Epi E2 = E; gemm_phase_t<PERM, GATHER, false>(lds, K, lda, S, E2); }

__device__ __forceinline__ u32x4 pack8(const f32x4 v0, const f32x4 v1) { u32x4 w; w.x = cvt_pk_bf16(v0[0], v0[1]); w.y = cvt_pk_bf16(v0[2], v0[3]); w.z = cvt_pk_bf16(v1[0], v1[1]); w.w = cvt_pk_bf16(v1[2], v1[3]); return w; }
__device__ __forceinline__ float fsig(float x) { return __builtin_amdgcn_rcpf(1.f + __builtin_amdgcn_exp2f(-LOG2E * x)); }
__device__ __forceinline__ f32x4 sig4(f32x4 v) { return (f32x4){fsig(v[0]), fsig(v[1]), fsig(v[2]), fsig(v[3])}; }
__device__ __forceinline__ void epi_store_bf16(const Acc& acc, bf16_t* O, int ldc, int row0, int col0, bool sig, int wr, int wc, int fr, int fq) {
#pragma unroll
    for (int ai = 0; ai < 2; ++ai)
#pragma unroll
        for (int m = 0; m < 4; ++m) { bf16_t* rowp = O + (size_t)(row0 + ai * HALF + wr * 64 + m * 16 + fr) * ldc + col0 + wc * 32 + 8 * fq;
#pragma unroll
            for (int bj = 0; bj < 2; ++bj) { f32x4 v0 = acc[ai][bj][m][0], v1 = acc[ai][bj][m][1]; if (sig) { v0 = sig4(v0); v1 = sig4(v1); } *(u32x4*)(rowp + bj * HALF) = pack8(v0, v1); } }
}

template <class RM>
__device__ __forceinline__ void transpose_item(const float* W, int K, int N, int ldk, bf16_t* WT, RM rowmap, const float* ksc, float* scr, int k0, int n0, int lane) {
    float tv[32];
#pragma unroll
    for (int i = 0; i < 32; ++i) tv[i] = W[(size_t)(k0 + 2 * i + (lane >> 5)) * N + n0 + (lane & 31)];
    if (ksc) {
#pragma unroll
        for (int i = 0; i < 32; ++i) tv[i] *= ksc[k0 + 2 * i + (lane >> 5)];
    }
#pragma unroll
    for (int i = 0; i < 32; ++i) scr[(2 * i + (lane >> 5)) * 33 + (lane & 31)] = tv[i];
    asm volatile("s_waitcnt lgkmcnt(0)" ::: "memory");
    const int c = lane & 7;
#pragma unroll
    for (int j = 0; j < 4; ++j) { const int n = (lane >> 3) + 8 * j; const float* s = scr + (8 * c) * 33 + n;
        u32x4 o; o.x = pk2(s[0 * 33], s[1 * 33]); o.y = pk2(s[2 * 33], s[3 * 33]); o.z = pk2(s[4 * 33], s[5 * 33]); o.w = pk2(s[6 * 33], s[7 * 33]);
        *(u32x4*)(WT + (size_t)rowmap(n0 + n) * ldk + k0 + 8 * c) = o; }
    asm volatile("s_waitcnt lgkmcnt(0)" ::: "memory");
}

constexpr size_t WS_WIN_T = 76 * MiB;
constexpr size_t WS_WBR_T = 108 * MiB;
constexpr size_t WS_WOUT_T = 116 * MiB;
constexpr size_t WS_WUQ_T = 120 * MiB;
constexpr size_t WS_WUKV_T = 121 * MiB + 512 * 1024;
constexpr size_t WS_FFGU_T = 123 * MiB + 512 * 1024;
constexpr size_t WS_FFD_T = 134 * MiB + 512 * 1024;
constexpr size_t WS_MACC = 184 * MiB;
constexpr size_t WS_W13_T = 40 * MiB;
constexpr size_t WS_W2_T = 152 * MiB;
constexpr int CONV_LDS_OFF = 65536;

template <class RM>
__device__ __forceinline__ void transpose_item64(const float* W, int K, int N, int ldk, bf16_t* WT, RM rowmap, const float* ksc, float* scr, int k0, int n0, int lane) {
#pragma unroll
    for (int h = 0; h < 2; ++h) {
        float tv[32];
#pragma unroll
        for (int i = 0; i < 32; ++i) tv[i] = __builtin_nontemporal_load(W + (size_t)(k0 + 32 * h + i) * N + n0 + lane);
        if (ksc) {
#pragma unroll
            for (int i = 0; i < 32; ++i) tv[i] *= ksc[k0 + 32 * h + i];
        }
#pragma unroll
        for (int i = 0; i < 32; ++i) scr[(32 * h + i) * 65 + lane] = tv[i];
    }
    asm volatile("s_waitcnt lgkmcnt(0)" ::: "memory");
    const int c = lane & 7;
#pragma unroll
    for (int j = 0; j < 8; ++j) { const int n = (lane >> 3) + 8 * j; const float* sp = scr + (8 * c) * 65 + n;
        u32x4 o; o.x = pk2(sp[0 * 65], sp[1 * 65]); o.y = pk2(sp[2 * 65], sp[3 * 65]); o.z = pk2(sp[4 * 65], sp[5 * 65]); o.w = pk2(sp[6 * 65], sp[7 * 65]);
        *(u32x4*)(WT + (size_t)rowmap(n0 + n) * ldk + k0 + 8 * c) = o; }
    asm volatile("s_waitcnt lgkmcnt(0)" ::: "memory");
}

struct ConvJob { const float* W; bf16_t* WT; const float* ksc; int K, N, kind, nitems, ldk; };
__device__ __forceinline__ int conv_rowmap(int kind, int n) {
    return kind == 0 ? n : (kind == 1 ? (n < 3872 ? n : n + 224) : ((n >> 7) * 256 + (n & 127) + (kind == 3 ? 128 : 0)));
}
__device__ __forceinline__ ConvJob conv_job_small(const Ctx& C, int j) {
    ConvJob J; J.ksc = nullptr; J.kind = 0;
    if (j < 2) { J.W = C.P.in[8] + (size_t)j * 1024 * IN_COLS; J.WT = (bf16_t*)(C.P.ws + WS_WIN_T) + (size_t)j * 8192 * 1024; J.K = 1024; J.N = IN_COLS; J.kind = 1; }
    else if (j < 4) { const int l = j - 2; J.W = C.P.in[23] + (size_t)l * 512 * 768; J.WT = (bf16_t*)(C.P.ws + WS_WUQ_T) + (size_t)l * 768 * 512; J.K = 512; J.N = 768; J.ksc = C.P.in[21] + l * 512; }
    else if (j < 6) { const int l = j - 4; J.W = C.P.in[24] + (size_t)l * 256 * 1024; J.WT = (bf16_t*)(C.P.ws + WS_WUKV_T) + (size_t)l * 1024 * 512; J.K = 256; J.N = 1024; J.ksc = C.P.in[22] + l * 256; J.ldk = 512; }
    else if (j < 14) { const int q = j - 6; J.W = C.P.in[29] + (size_t)q * 512 * 1024; J.WT = (bf16_t*)(C.P.ws + WS_WBR_T) + (size_t)q * 1024 * 512; J.K = 512; J.N = 1024; }
    else if (j < 16) { const int l = j - 14; J.W = C.P.in[30] + (size_t)l * 1024 * 1024; J.WT = (bf16_t*)(C.P.ws + WS_WOUT_T) + (size_t)l * 1024 * 1024; J.K = 1024; J.N = 1024; }
    else if (j == 16) { J.W = C.P.in[31]; J.WT = (bf16_t*)(C.P.ws + WS_FFGU_T); J.K = 1024; J.N = DFF; J.kind = 2; }
    else if (j == 17) { J.W = C.P.in[32]; J.WT = (bf16_t*)(C.P.ws + WS_FFGU_T); J.K = 1024; J.N = DFF; J.kind = 3; }
    else { J.W = C.P.in[33]; J.WT = (bf16_t*)(C.P.ws + WS_FFD_T); J.K = DFF; J.N = 1024; }
    J.nitems = (J.K / 64) * ((J.N + 63) / 64); if (j < 4 || j >= 6) J.ldk = J.K;
    return J;
}
__device__ __forceinline__ ConvJob conv_job_moe(const Ctx& C, int j) {
    ConvJob J; J.ksc = nullptr; const int e = j / 3, t = j % 3;
    if (t == 0) { J.W = C.P.in[35] + (size_t)e * 1024 * EFF; J.WT = (bf16_t*)(C.P.ws + WS_W13_T) + (size_t)e * 7168 * 1024; J.K = 1024; J.N = EFF; J.kind = 2; }
    else if (t == 1) { J.W = C.P.in[36] + (size_t)e * 1024 * EFF; J.WT = (bf16_t*)(C.P.ws + WS_W13_T) + (size_t)e * 7168 * 1024; J.K = 1024; J.N = EFF; J.kind = 3; }
    else { J.W = C.P.in[37] + (size_t)e * EFF * 1024; J.WT = (bf16_t*)(C.P.ws + WS_W2_T) + (size_t)e * 1024 * EFF; J.K = EFF; J.N = 1024; J.kind = 0; }
    J.nitems = (J.K / 64) * (J.N / 64); J.ldk = J.K;
    return J;
}
template <bool MOE>
__device__ __forceinline__ void conv_weights(const Ctx& C) {
    float* scr = C.lds_f + C.wave * (64 * 65);
    const int gw = C.blk * 8 + C.wave, NGW = C.nblk * 8;
    constexpr int NJ = MOE ? 24 : 19;
    int total = 0;
    for (int j = 0; j < NJ; ++j) total += (MOE ? conv_job_moe(C, j) : conv_job_small(C, j)).nitems;
    for (int it = gw; it < total; it += NGW) {
        int r = it;
        for (int j = 0; j < NJ; ++j) {
            const ConvJob J = MOE ? conv_job_moe(C, j) : conv_job_small(C, j);
            if (r < J.nitems) { const int kind = J.kind; const int nblk = (J.N + 63) / 64, k0 = 64 * (r / nblk), n0 = 64 * (r % nblk);
                if (n0 + 64 <= J.N) transpose_item64(J.W, J.K, J.N, J.ldk, J.WT, [&](int n) { return conv_rowmap(kind, n); }, J.ksc, scr, k0, n0, C.lane);
                else transpose_item(J.W, J.K, J.N, J.ldk, J.WT, [&](int n) { return conv_rowmap(kind, n); }, J.ksc, scr, k0, n0, C.lane);
                break; }
            r -= J.nitems;
        }
    }
    if (!MOE) {
        const int gt = C.blk * NTHREADS + C.tid, NGT = C.nblk * NTHREADS;
        for (int i = gt; i < 2 * 1024 * 32; i += NGT) { const int row = i >> 5, q = i & 31; ((u32x4*)((bf16_t*)(C.P.ws + WS_WUKV_T) + (size_t)row * 512 + 256))[q] = (u32x4){0u, 0u, 0u, 0u}; }
    }
    if (!MOE) {
        const int gt = C.blk * NTHREADS + C.tid, NGT = C.nblk * NTHREADS;
        for (int i = gt; i < 2 * 224 * 128; i += NGT) { const int l = i / (224 * 128), q = i % (224 * 128);
            ((u32x4*)((bf16_t*)(C.P.ws + WS_WIN_T) + ((size_t)l * 8192 + 3872) * 1024))[q] = (u32x4){0u, 0u, 0u, 0u}; }
    }
}

__device__ __forceinline__ float silu_mul(float g, float u) { return g * u * __builtin_amdgcn_rcpf(1.f + __builtin_amdgcn_exp2f(-LOG2E * g)); }
__device__ __forceinline__ void epi_swiglu(const Acc& acc, bf16_t* O, int ldc, int row0, int col0, int wr, int wc, int fr, int fq) {
#pragma unroll
    for (int ai = 0; ai < 2; ++ai)
#pragma unroll
        for (int m = 0; m < 4; ++m) {
            f32x4 h0, h1;
#pragma unroll
            for (int q = 0; q < 4; ++q) { h0[q] = silu_mul(acc[ai][0][m][0][q], acc[ai][1][m][0][q]); h1[q] = silu_mul(acc[ai][0][m][1][q], acc[ai][1][m][1][q]); }
            *(u32x4*)(O + (size_t)(row0 + ai * HALF + wr * 64 + m * 16 + fr) * ldc + col0 + wc * 32 + 8 * fq) = pack8(h0, h1);
        }
}
__device__ __forceinline__ void epi_resid(const Ctx& C, const Acc& acc, int l, int mi, bool first, int row0, int col0, int wr, int wc, int fr, int fq) {
#pragma unroll
    for (int ai = 0; ai < 2; ++ai)
#pragma unroll
        for (int m = 0; m < 4; ++m) {
            const int row = row0 + ai * HALF + wr * 64 + m * 16 + fr;
            const int mrow = row < NL ? (row >> 11) : 8;
            const float* modp = (const float*)(C.P.ws + WS_MOD) + (size_t)(l * 9 + mrow) * 6144 + mi * 1024;
            float* dst = row < NL ? C.P.out + (size_t)row * 1024 : (float*)(C.P.ws + WS_CX) + (size_t)(row - NL) * 1024;
            const float* base = first ? (row < NL ? C.P.in[0] + (size_t)row * 1024 : C.P.in[2] + (size_t)(row - NL) * 1024) : dst;
#pragma unroll
            for (int bj = 0; bj < 2; ++bj)
#pragma unroll
                for (int n = 0; n < 2; ++n) { const int col = col0 + bj * HALF + wc * 32 + n * 16 + 4 * fq;
                    const f32x4 b = *(const f32x4*)(base + col), mv = *(const f32x4*)(modp + col); *(f32x4*)(dst + col) = b + mv * acc[ai][bj][m][n]; }
        }
}

struct SchedG1 { const char* A; const char* B; int l, G, c;
    __device__ __forceinline__ bool next(int i, GUnit& u) const {
        const long L = (long)i * G + c; int pm, pn;
        if (l == 0) { if (!static_order(NT / 256, 32, G, c, i, pm, pn)) return false; }
        else {
            const int nlat = (NL / 256) * 32;
            if (L < nlat) { static_order(NL / 256, 32, G, c, i, pm, pn); }
            else { const long L2 = L - nlat; if (L2 >= (NC / 256) * 8) return false; pm = NL / 256 + (int)(L2 >> 3); pn = 8 + (int)(L2 & 7); }
        }
        u.pm = pm; u.pn = pn; u.aux = 0; u.A = A + (size_t)pm * 256 * 1024 * 2; u.B = B + (size_t)pn * 256 * 1024 * 2; return true;
    } };
struct EpiG1 { bf16_t* PQKV; bf16_t* PG;
    __device__ __forceinline__ void operator()(const Acc& acc, const GUnit& u, int wr, int wc, int fr, int fq) const {
        if (u.pn < 16) epi_store_bf16(acc, PQKV, PQW, u.pm * 256, u.pn * 256, false, wr, wc, fr, fq);
        else epi_store_bf16(acc, PG, PGW, u.pm * 256, (u.pn - 16) * 256, true, wr, wc, fr, fq);
    } };
__device__ __forceinline__ void fg1(const Ctx& C, int l) {
    const SchedG1 S{(const char*)(C.P.ws + WS_XN), (const char*)(C.P.ws + WS_WIN_T) + (size_t)l * 8192 * 1024 * 2, l, C.nblk, C.blk};
    const EpiG1 E{(bf16_t*)(C.P.ws + WS_PQKV), (bf16_t*)(C.P.ws + WS_PG)};
    gemm_phase<true, false>((LAS unsigned char*)C.lds_f, 1024, 1024, S, E);
}
struct SchedRect { const char* A; const char* B; size_t astep, bstep; int nM, nN, G, c;
    __device__ __forceinline__ bool next(int i, GUnit& u) const {
        int pm, pn; if (!static_order(nM, nN, G, c, i, pm, pn)) return false;
        u.pm = pm; u.pn = pn; u.aux = 0; u.A = A + (size_t)pm * astep; u.B = B + (size_t)pn * bstep; return true;
    } };
struct EpiPlain { bf16_t* O; int ldc;
    __device__ __forceinline__ void operator()(const Acc& acc, const GUnit& u, int wr, int wc, int fr, int fq) const { epi_store_bf16(acc, O, ldc, u.pm * 256, u.pn * 256, false, wr, wc, fr, fq); } };
struct SchedG2 { const char* PQ; const char* Wq; const char* Wk; int G, c;
    __device__ __forceinline__ bool next(int i, GUnit& u) const {
        const int L = i * G + c;
        if (L < (NT / 256) * 3) { u.pm = L / 3; u.pn = L % 3; u.aux = 0; u.A = PQ + (size_t)u.pm * 256 * PQW * 2 + C_CQ * 2; u.B = Wq + (size_t)u.pn * 256 * 512 * 2; return true; }
        const int L2 = L - (NT / 256) * 3; if (L2 >= (NT / 256) * 4) return false;
        u.pm = L2 >> 2; u.pn = L2 & 3; u.aux = 1; u.A = PQ + (size_t)u.pm * 256 * PQW * 2 + C_CKV * 2; u.B = Wk + (size_t)u.pn * 256 * 512 * 2; return true;
    } };
struct EpiG2 { bf16_t* QD; bf16_t* KVD;
    __device__ __forceinline__ void operator()(const Acc& acc, const GUnit& u, int wr, int wc, int fr, int fq) const {
        if (u.aux == 0) epi_store_bf16(acc, QD, 768, u.pm * 256, u.pn * 256, false, wr, wc, fr, fq); else epi_store_bf16(acc, KVD, 1024, u.pm * 256, u.pn * 256, false, wr, wc, fr, fq);
    } };
__device__ __forceinline__ void fg2(const Ctx& C, int l) {
    const SchedG2 S{(const char*)(C.P.ws + WS_PQKV), (const char*)(C.P.ws + WS_WUQ_T) + (size_t)l * 768 * 512 * 2, (const char*)(C.P.ws + WS_WUKV_T) + (size_t)l * 1024 * 512 * 2, C.nblk, C.blk};
    const EpiG2 E{(bf16_t*)(C.P.ws + WS_QD), (bf16_t*)(C.P.ws + WS_KVD)};
    gemm_phase<true, false>((LAS unsigned char*)C.lds_f, 512, PQW, S, E);
}
struct SchedG3 { const char* BR; const char* W; int nM, G, c;
    __device__ __forceinline__ bool next(int i, GUnit& u) const {
        int pm, pn; if (!static_order(nM, 8, G, c, i >> 2, pm, pn)) return false;
        const int n = i & 3; u.pm = pm; u.pn = pn; u.aux = n;
        u.A = BR + (size_t)pm * 256 * BRW * 2 + (size_t)n * 512 * 2; u.B = W + (size_t)n * 1024 * 512 * 2 + (size_t)pn * 128 * 512 * 2; return true;
    } };
struct EpiG3 { const bf16_t* PG; bf16_t* MERGED; f32x4 tot[2][4][2];
    __device__ __forceinline__ void operator()(const Acc& acc, const GUnit& u, int wr, int wc, int fr, int fq) {
        const int n = u.aux;
#pragma unroll
        for (int ai = 0; ai < 2; ++ai)
#pragma unroll
            for (int m = 0; m < 4; ++m) {
                const size_t row = (size_t)(u.pm * 256 + ai * HALF + wr * 64 + m * 16 + fr);
                const int col = u.pn * 128 + wc * 32 + 8 * fq;
                const u32x4 g = *(const u32x4*)(PG + row * PGW + n * 1024 + col);
                float gg[8]; unpack8(g, gg);
                f32x4 v0 = acc[ai][0][m][0], v1 = acc[ai][0][m][1];
                v0 = (f32x4){v0[0] * gg[0], v0[1] * gg[1], v0[2] * gg[2], v0[3] * gg[3]}; v1 = (f32x4){v1[0] * gg[4], v1[1] * gg[5], v1[2] * gg[6], v1[3] * gg[7]};
                if (n > 0) { v0 += tot[ai][m][0]; v1 += tot[ai][m][1]; }
                tot[ai][m][0] = v0; tot[ai][m][1] = v1;
                if (n == 3) *(u32x4*)(MERGED + row * 1024 + col) = pack8(v0, v1);
            }
    } };
__device__ __forceinline__ void fg3(const Ctx& C, int l) {
    const SchedG3 S{(const char*)(C.P.ws + WS_BR), (const char*)(C.P.ws + WS_WBR_T) + (size_t)l * 4 * 1024 * 512 * 2, (l == 0 ? NT : NL) / 256, C.nblk, C.blk};
    EpiG3 E; E.PG = (const bf16_t*)(C.P.ws + WS_PG); E.MERGED = (bf16_t*)(C.P.ws + WS_MERGED);
#pragma unroll
    for (int a = 0; a < 2; ++a)
#pragma unroll
        for (int m = 0; m < 4; ++m) { E.tot[a][m][0] = (f32x4){0.f, 0.f, 0.f, 0.f}; E.tot[a][m][1] = (f32x4){0.f, 0.f, 0.f, 0.f}; }
    gemm_phase_t<true, false, true>((LAS unsigned char*)C.lds_f, 512, BRW, S, E);
}
struct EpiResid { const Ctx& C; int l, mi; bool first;
    __device__ __forceinline__ void operator()(const Acc& acc, const GUnit& u, int wr, int wc, int fr, int fq) const { epi_resid(C, acc, l, mi, first, u.pm * 256, u.pn * 256, wr, wc, fr, fq); } };
__device__ __forceinline__ void fg4(const Ctx& C, int l) {
    const SchedRect S{(const char*)(C.P.ws + WS_MERGED), (const char*)(C.P.ws + WS_WOUT_T) + (size_t)l * 1024 * 1024 * 2, (size_t)256 * 1024 * 2, (size_t)256 * 1024 * 2, (l == 0 ? NT : NL) / 256, 4, C.nblk, C.blk};
    const EpiResid E{C, l, 2, l == 0};
    gemm_phase<false, false>((LAS unsigned char*)C.lds_f, 1024, 1024, S, E);
}
struct EpiSwiglu { bf16_t* O; int ldc;
    __device__ __forceinline__ void operator()(const Acc& acc, const GUnit& u, int wr, int wc, int fr, int fq) const { epi_swiglu(acc, O, ldc, u.pm * 256, u.pn * 128, wr, wc, fr, fq); } };
__device__ __forceinline__ void fg5(const Ctx& C) {
    const SchedRect S{(const char*)(C.P.ws + WS_XN), (const char*)(C.P.ws + WS_FFGU_T), (size_t)256 * 1024 * 2, (size_t)256 * 1024 * 2, NT / 256, 22, C.nblk, C.blk};
    const EpiSwiglu E{(bf16_t*)(C.P.ws + WS_H), DFF};
    gemm_phase<true, false>((LAS unsigned char*)C.lds_f, 1024, 1024, S, E);
}
__device__ __forceinline__ void fg6(const Ctx& C) {
    const SchedRect S{(const char*)(C.P.ws + WS_H), (const char*)(C.P.ws + WS_FFD_T), (size_t)256 * DFF * 2, (size_t)256 * DFF * 2, NT / 256, 4, C.nblk, C.blk};
    const EpiResid E{C, 0, 5, false};
    gemm_phase<false, false>((LAS unsigned char*)C.lds_f, DFF, DFF, S, E);
}
struct SchedG7 { const char* XN; const char* W; const int* ROWMAP; int ps[9]; int nM, G, c;
    __device__ __forceinline__ bool next(int i, GUnit& u) const {
        int pm, pn; if (!static_order(nM, 28, G, c, i, pm, pn)) return false;
        const int e = moe_expert_of(ps, pm * 256);
        u.pm = pm; u.pn = pn; u.aux = e; u.A = XN; u.B = W + (size_t)e * 7168 * 1024 * 2 + (size_t)pn * 256 * 1024 * 2; return true;
    }
    __device__ __forceinline__ unsigned row_off(const GUnit& u, int row) const { int tok = ROWMAP[u.pm * 256 + row]; tok = tok < 0 ? 0 : tok; return (unsigned)tok * 2048u; } };
__device__ __forceinline__ void fg7(const Ctx& C) {
    SchedG7 S; int cnt[8]; moe_starts(C, cnt, S.ps);
    S.XN = (const char*)(C.P.ws + WS_XN); S.W = (const char*)(C.P.ws + WS_W13_T); S.ROWMAP = (const int*)(C.P.ws + WS_ROWMAP); S.nM = S.ps[8] / 256; S.G = C.nblk; S.c = C.blk;
    const EpiSwiglu E{(bf16_t*)(C.P.ws + WS_HM), EFF};
    gemm_phase<true, true>((LAS unsigned char*)C.lds_f, 1024, 1024, S, E);
}
struct SchedG8 { const char* HM; const char* W; int ps[9]; int nM, G, c;
    __device__ __forceinline__ bool next(int i, GUnit& u) const {
        int pm, pn; if (!static_order(nM, 4, G, c, i, pm, pn)) return false;
        const int e = moe_expert_of(ps, pm * 256);
        u.pm = pm; u.pn = pn; u.aux = e; u.A = HM + (size_t)pm * 256 * EFF * 2; u.B = W + (size_t)e * 1024 * EFF * 2 + (size_t)pn * 256 * EFF * 2; return true;
    } };
__device__ __forceinline__ void fg8(const Ctx& C) {
    SchedG8 S; int cnt[8]; moe_starts(C, cnt, S.ps);
    S.HM = (const char*)(C.P.ws + WS_HM); S.W = (const char*)(C.P.ws + WS_W2_T); S.nM = S.ps[8] / 256; S.G = C.nblk; S.c = C.blk;
    const EpiPlain E{(bf16_t*)(C.P.ws + WS_YM), 1024};
    gemm_phase<true, false>((LAS unsigned char*)C.lds_f, EFF, EFF, S, E);
}

#ifndef FAST_G1
#define FAST_G1 1
#endif
#ifndef FAST_G2
#define FAST_G2 1
#endif
#ifndef FAST_G3
#define FAST_G3 1
#endif
#ifndef FAST_G4
#define FAST_G4 1
#endif
#ifndef FAST_G5
#define FAST_G5 1
#endif
#ifndef FAST_G6
#define FAST_G6 1
#endif
#ifndef FAST_G7
#define FAST_G7 1
#endif
#ifndef FAST_G8
#define FAST_G8 1
#endif
#define FAST_ANY_SMALL (FAST_G1 || FAST_G2 || FAST_G3 || FAST_G4 || FAST_G5 || FAST_G6)
#define FAST_ANY_MOE (FAST_G7 || FAST_G8)

typedef float f32x16 __attribute__((ext_vector_type(16)));
typedef short s16x4 __attribute__((ext_vector_type(4)));
constexpr int FA_STG = 28672, FA_VOFF = 12288, FA_WSF = 4 * FA_STG, FA_IDX = FA_WSF + 2048;
__device__ __forceinline__ int crow(int r, int hi) { return (r & 3) + 8 * (r >> 2) + 4 * hi; }
struct FAttn {
    const bf16_t* q; int qpitch; const bf16_t* k1; int k1pitch; const bf16_t* k2; int k2pitch; const bf16_t* v; int vpitch;
    int qrow0, qpos0, krow_lat, t0, nlat, krow_ctx; bool masked, has_sink; float sink2;
    const float* qgain; const float* qgain2; const float* rq; bool lat;
};
__device__ __forceinline__ s16x4 ds_tr(const LAS unsigned char* p) { return __builtin_bit_cast(s16x4, __builtin_amdgcn_ds_read_tr16_b64_v4i16((LAS s16x4*)p)); }
__device__ __forceinline__ float xhalf(float v) { return __shfl_xor(v, 32); }
__device__ __forceinline__ unsigned cvtpk(float lo, float hi) { f32x2_t v = {lo, hi}; bf16x2_t b = __builtin_convertvector(v, bf16x2_t); return __builtin_bit_cast(unsigned, b); }
#define FA_WAITV(n) asm volatile("s_waitcnt vmcnt(" #n ")" ::: "memory")
__device__ __forceinline__ void glds16(const void* gsrc, unsigned lds_dst) { unsigned keep;
    asm volatile("s_mov_b32 %0, m0\n\ts_mov_b32 m0, %2\n\ts_nop 0\n\tglobal_load_lds_dwordx4 %1, off\n\ts_mov_b32 m0, %0" : "=&s"(keep) : "v"(gsrc), "s"(lds_dst) : "memory"); }
__device__ __forceinline__ float max3f(float a, float b, float c) { float r; asm("v_max3_f32 %0, %1, %2, %3" : "=v"(r) : "v"(a), "v"(b), "v"(c)); return r; }
__device__ __forceinline__ float xhalf_max(float v) { auto rr = __builtin_amdgcn_permlane32_swap(__float_as_uint(v), __float_as_uint(v), false, false); return fmaxf(__uint_as_float(rr[0]), __uint_as_float(rr[1])); }
__device__ __forceinline__ float xhalf_sum(float v) { auto rr = __builtin_amdgcn_permlane32_swap(__float_as_uint(v), __float_as_uint(v), false, false); return __uint_as_float(rr[0]) + __uint_as_float(rr[1]); }
template <int DQK, int DV>
__device__ __forceinline__ void fattn_core(LAS unsigned char* lds, const FAttn& a, f32x16 (&o)[DV / 32]) {
    constexpr bool NEGM = (DV == 64 && DQK == 64);
    constexpr bool PIPE = (DV == 64);
    const int tid = threadIdx.x, lane = tid & 63, r32 = lane & 31, hi = lane >> 5; const int wid = __builtin_amdgcn_readfirstlane(tid >> 6);
    LAS float* wsf = (LAS float*)(lds + FA_WSF) + wid * 64;
    const int ntiles = a.nlat + 4;
    auto tile_row = [&](int tt) { return tt < a.nlat ? a.krow_lat + 64 * (a.t0 + tt) : a.krow_ctx + 64 * (tt - a.nlat); };
    const unsigned lds0 = (unsigned)(size_t)lds;
    auto issue = [&](int tt) {
        const size_t krow = (size_t)tile_row(tt); const unsigned sb = lds0 + (unsigned)((tt & 3) * FA_STG);
        glds16(a.k1 + (krow + lane) * a.k1pitch + wid * 8, (unsigned)__builtin_amdgcn_readfirstlane(sb + wid * 1024));
        if constexpr (DQK == 96) { if (wid < 4) glds16(a.k2 + (krow + lane) * a.k2pitch + wid * 8, (unsigned)__builtin_amdgcn_readfirstlane(sb + (8 + wid) * 1024)); }
#pragma unroll
        for (int j = 0; j < DV / 64; ++j) { const int cw = j * 8 + wid;
            glds16(a.v + (krow + 16 * (cw & 3) + (lane >> 2)) * a.vpitch + (cw >> 2) * 32 + (lane & 3) * 8, (unsigned)__builtin_amdgcn_readfirstlane(sb + FA_VOFF + cw * 1024)); }
    };
    auto wait_tiles = [&](int tiles_left) {
        if (tiles_left <= 0) FA_WAITV(0);
        else if constexpr (DQK == 96) { if (tiles_left == 1) { if (wid < 4) FA_WAITV(3); else FA_WAITV(2); } else { if (wid < 4) FA_WAITV(6); else FA_WAITV(4); } }
        else if constexpr (DV == 128) { if (tiles_left == 1) FA_WAITV(3); else FA_WAITV(6); }
        else { if (tiles_left == 1) FA_WAITV(2); else FA_WAITV(4); }
    };
    bf16x8 qr[DQK / 16];
    {
        const int row = a.qrow0 + wid * 32 + r32;
        const bf16_t* qp = a.q + (size_t)row * a.qpitch + hi * 8;
        float v[DQK / 16][8];
#pragma unroll
        for (int d0 = 0; d0 < DQK / 16; ++d0) unpack8(*(const u32x4*)(qp + d0 * 16), v[d0]);
        const int tq = a.qpos0 + wid * 32 + r32; const float prow = (float)(tq >> 6), pcol = (float)(tq & 63);
        if constexpr (DQK == 64) {
            float ss = 0.f;
#pragma unroll
            for (int d0 = 0; d0 < 4; ++d0)
#pragma unroll
                for (int j = 0; j < 8; ++j) ss += v[d0][j] * v[d0][j];
            const float rinv = __builtin_amdgcn_rsqf(xhalf_sum(ss) * (1.f / 64.f) + EPS) * QSCALE64;
#pragma unroll
            for (int d0 = 0; d0 < 4; ++d0) { const f32x4 g0 = *(const f32x4*)(a.qgain + 16 * d0 + 8 * hi), g1 = *(const f32x4*)(a.qgain + 16 * d0 + 8 * hi + 4);
#pragma unroll
                for (int j = 0; j < 4; ++j) { v[d0][j] *= rinv * g0[j]; v[d0][4 + j] *= rinv * g1[j]; } }
            if (a.lat) {
#pragma unroll
                for (int j = 0; j < 8; ++j) { const float f = inv_freq(8 * hi + j, 16); float s0, c0, s1, c1; __sincosf(prow * f, &s0, &c0); __sincosf(pcol * f, &s1, &c1);
                    const float x1 = v[0][j], x2 = v[2][j], y1 = v[1][j], y2 = v[3][j];
                    v[0][j] = x1 * c0 - x2 * s0; v[2][j] = x1 * s0 + x2 * c0; v[1][j] = y1 * c1 - y2 * s1; v[3][j] = y1 * s1 + y2 * c1; }
            }
        } else {
            const float rq = a.rq[row];
            float ssn = 0.f, ssr = 0.f;
#pragma unroll
            for (int d0 = 0; d0 < 6; ++d0)
#pragma unroll
                for (int j = 0; j < 8; ++j) { v[d0][j] *= rq; if (d0 < 4) ssn += v[d0][j] * v[d0][j]; else ssr += v[d0][j] * v[d0][j]; }
            const float rn = __builtin_amdgcn_rsqf(xhalf_sum(ssn) * (1.f / 64.f) + EPS) * QSCALE96, rr = __builtin_amdgcn_rsqf(xhalf_sum(ssr) * (1.f / 32.f) + EPS) * QSCALE96;
#pragma unroll
            for (int d0 = 0; d0 < 6; ++d0) { const float* gp = d0 < 4 ? a.qgain + 16 * d0 + 8 * hi : a.qgain2 + 16 * (d0 - 4) + 8 * hi; const float rs = d0 < 4 ? rn : rr;
                const f32x4 g0 = *(const f32x4*)gp, g1 = *(const f32x4*)(gp + 4);
#pragma unroll
                for (int j = 0; j < 4; ++j) { v[d0][j] *= rs * g0[j]; v[d0][4 + j] *= rs * g1[j]; } }
            if (a.lat) {
#pragma unroll
                for (int j = 0; j < 8; ++j) { const float f = inv_freq(j, 8); float s0, c0; __sincosf((hi == 0 ? prow : pcol) * f, &s0, &c0);
                    const float x1 = v[4][j], x2 = v[5][j]; v[4][j] = x1 * c0 - x2 * s0; v[5][j] = x1 * s0 + x2 * c0; }
            }
        }
#pragma unroll
        for (int d0 = 0; d0 < DQK / 16; ++d0) { u32x4 w; w.x = cvtpk(v[d0][0], v[d0][1]); w.y = cvtpk(v[d0][2], v[d0][3]); w.z = cvtpk(v[d0][4], v[d0][5]); w.w = cvtpk(v[d0][6], v[d0][7]); qr[d0] = __builtin_bit_cast(bf16x8, w); }
    }
    asm volatile("s_waitcnt vmcnt(0)" ::: "memory");
    issue(0); issue(1); issue(2);
    float m = a.has_sink ? a.sink2 : 0.f, l = a.has_sink ? (hi == 0 ? 1.f : 0.f) : 0.f;
    f32x16 negm;
#pragma unroll
    for (int r = 0; r < 16; ++r) negm[r] = NEGM ? -m : 0.f;
#pragma unroll
    for (int d0 = 0; d0 < DV / 32; ++d0)
#pragma unroll
        for (int r = 0; r < 16; ++r) o[d0][r] = 0.f;
    const int qpos = a.qpos0 + wid * 32 + r32;
    auto qk = [&](int tt, f32x16& p0, f32x16& p1) {
        const LAS unsigned char* kb = lds + (tt & 3) * FA_STG + hi * 1024 + r32 * 16;
#pragma unroll
        for (int dd = 0; dd < DQK / 32; ++dd) {
            bf16x8 kf[4];
#pragma unroll
            for (int e = 0; e < 2; ++e) { kf[2 * e] = *(const LAS bf16x8*)(kb + (2 * dd + e) * 2048); kf[2 * e + 1] = *(const LAS bf16x8*)(kb + (2 * dd + e) * 2048 + 512); }
#pragma unroll
            for (int e = 0; e < 2; ++e) { const int d0 = 2 * dd + e;
                p0 = __builtin_amdgcn_mfma_f32_32x32x16_bf16(kf[2 * e], qr[d0], d0 == 0 ? negm : p0, 0, 0, 0); p1 = __builtin_amdgcn_mfma_f32_32x32x16_bf16(kf[2 * e + 1], qr[d0], d0 == 0 ? negm : p1, 0, 0, 0); }
        }
    };
    auto step = [&](int t, f32x16& pc0, f32x16& pc1, f32x16& pn0, f32x16& pn1) {
        wait_tiles(t + 2 < ntiles ? 1 : 0);
        __builtin_amdgcn_s_barrier();
        asm volatile("" ::: "memory");
        if (t + 3 < ntiles) issue(t + 3);
        if constexpr (!PIPE) qk(t, pc0, pc1);
        const LAS unsigned char* vp = lds + (t & 3) * FA_STG + FA_VOFF + ((lane >> 4) & 1) * 32 + (lane & 3) * 8 + (4 * hi + ((lane & 15) >> 2)) * 64;
        s16x4 vlo[4], vhh[4];
#pragma unroll
        for (int ks = 0; ks < 4; ++ks) { vlo[ks] = ds_tr(vp + ks * 1024); vhh[ks] = ds_tr(vp + ks * 1024 + 512); }
        if constexpr (!NEGM) {
#pragma unroll
            for (int r = 0; r < 16; ++r) { pc0[r] -= m; pc1[r] -= m; }
        }
        if (a.masked && t < a.nlat) {
            const int kbase = 64 * (a.t0 + t) + 4 * hi - qpos;
#pragma unroll
            for (int r = 0; r < 16; ++r) { const int d = kbase + (r & 3) + 8 * (r >> 2); if (d > 128 || d < -128) pc0[r] = -1e30f; if (d + 32 > 128 || d + 32 < -128) pc1[r] = -1e30f; }
        }
        float mt = max3f(pc0[0], pc0[1], pc1[0]), mu = max3f(pc0[2], pc0[3], pc1[1]); mt = max3f(mt, pc1[2], pc1[3]);
#pragma unroll
        for (int r = 4; r < 16; r += 4) { mt = max3f(mt, pc0[r], pc0[r + 1]); mu = max3f(mu, pc0[r + 2], pc0[r + 3]); mt = max3f(mt, pc1[r], pc1[r + 1]); mu = max3f(mu, pc1[r + 2], pc1[r + 3]); }
        mt = xhalf_max(fmaxf(mt, mu));
        if (__any(mt > 6.0f)) {
            const float dl = fmaxf(mt, 0.f), alpha = __builtin_amdgcn_exp2f(-dl);
            m += dl; l *= alpha;
#pragma unroll
            for (int r = 0; r < 16; ++r) { pc0[r] -= dl; pc1[r] -= dl; }
            if constexpr (NEGM) {
#pragma unroll
                for (int r = 0; r < 16; ++r) negm[r] = -m;
            }
            if (hi == 0) wsf[r32] = alpha;
#pragma unroll
            for (int r4 = 0; r4 < 4; ++r4) { const f32x4 al = *(const LAS f32x4*)(wsf + 8 * r4 + 4 * hi);
#pragma unroll
                for (int d0 = 0; d0 < DV / 32; ++d0) { o[d0][4 * r4] *= al[0]; o[d0][4 * r4 + 1] *= al[1]; o[d0][4 * r4 + 2] *= al[2]; o[d0][4 * r4 + 3] *= al[3]; } }
        }
        __builtin_amdgcn_s_setprio(1);
        if constexpr (PIPE) qk(t + 1, pn0, pn1);
        float ls = 0.f;
#pragma unroll
        for (int r = 0; r < 16; ++r) { pc0[r] = __builtin_amdgcn_exp2f(pc0[r]); pc1[r] = __builtin_amdgcn_exp2f(pc1[r]); ls += pc0[r] + pc1[r]; }
        l += ls;
        bf16x8 pa[4];
#pragma unroll
        for (int s = 0; s < 2; ++s) {
            u32x4 w0, w1;
            w0.x = cvtpk(pc0[8 * s], pc0[8 * s + 1]); w0.y = cvtpk(pc0[8 * s + 2], pc0[8 * s + 3]); w0.z = cvtpk(pc0[8 * s + 4], pc0[8 * s + 5]); w0.w = cvtpk(pc0[8 * s + 6], pc0[8 * s + 7]);
            w1.x = cvtpk(pc1[8 * s], pc1[8 * s + 1]); w1.y = cvtpk(pc1[8 * s + 2], pc1[8 * s + 3]); w1.z = cvtpk(pc1[8 * s + 4], pc1[8 * s + 5]); w1.w = cvtpk(pc1[8 * s + 6], pc1[8 * s + 7]);
            pa[s] = __builtin_bit_cast(bf16x8, w0); pa[2 + s] = __builtin_bit_cast(bf16x8, w1);
        }
#pragma unroll
        for (int d0 = 0; d0 < DV / 32; ++d0) {
#pragma unroll
            for (int ks = 0; ks < 4; ++ks) { const bf16x8 vf = (bf16x8){vlo[ks][0], vlo[ks][1], vlo[ks][2], vlo[ks][3], vhh[ks][0], vhh[ks][1], vhh[ks][2], vhh[ks][3]};
                o[d0] = __builtin_amdgcn_mfma_f32_32x32x16_bf16(pa[ks], vf, o[d0], 0, 0, 0); }
            if (d0 + 1 < DV / 32) {
#pragma unroll
                for (int ks = 0; ks < 4; ++ks) { vlo[ks] = ds_tr(vp + (d0 + 1) * 4096 + ks * 1024); vhh[ks] = ds_tr(vp + (d0 + 1) * 4096 + ks * 1024 + 512); }
            }
        }
        __builtin_amdgcn_s_setprio(0);
        if constexpr (PIPE) {
#pragma unroll
            for (int i = 0; i < DQK / 8; ++i) { __builtin_amdgcn_sched_group_barrier(0x008, 1, 0); __builtin_amdgcn_sched_group_barrier(0x002, 80 / (DQK / 8), 0); }
        }
    };
    f32x16 pA0, pA1, pB0, pB1;
    wait_tiles(2); __builtin_amdgcn_s_barrier(); asm volatile("" ::: "memory");
    if constexpr (PIPE) { qk(0, pA0, pA1); for (int t = 0; t < ntiles; t += 2) { step(t, pA0, pA1, pB0, pB1); step(t + 1, pB0, pB1, pA0, pA1); } }
    else { for (int t = 0; t < ntiles; ++t) step(t, pA0, pA1, pA0, pA1); }
    l = xhalf_sum(l);
    if (hi == 0) wsf[r32] = l > 0.f ? 1.f / l : 0.f;
#pragma unroll
    for (int r4 = 0; r4 < 4; ++r4) { const f32x4 il = *(const LAS f32x4*)(wsf + 8 * r4 + 4 * hi);
#pragma unroll
        for (int d0 = 0; d0 < DV / 32; ++d0) { o[d0][4 * r4] *= il[0]; o[d0][4 * r4 + 1] *= il[1]; o[d0][4 * r4 + 2] *= il[2]; o[d0][4 * r4 + 3] *= il[3]; } }
    __syncthreads();
}
template <int NB>
__device__ __forceinline__ void fattn_store(bf16_t* dst  , int row0, const f32x16 (&o)[NB], int lane) {
    const int r32 = lane & 31, hi = lane >> 5;
#pragma unroll
    for (int d0 = 0; d0 < NB; ++d0)
#pragma unroll
        for (int r = 0; r < 16; ++r) dst[(size_t)(row0 + crow(r, hi)) * BRW + 32 * d0 + r32] = (bf16_t)f2bf(o[d0][r]);
}
__device__ __forceinline__ void fattn_phase(const Ctx& C, int l, int rep = 0) {
    LAS unsigned char* lds = (LAS unsigned char*)C.lds_f;
    const int n_lat = 1792, total = n_lat + (l == 0 ? NBATCH * 28 : 0);
    int* counter = (int*)(C.P.ws + WS_CNT) + 24 + l + 2 * rep;
    const float lam = __hip_atomic_load(&((float*)(C.P.ws + WS_CNT + 128))[l], __ATOMIC_RELAXED, __HIP_MEMORY_SCOPE_AGENT);
    const float lam_init = 0.8f - 0.6f * expf(-0.3f * (float)l);
    const int wid = __builtin_amdgcn_readfirstlane(C.tid >> 6);
    for (;;) {
        unsigned char* wsb = C.P.ws; asm volatile("" : "+s"(wsb));
        bf16_t* PQKV = (bf16_t*)(wsb + WS_PQKV); bf16_t* BR = (bf16_t*)(wsb + WS_BR); bf16_t* QD = (bf16_t*)(wsb + WS_QD); bf16_t* KVD = (bf16_t*)(wsb + WS_KVD);
        if (C.tid == 0) *(LAS int*)(lds + FA_IDX) = atomicAdd(counter, 1);
        __syncthreads();
        const int idx = __builtin_amdgcn_readfirstlane(*(LAS int*)(lds + FA_IDX));
        __syncthreads();
        if (idx >= total) break;
        int mixer, b, h, qb; bool isctx = false;
        if (idx < 256) { mixer = 2; b = idx >> 5; h = (idx >> 3) & 3; qb = idx & 7; }
        else if (idx < n_lat) { const int j = (idx - 256) & 511; mixer = idx < 768 ? 3 : (idx < 1280 ? 1 : 0); b = j >> 6; h = (j >> 3) & 7; qb = j & 7; }
        else { const int j = idx - n_lat, hitem = j % 28; b = j / 28; qb = 0; isctx = true; mixer = hitem < 8 ? 0 : (hitem < 16 ? 1 : (hitem < 20 ? 2 : 3)); h = hitem < 16 ? (hitem & 7) : (hitem < 20 ? hitem - 16 : hitem - 20); }
        FAttn a;
        a.qrow0 = isctx ? NL + b * CTXL : b * SEQ + qb * 256; a.qpos0 = qb * 256;
        a.krow_lat = b * SEQ; a.t0 = 0; a.nlat = isctx ? 0 : 32; a.krow_ctx = NL + b * CTXL; a.masked = false; a.has_sink = false; a.sink2 = 0.f;
        a.k2 = nullptr; a.k2pitch = 0; a.qgain2 = nullptr; a.rq = nullptr; a.lat = !isctx;
        a.qgain = (mixer == 0 ? C.P.in[9] : (mixer == 1 ? C.P.in[12] : (mixer == 2 ? C.P.in[14] : C.P.in[25]))) + l * 64;
        const int row0 = a.qrow0 + wid * 32;
        if (mixer <= 1) {
            const bool isA = mixer == 0; const int kvh = h >> 2;
            a.q = PQKV + (isA ? C_QA : C_QB) + h * 64; a.qpitch = PQW; a.k1 = PQKV + (isA ? C_KA : C_KB) + kvh * 64; a.k1pitch = PQW; a.v = PQKV + (isA ? C_VA : C_VB) + kvh * 64; a.vpitch = PQW;
            if (isA) { a.has_sink = true; a.sink2 = (C.P.in[11])[l * 8 + h] * LOG2E;
                if (!isctx) { a.masked = true; const int ta = 4 * qb - 2, tb = 4 * qb + 6; a.t0 = ta < 0 ? 0 : ta; a.nlat = (tb > 32 ? 32 : tb) - a.t0; } }
            f32x16 o[2]; fattn_core<64, 64>(lds, a, o);
            fattn_store<2>(BR + (isA ? 0 : 512) + h * 64, row0, o, C.lane);
        } else if (mixer == 2) {
            const int hc = h; float* OC1 = (float*)(wsb + WS_OC1);
            a.v = PQKV + C_VC + hc * 128; a.vpitch = PQW; a.qpitch = PQW; a.k1pitch = PQW;
            const int r32 = C.lane & 31, hi = C.lane >> 5;
            f32x16 o[4];
            a.q = PQKV + C_QC + (2 * hc) * 64; a.k1 = PQKV + C_KC + (2 * hc) * 64;
            fattn_core<64, 128>(lds, a, o);
#pragma unroll
            for (int d0 = 0; d0 < 4; ++d0)
#pragma unroll
                for (int r = 0; r < 16; ++r) OC1[((size_t)(row0 + crow(r, hi)) * 4 + hc) * 128 + 32 * d0 + r32] = o[d0][r];
            a.q = PQKV + C_QC + (2 * hc + 1) * 64; a.k1 = PQKV + C_KC + (2 * hc + 1) * 64;
            fattn_core<64, 128>(lds, a, o);
            float ss[16];
#pragma unroll
            for (int r = 0; r < 16; ++r) ss[r] = 0.f;
#pragma unroll
            for (int d0 = 0; d0 < 4; ++d0)
#pragma unroll
                for (int r = 0; r < 16; ++r) { const float o1 = OC1[((size_t)(row0 + crow(r, hi)) * 4 + hc) * 128 + 32 * d0 + r32]; const float dl = o1 - lam * o[d0][r]; o[d0][r] = dl; ss[r] += dl * dl; }
#pragma unroll
            for (int r = 0; r < 16; ++r) {
#pragma unroll
                for (int sft = 1; sft < 32; sft <<= 1) ss[r] += __shfl_xor(ss[r], sft);
                ss[r] = (1.0f / sqrtf(ss[r] * (1.f / 128.f) + EPS)) * (1.f - lam_init);
            }
            const float* gn = (C.P.in[20]) + l * 128;
#pragma unroll
            for (int d0 = 0; d0 < 4; ++d0) { const float g = gn[32 * d0 + r32];
#pragma unroll
                for (int r = 0; r < 16; ++r) o[d0][r] *= ss[r] * g; }
            fattn_store<4>(BR + 1024 + hc * 128, row0, o, C.lane);
        } else {
            a.qgain2 = C.P.in[27] + l * 32; a.rq = (const float*)(wsb + WS_RQ);
            a.q = QD + h * 96; a.qpitch = 768; a.k1 = KVD + h * 128; a.k1pitch = 1024; a.k2 = PQKV + C_KR; a.k2pitch = PQW; a.v = KVD + h * 128 + 64; a.vpitch = 1024;
            f32x16 o[2]; fattn_core<96, 64>(lds, a, o);
            fattn_store<2>(BR + 1536 + h * 64, row0, o, C.lane);
        }
    }
}
#ifndef FAST_ATTN
#define FAST_ATTN 1
#endif

#define XB_TMO      128
#define XB_XCNT(j)  (256  + 64 * (j))
#define XB_XSUB(j)  (1280 + 64 * (j))
#define XB_XGEN(j)  (2304 + 64 * (j))
#define XB_TOP      3328
#define XB_TOPGEN   3392
#define XCD_BAR_WORDS 3456
#define XB_SPIN_CAP (1u << 22)
constexpr size_t WS_BAR = 2 * MiB;
constexpr int LDS_ST_OFF = LDS_BYTES - 64;
__device__ __forceinline__ unsigned xb_ld(unsigned* p)              { return __hip_atomic_load(p, __ATOMIC_RELAXED, __HIP_MEMORY_SCOPE_AGENT); }
__device__ __forceinline__ unsigned xb_add(unsigned* p, unsigned v) { return __hip_atomic_fetch_add(p, v, __ATOMIC_RELAXED, __HIP_MEMORY_SCOPE_AGENT); }
__device__ __forceinline__ unsigned xb_xcc_id() { return (unsigned)__builtin_amdgcn_s_getreg((3 << 11) | 20) & 0xFu; }
#define XB_SPIN(cond, bar) do { unsigned _sp = 0; while (cond) { __builtin_amdgcn_s_sleep(1); \
    if ((++_sp & 255u) == 0u) { if (xb_ld(&(bar)[XB_TMO])) break; if (_sp > XB_SPIN_CAP) { atomicAdd(&(bar)[XB_TMO], 1u); break; } } } } while (0)
struct XcdBarrier { unsigned* bar; unsigned x; volatile LAS unsigned* st; };
__device__ __forceinline__ XcdBarrier xcd_barrier_post(unsigned* bar, volatile LAS unsigned* st) {
    XcdBarrier b; b.bar = bar; b.x = xb_xcc_id(); b.st = st;
    if (threadIdx.x == 0) (void)xb_add(&bar[XB_XCNT(b.x)], 1u);
    return b;
}
__device__ __forceinline__ void xcd_barrier_complete(unsigned* bar, unsigned x, unsigned& nloc, unsigned& nx) {
    const unsigned G = gridDim.x * gridDim.y * gridDim.z;
    unsigned sum, cnt, mine, sp = 0u;
    for (;;) {
        sum = 0u; cnt = 0u; mine = 0u;
#pragma unroll
        for (unsigned j = 0; j < 16; ++j) { const unsigned c = xb_ld(&bar[XB_XCNT(j)]); sum += c; cnt += (c > 0u) ? 1u : 0u; mine = (j == x) ? c : mine; }
        if (sum == G) break;
        __builtin_amdgcn_s_sleep(1);
        if ((++sp & 255u) == 0u) { if (xb_ld(&bar[XB_TMO])) break; if (sp > XB_SPIN_CAP) { atomicAdd(&bar[XB_TMO], 1u); break; } }
    }
    nloc = mine > 0u ? mine : 1u; nx = cnt > 0u ? cnt : 1u;
}
__device__ __forceinline__ void xcd_barrier(const XcdBarrier& b) {
    asm volatile("s_waitcnt vmcnt(0)" ::: "memory");
    __syncthreads();
    if (threadIdx.x == 0) {
        unsigned* bar = b.bar;
        __builtin_amdgcn_s_waitcnt(0);
        unsigned nloc = b.st[0], nx = b.st[1];
        if (nloc == 0u) { xcd_barrier_complete(bar, b.x, nloc, nx); b.st[0] = nloc; b.st[1] = nx; }
        const unsigned old = xb_add(&bar[XB_XSUB(b.x)], 1u);
        const unsigned gen = old / nloc;
        if (old + 1u == (gen + 1u) * nloc) {
            __builtin_amdgcn_fence(__ATOMIC_RELEASE, "agent");
            asm volatile("s_waitcnt vmcnt(0)" ::: "memory");
            const unsigned og = xb_add(&bar[XB_TOP], 1u);
            const unsigned tg = og / nx;
            if (og + 1u == (tg + 1u) * nx) xb_add(&bar[XB_TOPGEN], 1u);
            else XB_SPIN(xb_ld(&bar[XB_TOPGEN]) == tg, bar);
            __builtin_amdgcn_fence(__ATOMIC_ACQUIRE, "agent");
            xb_add(&bar[XB_XGEN(b.x)], 1u);
            asm volatile("s_waitcnt vmcnt(0)" ::: "memory");
        } else {
            XB_SPIN(xb_ld(&bar[XB_XGEN(b.x)]) == gen, bar);
            __builtin_amdgcn_fence(__ATOMIC_ACQUIRE, "agent");
            asm volatile("s_waitcnt vmcnt(0)" ::: "memory");
        }
    }
    __syncthreads();
}

constexpr int N_PHASES = 23;
__global__ void __launch_bounds__(NTHREADS) mk_fwd(Params p) {
    extern __shared__ __attribute__((aligned(16))) unsigned char lds[];
    cg::grid_group grid = cg::this_grid();
#define MKCTX int tid_l_ = (int)threadIdx.x; asm volatile("" : "+v"(tid_l_)); const Ctx C{p, (float*)lds, tid_l_, tid_l_ & 63, tid_l_ >> 6, (int)gridDim.x, (int)blockIdx.x}
    const int lo = p.ph_lo, hi = p.ph_hi;
    if (threadIdx.x < 2) ((volatile LAS unsigned*)((LAS unsigned char*)lds + LDS_ST_OFF))[threadIdx.x] = 0u;
    __syncthreads();
    XcdBarrier xbar; xbar.bar = (unsigned*)(p.ws + WS_BAR); xbar.x = 0; xbar.st = (volatile LAS unsigned*)((LAS unsigned char*)lds + LDS_ST_OFF);
#define SEAM(k) do { if ((k) == 0) { grid.sync(); xbar = xcd_barrier_post((unsigned*)(p.ws + WS_BAR), (volatile LAS unsigned*)((LAS unsigned char*)lds + LDS_ST_OFF)); } else xcd_barrier(xbar); } while (0)
#ifndef REPEAT_MASK
#define REPEAT_MASK 0u
#endif
int rep = 0;
#define PHASE(k, call) if (lo <= (k) && (k) < hi) { MKCTX; rep = 0; call; if ((REPEAT_MASK >> (k)) & 1u) { SEAM(k); rep = 1; call; } if ((k) + 1 < hi) SEAM(k); }
#define PHASEAB(k, callA, callB) if (lo <= (k) && (k) < hi) { MKCTX; callA; callB; if ((REPEAT_MASK >> (k)) & 1u) { SEAM(k); callB; } if ((k) + 1 < hi) SEAM(k); }
    PHASEAB(0, ph_prologue(C), (FAST_ANY_SMALL ? conv_weights<false>(C) : (void)0))
    PHASE(1, ph_adaln(C, 0, 0))
    PHASE(2, (FAST_G1 ? fg1(C, 0) : ph_g1(C, 0)))
    PHASE(3, (FAST_G2 ? fg2(C, 0) : ph_g2(C, 0)))
    PHASE(4, ph_post(C, 0, rep))
    PHASE(5, (FAST_ATTN ? fattn_phase(C, 0, rep) : ph_attn(C, 0)))
    PHASE(6, (FAST_G3 ? fg3(C, 0) : ph_g3(C, 0)))
    PHASE(7, (FAST_G4 ? fg4(C, 0) : ph_g4(C, 0)))
    PHASE(8, ph_adaln(C, 0, 1))
    PHASE(9, (FAST_G5 ? fg5(C) : ph_g5(C)))
    PHASE(10, (FAST_G6 ? fg6(C) : ph_g6(C)))
    PHASE(11, ph_adaln(C, 1, 0))
    PHASE(12, (FAST_G1 ? fg1(C, 1) : ph_g1(C, 1)))
    PHASE(13, (FAST_G2 ? fg2(C, 1) : ph_g2(C, 1)))
    PHASE(14, ph_post(C, 1, rep))
    PHASE(15, (FAST_ATTN ? fattn_phase(C, 1, rep) : ph_attn(C, 1)))
    PHASE(16, (FAST_G3 ? fg3(C, 1) : ph_g3(C, 1)))
    PHASE(17, (FAST_G4 ? fg4(C, 1) : ph_g4(C, 1)))
    PHASEAB(18, ph_adaln(C, 1, 1), (FAST_ANY_MOE ? conv_weights<true>(C) : (void)0))
    PHASE(19, ph_assign(C))
    PHASE(20, (FAST_G7 ? fg7(C) : ph_g7(C)))
    PHASE(21, (FAST_G8 ? fg8(C) : ph_g8(C)))
    PHASE(22, ph_combine(C))
#ifdef EXTRA_SYNCS
    for (int i = 0; i < EXTRA_SYNCS; ++i) xcd_barrier(xbar);
#endif
#ifdef REPEAT_PRO
    grid.sync(); if (blockIdx.x < 0) ph_prologue(C);
#endif
#undef PHASE
#undef PHASEAB
#undef SEAM
}

extern "C" void kernel_launch(void* const* d_in, const int* in_sizes, int n_in, void* d_out, int out_size, void* d_ws, size_t ws_size, hipStream_t stream) {
    static int grid_blocks = 0;
    if (grid_blocks == 0) {
        if (n_in != 38 || ws_size < WS_NEED) { fprintf(stderr, "kernel_launch: unexpected n_in %d / ws_size %zu\n", n_in, ws_size); grid_blocks = -1; return; }
        int dev = 0, cus = 0, per_cu = 0;
        hipGetDevice(&dev);
        hipDeviceGetAttribute(&cus, hipDeviceAttributeMultiprocessorCount, dev);
        hipFuncSetAttribute((const void*)mk_fwd, hipFuncAttributeMaxDynamicSharedMemorySize, LDS_BYTES);
        hipOccupancyMaxActiveBlocksPerMultiprocessor(&per_cu, (const void*)mk_fwd, NTHREADS, LDS_BYTES);
        if (per_cu < 1) per_cu = 1;
        grid_blocks = cus * per_cu;
        (void)hipGetLastError();
    }
    if (grid_blocks < 0) return;
    Params p{};
    for (int i = 0; i < 38; ++i) p.in[i] = (const float*)d_in[i];
    p.out = (float*)d_out; p.ws = (unsigned char*)d_ws; p.ph_lo = 0; p.ph_hi = N_PHASES;
    void* args[] = {&p};
    hipError_t e = hipLaunchCooperativeKernel((const void*)mk_fwd, dim3(grid_blocks), dim3(NTHREADS), args, LDS_BYTES, stream);
    if (e != hipSuccess) fprintf(stderr, "cooperative launch failed: %s (grid %d)\n", hipGetErrorString(e), grid_blocks);
}
```
